# Optimizing an MI355X kernel written in HIP

```python
import jax, jax.numpy as jnp
from jax import lax
import numpy as np

D_MODEL = 1024
BATCH = 16
SEQ = 2048
DEPTH = 2

CHUNK = 64
N_EVEN = (DEPTH + 1) // 2
N_ODD = DEPTH // 2
D_A = 512
CONV_A = 31
D_B = 512
CONV_B = 3
D_C = 512
HEADS_C = 8
SGU_BLOCK = 128
D_D = 512
HEADS_D = 8
HEAD_DIM_D = D_D // HEADS_D
LEFT_CHUNKS = 8
BAND_LEN = (LEFT_CHUNKS + 1) * CHUNK
MAX_REL = 256
W_IN_AB = 2 * D_A + 3 * D_B
W_IN_CD = 2 * D_C + 3 * D_D
N_GROUPS = 4
EXPERTS_PER_GROUP = 8
N_EXPERTS = N_GROUPS * EXPERTS_PER_GROUP
TOP_K = 2
D_EXPERT = 512
EXPERT_BLOCK = 256
ALPHA = (2 * DEPTH) ** 0.25
BETA = (8 * DEPTH) ** -0.25
LN_EPS = 1e-5
NEG_INF = -1e30

kernel_name = "chunk_causal_hybrid_conv_sgu_attn_hmoe"


def layer_norm(x, g, b):
    xf = x.astype(jnp.float32)
    mu = jnp.mean(xf, axis=-1, keepdims=True)
    var = jnp.mean(jnp.square(xf - mu), axis=-1, keepdims=True)
    return ((xf - mu) * lax.rsqrt(var + LN_EPS)).astype(x.dtype) * g + b


def causal_dwconv(x, w):
    k, c = w.shape
    return lax.conv_general_dilated(
        x, w[:, None, :].astype(x.dtype), window_strides=(1,), padding=[(k - 1, 0)],
        dimension_numbers=("NWC", "WIO", "NWC"), feature_group_count=c)


def conv_shortconv_mixer(x, w_in, b_in, a_dw, a_dw_b, a_ln_g, a_ln_b, b_dw, w_out):
    h = x @ w_in + b_in
    a_val, a_gate, g_b, g_c, b_h = jnp.split(
        h, [D_A, 2 * D_A, 2 * D_A + D_B, 2 * D_A + 2 * D_B], axis=-1)
    a = a_val * jax.nn.sigmoid(a_gate)
    a = causal_dwconv(a, a_dw) + a_dw_b
    a = jax.nn.silu(layer_norm(a, a_ln_g, a_ln_b))
    s = g_b * causal_dwconv(g_c * b_h, b_dw)
    return jnp.concatenate([a, s], axis=-1) @ w_out


def sgu_chunk_attention_mixer(x, w_in, b_in, c_ln_g, c_ln_b, c_ws, c_ws_b, d_rel_bias, w_out):
    bt, s_len, _ = x.shape
    h = x @ w_in + b_in
    u, v, q, k, val = jnp.split(
        h, [D_C, 2 * D_C, 2 * D_C + D_D, 2 * D_C + 2 * D_D], axis=-1)

    v = layer_norm(v, c_ln_g, c_ln_b)
    nb = s_len // SGU_BLOCK
    v = v.reshape(bt, nb, SGU_BLOCK, HEADS_C, D_C // HEADS_C)
    pos = jnp.arange(SGU_BLOCK)
    sgu_mask = (pos[None, :] // CHUNK) <= (pos[:, None] // CHUNK)
    ws = jnp.where(sgu_mask[None], c_ws, jnp.zeros((), c_ws.dtype))
    gate = jnp.einsum("hij,bnjhc->bnihc", ws, v) + c_ws_b.T[None, None, :, :, None]
    c_out = u * gate.reshape(bt, s_len, D_C)

    n_chunks = s_len // CHUNK
    q = (q * (HEAD_DIM_D ** -0.5)).reshape(bt, n_chunks, CHUNK, HEADS_D, HEAD_DIM_D)
    q = jnp.transpose(q, (1, 0, 2, 3, 4))
    pad = ((0, 0), (LEFT_CHUNKS * CHUNK, 0), (0, 0), (0, 0))
    kp = jnp.pad(k.reshape(bt, s_len, HEADS_D, HEAD_DIM_D), pad)
    vp = jnp.pad(val.reshape(bt, s_len, HEADS_D, HEAD_DIM_D), pad)
    qi = jnp.arange(CHUNK)[:, None]
    kj = jnp.arange(BAND_LEN)[None, :]
    rel_idx = jnp.clip(qi + LEFT_CHUNKS * CHUNK - kj, -MAX_REL, MAX_REL) + MAX_REL
    rel = d_rel_bias[:, rel_idx].astype(jnp.float32)

    def one_chunk(args):
        n, qn = args
        kb = lax.dynamic_slice_in_dim(kp, n * CHUNK, BAND_LEN, axis=1)
        vb = lax.dynamic_slice_in_dim(vp, n * CHUNK, BAND_LEN, axis=1)
        sc = jnp.einsum("bqhd,bkhd->bhqk", qn, kb, preferred_element_type=jnp.float32) + rel
        key_ok = (n * CHUNK + jnp.arange(BAND_LEN)) >= LEFT_CHUNKS * CHUNK
        sc = jnp.where(key_ok[None, None, None, :], sc, NEG_INF)
        p = jax.nn.softmax(sc, axis=-1).astype(vb.dtype)
        return jnp.einsum("bhqk,bkhd->bqhd", p, vb)

    o = lax.map(one_chunk, (jnp.arange(n_chunks), q))
    o = jnp.transpose(o, (1, 0, 2, 3, 4)).reshape(bt, s_len, D_D)
    return jnp.concatenate([c_out, o], axis=-1) @ w_out


def grouped_expert_ffn(xt, expert_idx, w_gate, w_up, w_down):
    n_tok, k_sel = expert_idx.shape
    m = n_tok * k_sel
    d = xt.shape[-1]
    n_exp = w_gate.shape[0]
    flat_e = expert_idx.reshape(-1)
    order = jnp.argsort(flat_e)
    sorted_e = flat_e[order]
    counts = jnp.bincount(flat_e, length=n_exp)
    padded = ((counts + EXPERT_BLOCK - 1) // EXPERT_BLOCK) * EXPERT_BLOCK
    starts = jnp.cumsum(counts) - counts
    pad_ends = jnp.cumsum(padded)
    pad_starts = pad_ends - padded
    dest = pad_starts[sorted_e] + (jnp.arange(m) - starts[sorted_e])
    n_blocks = -(-m // EXPERT_BLOCK) + n_exp
    xp = jnp.zeros((n_blocks * EXPERT_BLOCK, d), xt.dtype).at[dest].set(xt[order // k_sel])
    block_e = jnp.searchsorted(pad_ends, jnp.arange(n_blocks) * EXPERT_BLOCK, side="right")
    block_e = jnp.minimum(block_e, n_exp - 1)

    def one_block(args):
        xb, e = args
        hb = jax.nn.silu(xb @ w_gate[e]) * (xb @ w_up[e])
        return hb @ w_down[e]

    yp = lax.map(one_block, (xp.reshape(n_blocks, EXPERT_BLOCK, d), block_e))
    y_sorted = yp.reshape(n_blocks * EXPERT_BLOCK, d)[dest]
    y = jnp.zeros((m, d), y_sorted.dtype).at[order].set(y_sorted)
    return y.reshape(n_tok, k_sel, d)


def hierarchical_moe(x, rg_w, rg_b, re_w, re_b, w_gate, w_up, w_down):
    bt, s_len, d = x.shape
    xt = x.reshape(-1, d)
    g_prob = jax.nn.softmax((xt @ rg_w + rg_b).astype(jnp.float32), axis=-1)
    g_top, g_idx = lax.top_k(g_prob, 1)
    e_all = (jnp.einsum("nd,gde->nge", xt, re_w) + re_b).astype(jnp.float32)
    e_logits = jnp.take_along_axis(e_all, g_idx[:, :, None], axis=1)[:, 0]
    e_top, e_idx = lax.top_k(jax.nn.softmax(e_logits, axis=-1), TOP_K)
    e_w = e_top / jnp.sum(e_top, axis=-1, keepdims=True)
    weights = (g_top * e_w).astype(x.dtype)
    expert_idx = g_idx * EXPERTS_PER_GROUP + e_idx
    y = grouped_expert_ffn(xt, expert_idx, w_gate, w_up, w_down)
    return jnp.einsum("nk,nkd->nd", weights, y).reshape(bt, s_len, d)


def setup_inputs(seed: int = 0) -> dict:
    key = jax.random.key(seed)
    ks = iter(jax.random.split(key, 32))

    def nrm(shape, scale):
        return jax.random.normal(next(ks), shape, jnp.float32) * scale

    return {
        "x": nrm((BATCH, SEQ, D_MODEL), 1.0),
        "ab_w_in": nrm((N_EVEN, D_MODEL, W_IN_AB), D_MODEL ** -0.5),
        "ab_b_in": nrm((N_EVEN, W_IN_AB), 0.02),
        "a_dw": nrm((N_EVEN, CONV_A, D_A), CONV_A ** -0.5),
        "a_dw_b": nrm((N_EVEN, D_A), 0.02),
        "a_ln_g": 1.0 + nrm((N_EVEN, D_A), 0.02),
        "a_ln_b": nrm((N_EVEN, D_A), 0.02),
        "b_dw": nrm((N_EVEN, CONV_B, D_B), CONV_B ** -0.5),
        "ab_w_out": nrm((N_EVEN, D_A + D_B, D_MODEL), BETA * (D_A + D_B) ** -0.5),
        "cd_w_in": nrm((N_ODD, D_MODEL, W_IN_CD), D_MODEL ** -0.5),
        "cd_b_in": nrm((N_ODD, W_IN_CD), 0.02),
        "c_ln_g": 1.0 + nrm((N_ODD, D_C), 0.02),
        "c_ln_b": nrm((N_ODD, D_C), 0.02),
        "c_ws": nrm((N_ODD, HEADS_C, SGU_BLOCK, SGU_BLOCK), SGU_BLOCK ** -0.5),
        "c_ws_b": 1.0 + nrm((N_ODD, HEADS_C, SGU_BLOCK), 0.02),
        "d_rel_bias": nrm((N_ODD, HEADS_D, 2 * MAX_REL + 1), 0.1),
        "cd_w_out": nrm((N_ODD, D_C + D_D, D_MODEL), BETA * (D_C + D_D) ** -0.5),
        "mix_ln_g": 1.0 + nrm((DEPTH, D_MODEL), 0.02),
        "mix_ln_b": nrm((DEPTH, D_MODEL), 0.02),
        "moe_rg_w": nrm((DEPTH, D_MODEL, N_GROUPS), D_MODEL ** -0.5),
        "moe_rg_b": nrm((DEPTH, N_GROUPS), 0.01),
        "moe_re_w": nrm((DEPTH, N_GROUPS, D_MODEL, EXPERTS_PER_GROUP), D_MODEL ** -0.5),
        "moe_re_b": nrm((DEPTH, N_GROUPS, EXPERTS_PER_GROUP), 0.01),
        "moe_w_gate": nrm((DEPTH, N_EXPERTS, D_MODEL, D_EXPERT), D_MODEL ** -0.5),
        "moe_w_up": nrm((DEPTH, N_EXPERTS, D_MODEL, D_EXPERT), D_MODEL ** -0.5),
        "moe_w_down": nrm((DEPTH, N_EXPERTS, D_EXPERT, D_MODEL), BETA * D_EXPERT ** -0.5),
        "ffn_ln_g": 1.0 + nrm((DEPTH, D_MODEL), 0.02),
        "ffn_ln_b": nrm((DEPTH, D_MODEL), 0.02),
    }


def reference(x, ab_w_in, ab_b_in, a_dw, a_dw_b, a_ln_g, a_ln_b, b_dw, ab_w_out,
              cd_w_in, cd_b_in, c_ln_g, c_ln_b, c_ws, c_ws_b, d_rel_bias, cd_w_out,
              mix_ln_g, mix_ln_b, moe_rg_w, moe_rg_b, moe_re_w, moe_re_b,
              moe_w_gate, moe_w_up, moe_w_down, ffn_ln_g, ffn_ln_b):
    for layer in range(DEPTH):
        i = layer // 2
        if layer % 2 == 0:
            mix = conv_shortconv_mixer(x, ab_w_in[i], ab_b_in[i], a_dw[i], a_dw_b[i],
                                       a_ln_g[i], a_ln_b[i], b_dw[i], ab_w_out[i])
        else:
            mix = sgu_chunk_attention_mixer(x, cd_w_in[i], cd_b_in[i], c_ln_g[i], c_ln_b[i],
                                            c_ws[i], c_ws_b[i], d_rel_bias[i], cd_w_out[i])
        x = layer_norm(ALPHA * x + mix, mix_ln_g[layer], mix_ln_b[layer])
        ffn = hierarchical_moe(x, moe_rg_w[layer], moe_rg_b[layer], moe_re_w[layer],
                               moe_re_b[layer], moe_w_gate[layer], moe_w_up[layer],
                               moe_w_down[layer])
        x = layer_norm(ALPHA * x + ffn, ffn_ln_g[layer], ffn_ln_b[layer])
    return x
```

```cpp
#include <hip/hip_runtime.h>
#include <cstdio>
#include <cstdint>

#ifndef MK_PER_PHASE
#define MK_PER_PHASE 0
#endif
#ifndef SKIP_MIX0
#define SKIP_MIX0 0
#endif
#ifndef SKIP_MOE0
#define SKIP_MOE0 0
#endif
#ifndef SKIP_MIX1
#define SKIP_MIX1 0
#endif
#ifndef SKIP_MOE1
#define SKIP_MOE1 0
#endif

#ifndef MOE_W_IN_P0
#define MOE_W_IN_P0 0
#endif
#ifndef MOE_W_SLACK
#define MOE_W_SLACK 1
#endif
#ifndef MOE_W_SA
#define MOE_W_SA 4
#endif
#ifndef DBL_MASK
#define DBL_MASK 0
#endif
#define GAS __attribute__((address_space(1)))
#define LAS __attribute__((address_space(3)))
typedef unsigned short bf16_t;
typedef short bf16x8 __attribute__((ext_vector_type(8)));
typedef short s16x4 __attribute__((ext_vector_type(4)));
typedef float f32x2 __attribute__((ext_vector_type(2)));
typedef float f32x4 __attribute__((ext_vector_type(4)));
typedef float f32x16 __attribute__((ext_vector_type(16)));
typedef unsigned u32x2 __attribute__((ext_vector_type(2)));
typedef unsigned u32x4 __attribute__((ext_vector_type(4)));
typedef GAS unsigned gu32;

constexpr int BATCH = 16, SEQ = 2048, DM = 1024, M = BATCH * SEQ;
constexpr int NIN = 2560;
constexpr int NE = 32, DE = 512, CAP = 32768;
constexpr int H0P = 1536, H1P = 2560;
constexpr float LN_EPS = 1e-5f, ALPHA = 1.4142135623730951f, LOG2E = 1.4426950408889634f;
constexpr float QSCALE = 0.125f * LOG2E;
constexpr int NWAVES = 8, NTHR = 512;

constexpr size_t MiB = 1u << 20;
constexpr size_t WS_CTL = 0, CTL_ZERO_BYTES = 128 * 1024;
constexpr size_t WS_BIASP = 1 * MiB;
constexpr size_t WS_WR = 1 * MiB + 64 * 1024;
constexpr size_t WS_SGUW = 1 * MiB + 512 * 1024;
constexpr size_t WS_LIST = 2 * MiB;
constexpr size_t WS_ROWW = 6 * MiB;
constexpr size_t WS_WIN0 = 10 * MiB, WS_WIN1 = 15 * MiB, WS_WOUT0 = 20 * MiB, WS_WOUT1 = 22 * MiB;
constexpr size_t WS_WGU = 24 * MiB;
constexpr size_t WS_WD = 88 * MiB;
constexpr size_t WS_X1Q = 120 * MiB;
constexpr size_t WS_XA = 216 * MiB;
constexpr size_t WS_X1 = 280 * MiB;
constexpr size_t WS_H = 344 * MiB;
constexpr size_t WS_END = 504 * MiB;

constexpr int CW_TMO = 0, CW_CODE = 1;
constexpr int CW_BAR = 4096;
constexpr int CW_CNT = 16384;
static_assert((size_t)(CW_CNT + 2 * 32 * 64) * 4 <= CTL_ZERO_BYTES && (size_t)(CW_BAR + 3456) * 4 <= CTL_ZERO_BYTES, "control words inside the per-call memset");

constexpr int RING_BYTES = 131072;
constexpr int LDSCTL_OFF = RING_BYTES, MISC_OFF = LDSCTL_OFF + 320;
constexpr int TBL_OFF = RING_BYTES + 1024;
constexpr int ROUTER_REC_OFF = TBL_OFF + 2048;
constexpr int LDS_BYTES = 147456;
static_assert(ROUTER_REC_OFF + 4096 <= 147456 && TBL_OFF + 4096 + 2560 * 4 <= 147456, "LDS map");

#define RLX_AGENT __ATOMIC_RELAXED, __HIP_MEMORY_SCOPE_AGENT
#define LDS_WAIT() asm volatile("s_waitcnt lgkmcnt(0)" ::: "memory")
#define VM_WAIT() asm volatile("s_waitcnt vmcnt(0)" ::: "memory")
__device__ __forceinline__ unsigned f2bf(float f) { unsigned u = __builtin_bit_cast(unsigned, f); return (u + 0x7fffu + ((u >> 16) & 1u)) >> 16; }
__device__ __forceinline__ unsigned pk2(float lo, float hi) { return f2bf(lo) | (f2bf(hi) << 16); }
typedef __bf16 bf16x2_n __attribute__((ext_vector_type(2)));
__device__ __forceinline__ unsigned cvt_pk_bf16(float lo, float hi) { const f32x2 v = {lo, hi}; const bf16x2_n b = __builtin_convertvector(v, bf16x2_n); return __builtin_bit_cast(unsigned, b); }
__device__ __forceinline__ float bflo(unsigned w) { return __uint_as_float(w << 16); }
__device__ __forceinline__ float bfhi(unsigned w) { return __uint_as_float(w & 0xffff0000u); }
__device__ __forceinline__ float wave_sum(float v) {
#pragma unroll
    for (int o = 1; o < 64; o <<= 1) v += __shfl_xor(v, o);
    return v;
}
typedef int i32x4 __attribute__((ext_vector_type(4)));
typedef int i32x8 __attribute__((ext_vector_type(8)));
constexpr float W8SCALE = 32.0f, W8INV = 1.0f / 32.0f;
__device__ __forceinline__ float clamp8(float v) { return __builtin_fminf(__builtin_fmaxf(v, -448.0f), 448.0f); }
__device__ __forceinline__ unsigned pk4_fp8(float a, float b, float c, float d) { int w = 0; w = __builtin_amdgcn_cvt_pk_fp8_f32(clamp8(a), clamp8(b), w, false); w = __builtin_amdgcn_cvt_pk_fp8_f32(clamp8(c), clamp8(d), w, true); return (unsigned)w; }
__device__ __forceinline__ f32x4 unpk4_fp8(unsigned w) { const f32x2 lo = __builtin_amdgcn_cvt_pk_f32_fp8((int)w, false), hi = __builtin_amdgcn_cvt_pk_f32_fp8((int)w, true); return (f32x4){lo[0], lo[1], hi[0], hi[1]}; }
constexpr float Y8SCALE = 64.0f, Y8INV = 1.0f / 64.0f;
__device__ __forceinline__ float fast_sigmoid(float x) { return __builtin_amdgcn_rcpf(1.0f + __builtin_amdgcn_exp2f(-x * LOG2E)); }

namespace pg8 {
constexpr int BM = 256, BK = 64, HALF = 128, HTB = HALF * BK * 2, STAGE_BYTES = 8 * HTB, NXCD = 8, WGM = 8;
__host__ __device__ __forceinline__ int lds_byte(int r, int c) { const int st = (r >> 4) * 2 + (c >> 5), rr = r & 15, cc = c & 31, ob = rr * 64 + cc * 2; return st * 1024 + (ob ^ (((ob >> 9) & 1) << 5)); }
__host__ __device__ __forceinline__ void stage_rc(int b, int& R, int& C) { const int st = b / 1024, sb = b % 1024, swz = sb ^ (((sb >> 9) & 1) << 5); R = (st >> 1) * 16 + swz / 64; C = (st & 1) * 32 + (swz % 64) / 2; }
__host__ __device__ __forceinline__ int perm32(int rho) { const int n = rho >> 4, i = rho & 15; return 8 * (i >> 2) + 4 * n + (i & 3); }

struct Unit {
    int pm, pn;
    size_t aoff;
    unsigned lbase;
    int nvalid;
    const char* B;
    int slot;
};

struct StaticOrder {
    static constexpr bool GATHER = false;
    int nM, nN, nwg, G, c, K, dsh; const char* Bt; const unsigned* list;
    __device__ void init(int Mrows, int N, int K_, const void* Bt_, int G_, int c_, int dsh_) { nM = Mrows / BM; nN = N / BM; nwg = nM * nN; G = G_; c = c_; K = K_; Bt = (const char*)Bt_; list = nullptr; dsh = dsh_; }
    __device__ __forceinline__ bool next(int i, Unit& u) const {
        const int nmine = (nwg - c + G - 1) / G; if (i >= (nmine << dsh)) return false; const long L = (long)(i >= nmine ? i - nmine : i) * G + c;
        int wgid = (int)L; { const int q = nwg / NXCD, r = nwg % NXCD, xcd = wgid % NXCD, off = wgid / NXCD; wgid = (xcd < r ? xcd * (q + 1) : r * (q + 1) + (xcd - r) * q) + off; }
        const int nig = WGM * nN, gid = wgid / nig, fm = gid * WGM, gsz = (nM - fm) < WGM ? (nM - fm) : WGM;
        u.pm = fm + ((wgid % nig) % gsz); u.pn = (wgid % nig) / gsz;
        u.aoff = (size_t)u.pm * BM * K * 2; u.B = Bt + (size_t)u.pn * BM * K * 2; u.lbase = 0; u.nvalid = BM; return true;
    }
};
template <bool GATHER_> struct MoeOrder {
    static constexpr bool GATHER = GATHER_;
    const LAS unsigned* tinfo; const LAS unsigned* cntl; int ntiles, G, c, K; const char* Bbase; size_t per_expert; const unsigned* list; int dsh;
    __device__ __forceinline__ bool next(int i, Unit& u) const {
        const int nmine = (ntiles * 4 - c + G - 1) / G; if (i >= (nmine << dsh)) return false; const int L = (i >= nmine ? i - nmine : i) * G + c;
        const int tile = L >> 2; const unsigned ti = tinfo[tile]; const int e = (int)(ti >> 16), mt = (int)(ti & 0xffffu);
        u.pm = tile; u.pn = L & 3; u.aoff = (size_t)tile * BM * K * 2; u.lbase = (unsigned)(e * CAP + mt * BM);
        const int left = (int)cntl[e] - mt * BM; u.nvalid = left < BM ? left : BM;
        u.B = Bbase + (size_t)e * per_expert + (size_t)u.pn * BM * K * 2; return true;
    }
};

#define PG8_EPI_ARGS const f32x4 (&acc)[2][2][4][2], const Unit& u, int wr, int wc, int fr, int fq

template <class Epi, class Sched, bool ALIGN_EPI, bool F8 = false>
__device__ __forceinline__ void gemm_phase(LAS unsigned char* lds, const char* Abase, const int K, const Sched& S, const Epi& E) {
    const int tid = threadIdx.x, wid = __builtin_amdgcn_readfirstlane(tid >> 6), lane = tid & 63, wr = wid >> 2, wc = wid & 3, fr = lane & 15, fq = lane >> 4;
    const int nt = K / BK;
    unsigned voffA[2], voffB[2]; int RA[2]; unsigned CA2[2];
#pragma unroll
    for (int i = 0; i < 2; ++i) { int R, C; stage_rc(tid * 16 + i * 8192, R, C);
        const int Rb = Epi::BJ8 ? (64 * (R >> 5) + 16 * ((R & 15) >> 2) + 4 * ((R >> 4) & 1) + (R & 3)) : Epi::PERM ? ((R & ~31) + perm32(R & 31)) : R;
        voffA[i] = (unsigned)(R * K + C) * 2u; voffB[i] = (unsigned)(Rb * K + C) * 2u; RA[i] = R; CA2[i] = (unsigned)C * 2u; }
    const size_t kstep = (size_t)(BK * 2);
    const size_t hstep = (size_t)HALF * K * 2, hstepB = Epi::BJ8 ? (size_t)8 * K * 2 : hstep;
    const unsigned ldsw = (unsigned)wid * 1024u;
    const int c8 = (fq >> 1) * 32 + fq * 8;
    const int aoff = F8 ? lds_byte(wr * 64 + fr, c8) : lds_byte(wr * 64 + fr, fq * 8), boff = F8 ? lds_byte(wc * 32 + fr, c8) : lds_byte(wc * 32 + fr, fq * 8);
    const int aoffh = aoff ^ 32, boffh = boff ^ 32;

#define PG8_SA(b, h) (((b) * 2 + (h)) * HTB)
#define PG8_SB(b, h) ((4 + (b) * 2 + (h)) * HTB)
#define PG8_STAGE(bufoff, gbase, voff) do { _Pragma("unroll") for (int _i = 0; _i < 2; ++_i) \
        __builtin_amdgcn_global_load_lds((const unsigned*)((const char*)(gbase) + (voff)[_i]), (LAS unsigned*)(lds + (bufoff) + ldsw + _i * 8192), 16, 0, 0); } while (0)
#define PG8_STAGE_A(bufoff, h, pd, go, kb) do { if constexpr (Sched::GATHER) { PG8_STAGE(bufoff, Abase + (kb), go[h]); } else { PG8_STAGE(bufoff, (pd) + (h) * hstep, voffA); } } while (0)
#define PG8_LDA(dst, b, h) do { if constexpr (F8) { _Pragma("unroll") for (int m = 0; m < 4; ++m) { dst##8[m].lo = *(const LAS i32x4*)(lds + PG8_SA(b, h) + aoff + m * 2048); dst##8[m].hi = *(const LAS i32x4*)(lds + PG8_SA(b, h) + aoffh + m * 2048); } } \
        else { _Pragma("unroll") for (int m = 0; m < 4; ++m) _Pragma("unroll") for (int k = 0; k < 2; ++k) dst[m][k] = *(const LAS bf16x8*)(lds + PG8_SA(b, h) + aoff + m * 2048 + k * 1024); } } while (0)
#define PG8_LDB(dst, b, h) do { if constexpr (F8) { _Pragma("unroll") for (int n = 0; n < 2; ++n) { dst##8[n].lo = *(const LAS i32x4*)(lds + PG8_SB(b, h) + boff + n * 2048); dst##8[n].hi = *(const LAS i32x4*)(lds + PG8_SB(b, h) + boffh + n * 2048); } } \
        else { _Pragma("unroll") for (int n = 0; n < 2; ++n) _Pragma("unroll") for (int k = 0; k < 2; ++k) dst[n][k] = *(const LAS bf16x8*)(lds + PG8_SB(b, h) + boff + n * 2048 + k * 1024); } } while (0)
#define PG8_MMA(ai, bj, At, Bt) do { __builtin_amdgcn_s_setprio(1); if constexpr (F8) { _Pragma("unroll") for (int m = 0; m < 4; ++m) _Pragma("unroll") for (int n = 0; n < 2; ++n) \
        asm volatile("v_mfma_scale_f32_16x16x128_f8f6f4 %0, %1, %2, %0, %3, %3 op_sel_hi:[0,0,0]" : "+v"(acc[ai][bj][m][n]) : "v"(Bt##8[n]), "v"(At##8[m]), "v"(sc8)); } else { \
        _Pragma("unroll") for (int m = 0; m < 4; ++m) _Pragma("unroll") for (int n = 0; n < 2; ++n) _Pragma("unroll") for (int k = 0; k < 2; ++k) \
        acc[ai][bj][m][n] = __builtin_amdgcn_mfma_f32_16x16x32_bf16(Bt[n][k], At[m][k], acc[ai][bj][m][n], 0, 0, 0); } __builtin_amdgcn_s_setprio(0); } while (0)
#define PG8_WAIT_V(n) asm volatile("s_waitcnt vmcnt(" #n ")" ::: "memory")
#define PG8_WAIT_L(n) asm volatile("s_waitcnt lgkmcnt(" #n ")" ::: "memory")
#define PG8_BAR __builtin_amdgcn_s_barrier()
#define PG8_SCHED __builtin_amdgcn_sched_barrier(0)
#define PG8_GOFF(dst, uu) do { _Pragma("unroll") for (int _h = 0; _h < 2; ++_h) _Pragma("unroll") for (int _i = 0; _i < 2; ++_i) { \
        int _r = _h * HALF + RA[_i]; _r = _r < (uu).nvalid ? _r : 0; const unsigned _e = S.list[(uu).lbase + _r]; dst[_h][_i] = (_e >> 1) * (unsigned)(K * 2) + CA2[_i]; } } while (0)
    Unit cur, nxt; int ui = 0;
    if (!S.next(0, cur)) return;
    f32x4 acc[2][2][4][2];
#pragma unroll
    for (int a = 0; a < 2; ++a)
#pragma unroll
        for (int b = 0; b < 2; ++b)
#pragma unroll
            for (int m = 0; m < 4; ++m)
#pragma unroll
                for (int n = 0; n < 2; ++n) { acc[a][b][m][n] = (f32x4){0.f, 0.f, 0.f, 0.f}; }
    bf16x8 At[4][2], B0[2][2], B1[2][2];
    i32x8 At8[4], B08[2], B18[2];
    int sc8 = 0x7F7F7F7F; asm volatile("" : "+v"(sc8));
    unsigned goff[2][2] = {{0u, 0u}, {0u, 0u}}, goffn[2][2] = {{0u, 0u}, {0u, 0u}}, eraw[2][2] = {{0u, 0u}, {0u, 0u}};
#define PG8_ERAW(dst, uu) do { _Pragma("unroll") for (int _h = 0; _h < 2; ++_h) _Pragma("unroll") for (int _i = 0; _i < 2; ++_i) { \
        int _r = _h * HALF + RA[_i]; _r = _r < (uu).nvalid ? _r : 0; dst[_h][_i] = S.list[(uu).lbase + _r]; } } while (0)
#define PG8_ECONV(dst, src) do { _Pragma("unroll") for (int _h = 0; _h < 2; ++_h) _Pragma("unroll") for (int _i = 0; _i < 2; ++_i) dst[_h][_i] = (src[_h][_i] >> 1) * (unsigned)(K * 2) + CA2[_i]; } while (0)
    LAS unsigned* lrow = (LAS unsigned*)(lds + ROUTER_REC_OFF);
    if constexpr (Sched::GATHER) { PG8_ERAW(eraw, cur); PG8_ECONV(goff, eraw); }
    const char* cA = Abase + cur.aoff; const char* cB = cur.B;
    cur.slot = 0; E.stage(cur, wid, lane);
    PG8_STAGE(PG8_SB(0, 0), cB, voffB); PG8_STAGE(PG8_SB(0, 1), cB + hstepB, voffB); PG8_STAGE_A(PG8_SA(0, 0), 0, cA, goff, 0); PG8_STAGE_A(PG8_SA(0, 1), 1, cA, goff, 0);
    if (wr == 1) PG8_BAR;
    PG8_WAIT_V(2); PG8_BAR;
    PG8_STAGE(PG8_SB(1, 0), cB + kstep, voffB); PG8_STAGE_A(PG8_SA(1, 0), 0, cA + kstep, goff, kstep); PG8_STAGE(PG8_SB(1, 1), cB + hstepB + kstep, voffB);
    PG8_WAIT_V(6); PG8_BAR;
    for (;;) {
        const bool has_next = S.next(ui + 1, nxt);
        const char* nA = has_next ? Abase + nxt.aoff : cA; const char* nB = has_next ? nxt.B : cB;
        if constexpr (Sched::GATHER) { if (has_next && wid < 4) __builtin_amdgcn_global_load_lds((const unsigned*)(S.list + nxt.lbase + wid * 64 + lane), (LAS unsigned*)(lrow + wid * 64), 4, 0, 0); }
#pragma unroll 1
        for (int t = 0; t < nt; t += 2) {
            const bool last = (t == nt - 2);
            const char* a1 = cA + (size_t)(t + 1) * kstep;
            const char* a2 = last ? nA : cA + (size_t)(t + 2) * kstep; const char* b2 = last ? nB : cB + (size_t)(t + 2) * kstep;
            const char* a3 = a2 + kstep; const char* b3 = b2 + kstep;
            const size_t k1 = (size_t)(t + 1) * kstep, k2 = last ? (size_t)0 : (size_t)(t + 2) * kstep, k3 = k2 + kstep;
            if constexpr (Sched::GATHER) { if (last) {
                if (has_next) { unsigned et[2][2];
#pragma unroll
                    for (int h = 0; h < 2; ++h)
#pragma unroll
                        for (int i = 0; i < 2; ++i) { int r = h * HALF + RA[i]; r = r < nxt.nvalid ? r : 0; asm volatile("" : "+v"(r)); et[h][i] = lrow[r]; }
                    PG8_ECONV(goffn, et); }
                else {
#pragma unroll
                    for (int h = 0; h < 2; ++h) { goffn[h][0] = goff[h][0]; goffn[h][1] = goff[h][1]; } } } }
            unsigned gsel[2][2];
#pragma unroll
            for (int h = 0; h < 2; ++h) { gsel[h][0] = last ? goffn[h][0] : goff[h][0]; gsel[h][1] = last ? goffn[h][1] : goff[h][1]; }
            PG8_LDB(B0, 0, 0); PG8_LDB(B1, 0, 1); PG8_SCHED; PG8_LDA(At, 0, 0); PG8_STAGE_A(PG8_SA(1, 1), 1, a1, goff, k1);
            PG8_WAIT_V(8); PG8_WAIT_L(0); PG8_BAR; PG8_MMA(0, 0, At, B0); PG8_MMA(0, 1, At, B1); PG8_BAR; PG8_SCHED;
            PG8_LDA(At, 0, 1); PG8_STAGE(PG8_SB(0, 0), b2, voffB); PG8_STAGE(PG8_SB(0, 1), b2 + hstepB, voffB); PG8_STAGE_A(PG8_SA(0, 0), 0, a2, gsel, k2);
            PG8_WAIT_V(8); PG8_WAIT_L(0); PG8_BAR; PG8_MMA(1, 0, At, B0); PG8_MMA(1, 1, At, B1); PG8_BAR; PG8_SCHED;
            PG8_LDB(B0, 1, 0); PG8_LDB(B1, 1, 1); PG8_SCHED; PG8_LDA(At, 1, 0); PG8_STAGE_A(PG8_SA(0, 1), 1, a2, gsel, k2);
            PG8_WAIT_V(8); PG8_WAIT_L(0); PG8_BAR; PG8_MMA(0, 0, At, B0); PG8_MMA(0, 1, At, B1); PG8_BAR; PG8_SCHED;
            PG8_LDA(At, 1, 1); PG8_STAGE(PG8_SB(1, 0), b3, voffB); PG8_STAGE(PG8_SB(1, 1), b3 + hstepB, voffB); PG8_STAGE_A(PG8_SA(1, 0), 0, a3, gsel, k3);
            PG8_WAIT_V(8); PG8_WAIT_L(0); PG8_BAR; PG8_MMA(1, 0, At, B0); PG8_MMA(1, 1, At, B1); PG8_BAR; PG8_SCHED;
        }
        if constexpr (ALIGN_EPI) { if (wr == 0) PG8_BAR; }
        if constexpr (F8) asm volatile("s_nop 15\n\ts_nop 15" ::: "memory");
        E(acc, cur, wr, wc, fr, fq);
        if (!has_next) break;
#pragma unroll
        for (int a = 0; a < 2; ++a)
#pragma unroll
            for (int b = 0; b < 2; ++b)
#pragma unroll
                for (int m = 0; m < 4; ++m)
#pragma unroll
                    for (int n = 0; n < 2; ++n) { acc[a][b][m][n] = (f32x4){0.f, 0.f, 0.f, 0.f}; }
        cur = nxt; cA = nA; cB = nB; ++ui;
        cur.slot = ui & 1; E.stage(cur, wid, lane);
#pragma unroll
        for (int h = 0; h < 2; ++h) { goff[h][0] = goffn[h][0]; goff[h][1] = goffn[h][1]; }
        if constexpr (ALIGN_EPI) { if (wr == 1) PG8_BAR; }
    }
    PG8_WAIT_V(0);
    if constexpr (!ALIGN_EPI) { if (wr == 0) PG8_BAR; }
    PG8_BAR;
#undef PG8_SA
#undef PG8_SB
#undef PG8_STAGE
#undef PG8_STAGE_A
#undef PG8_LDA
#undef PG8_LDB
#undef PG8_MMA
#undef PG8_WAIT_V
#undef PG8_WAIT_L
#undef PG8_BAR
#undef PG8_SCHED
#undef PG8_GOFF
#undef PG8_ERAW
#undef PG8_ECONV
}

__device__ __forceinline__ u32x4 pack8(const f32x4 v0, const f32x4 v1) { u32x4 w; w.x = cvt_pk_bf16(v0[0], v0[1]); w.y = cvt_pk_bf16(v0[2], v0[3]); w.z = cvt_pk_bf16(v1[0], v1[1]); w.w = cvt_pk_bf16(v1[2], v1[3]); return w; }
__device__ __forceinline__ f32x4 sigm4(const f32x4 g) { return (f32x4){fast_sigmoid(g[0]), fast_sigmoid(g[1]), fast_sigmoid(g[2]), fast_sigmoid(g[3])}; }

struct EpiIn0 {
    static constexpr bool PERM = true, BJ8 = false;
    bf16_t* H; const LAS float* biasp;
    __device__ __forceinline__ void stage(const Unit&, int, int) const {}
    __device__ __forceinline__ void operator()(PG8_EPI_ARGS) const {
        const int row0 = u.pm * BM + wr * 64 + fr, cin = wc * 32 + 8 * fq, pn = u.pn;
        f32x4 bv[2][2];
#pragma unroll
        for (int bj = 0; bj < 2; ++bj)
#pragma unroll
            for (int n = 0; n < 2; ++n) bv[bj][n] = *(const LAS f32x4*)(biasp + pn * BM + bj * HALF + cin + 4 * n);
        if (pn == 4 || pn == 5) {
            const int oc = 512 + (pn - 4) * 256 + cin;
#pragma unroll
            for (int ai = 0; ai < 2; ++ai)
#pragma unroll
                for (int m = 0; m < 4; ++m) { bf16_t* rowp = H + (size_t)(row0 + ai * HALF + m * 16) * H0P + oc;
#pragma unroll
                    for (int bj = 0; bj < 2; ++bj) *(u32x4*)(rowp + bj * HALF) = pack8(acc[ai][bj][m][0] + bv[bj][0], acc[ai][bj][m][1] + bv[bj][1]); }
        } else {
            const bool glu = pn < 4; const int oc = glu ? pn * 128 + cin : 1024 + (pn - 6) * 128 + cin;
#pragma unroll
            for (int ai = 0; ai < 2; ++ai)
#pragma unroll
                for (int m = 0; m < 4; ++m) { bf16_t* rowp = H + (size_t)(row0 + ai * HALF + m * 16) * H0P + oc;
                    const f32x4 a0 = acc[ai][0][m][0] + bv[0][0], a1 = acc[ai][0][m][1] + bv[0][1]; f32x4 g0 = acc[ai][1][m][0] + bv[1][0], g1 = acc[ai][1][m][1] + bv[1][1];
                    if (glu) { g0 = sigm4(g0); g1 = sigm4(g1); }
                    *(u32x4*)rowp = pack8(a0 * g0, a1 * g1); }
        }
    }
};
struct EpiIn1 {
    static constexpr bool PERM = true, BJ8 = true;
    bf16_t* H; const LAS float* bias;
    __device__ __forceinline__ void stage(const Unit&, int, int) const {}
    __device__ __forceinline__ void operator()(PG8_EPI_ARGS) const {
        const int row0 = u.pm * BM + wr * 64 + fr, col0 = u.pn * BM + wc * 64 + 16 * fq; const float sc = (u.pn == 4 || u.pn == 5) ? QSCALE : 1.0f;
        f32x4 bv[2][2];
#pragma unroll
        for (int bj = 0; bj < 2; ++bj)
#pragma unroll
            for (int n = 0; n < 2; ++n) bv[bj][n] = *(const LAS f32x4*)(bias + col0 + bj * 8 + 4 * n);
#pragma unroll
        for (int ai = 0; ai < 2; ++ai)
#pragma unroll
            for (int m = 0; m < 4; ++m) { bf16_t* rowp = H + (size_t)(row0 + ai * HALF + m * 16) * H1P + col0;
#pragma unroll
                for (int bj = 0; bj < 2; ++bj) *(u32x4*)(rowp + bj * 8) = pack8((acc[ai][bj][m][0] + bv[bj][0]) * sc, (acc[ai][bj][m][1] + bv[bj][1]) * sc); }
    }
};
template <bool RESF32, bool SKIPMIX> struct EpiOut {
    static constexpr bool PERM = true, BJ8 = true;
    bf16_t* Z; const void* res;
    __device__ __forceinline__ void stage(const Unit&, int, int) const {}
    __device__ __forceinline__ void operator()(PG8_EPI_ARGS) const {
        static_assert(!RESF32, "bf16 residual only");
        const int row0 = u.pm * BM + wr * 64 + fr, col0 = u.pn * BM + wc * 64 + 16 * fq;
        u32x4 w[2][4][2];
#pragma unroll
        for (int ai = 0; ai < 2; ++ai)
#pragma unroll
            for (int m = 0; m < 4; ++m)
#pragma unroll
                for (int bj = 0; bj < 2; ++bj) w[ai][m][bj] = __builtin_nontemporal_load((const u32x4*)((const bf16_t*)res + (size_t)(row0 + ai * HALF + m * 16) * DM + col0 + bj * 8));
#pragma unroll
        for (int ai = 0; ai < 2; ++ai)
#pragma unroll
            for (int m = 0; m < 4; ++m)
#pragma unroll
                for (int bj = 0; bj < 2; ++bj) { const size_t off = (size_t)(row0 + ai * HALF + m * 16) * DM + col0 + bj * 8; const u32x4 ww = w[ai][m][bj];
                    const f32x4 r0 = (f32x4){bflo(ww.x), bfhi(ww.x), bflo(ww.y), bfhi(ww.y)}, r1 = (f32x4){bflo(ww.z), bfhi(ww.z), bflo(ww.w), bfhi(ww.w)};
                    f32x4 v0 = r0 * ALPHA, v1 = r1 * ALPHA; if (!SKIPMIX) { v0 += acc[ai][bj][m][0]; v1 += acc[ai][bj][m][1]; }
                    *(u32x4*)(Z + off) = pack8(v0, v1); }
    }
};
struct EpiGU {
    static constexpr bool PERM = true, BJ8 = false;
    unsigned char* HH;
    __device__ __forceinline__ void stage(const Unit&, int, int) const {}
    __device__ __forceinline__ void operator()(PG8_EPI_ARGS) const {
        const int row0 = u.pm * BM + wr * 64 + fr, oc = u.pn * 128 + wc * 32 + 8 * fq;
#pragma unroll
        for (int ai = 0; ai < 2; ++ai)
#pragma unroll
            for (int m = 0; m < 4; ++m) { unsigned char* rowp = HH + (size_t)(row0 + ai * HALF + m * 16) * DE + oc;
                const f32x4 g0 = acc[ai][0][m][0] * W8INV, g1 = acc[ai][0][m][1] * W8INV;
                const f32x4 h0 = g0 * sigm4(g0) * (acc[ai][1][m][0] * W8INV), h1 = g1 * sigm4(g1) * (acc[ai][1][m][1] * W8INV);
                *(u32x2*)rowp = (u32x2){pk4_fp8(h0[0], h0[1], h0[2], h0[3]), pk4_fp8(h1[0], h1[1], h1[2], h1[3])}; }
    }
};
struct EpiDown {
    static constexpr bool PERM = true, BJ8 = true;
    unsigned char* YB; const unsigned* list; const float* roww; LAS unsigned* lrow;
    __device__ __forceinline__ void stage(const Unit& u, int wid, int lane) const {
        const unsigned* src = (wid < 4 ? list : (const unsigned*)roww) + u.lbase + (wid & 3) * 64;
        __builtin_amdgcn_global_load_lds((const unsigned*)(src + lane), (LAS unsigned*)(lrow + u.slot * 512 + wid * 64), 4, 0, 0);
    }
    __device__ __forceinline__ void operator()(PG8_EPI_ARGS) const {
        const int col0 = u.pn * BM + wc * 64 + 16 * fq;
#pragma unroll
        for (int ai = 0; ai < 2; ++ai)
#pragma unroll
            for (int m = 0; m < 4; ++m) { const int r = ai * HALF + wr * 64 + m * 16 + fr;
                if (r < u.nvalid) { const unsigned e = lrow[u.slot * 512 + r]; const float w = __uint_as_float(lrow[u.slot * 512 + 256 + r]) * (W8INV * Y8SCALE); unsigned char* rowp = YB + (size_t)e * DM + col0;
                    const f32x4 v0 = acc[ai][0][m][0] * w, v1 = acc[ai][0][m][1] * w, v2 = acc[ai][1][m][0] * w, v3 = acc[ai][1][m][1] * w;
                    *(u32x4*)rowp = (u32x4){pk4_fp8(v0[0], v0[1], v0[2], v0[3]), pk4_fp8(v1[0], v1[1], v1[2], v1[3]), pk4_fp8(v2[0], v2[1], v2[2], v2[3]), pk4_fp8(v3[0], v3[1], v3[2], v3[3])}; } }
    }
};
}

#define XB_TMO      128
#define XB_XCNT(j)  (256  + 64 * (j))
#define XB_XSUB(j)  (1280 + 64 * (j))
#define XB_XGEN(j)  (2304 + 64 * (j))
#define XB_TOP      3328
#define XB_TOPGEN   3392
#define XCD_BAR_WORDS 3456
#define XB_SPIN_CAP (1u << 18)
__device__ __forceinline__ unsigned xb_ld(unsigned* p)              { return __hip_atomic_load(p, __ATOMIC_RELAXED, __HIP_MEMORY_SCOPE_AGENT); }
__device__ __forceinline__ unsigned xb_add(unsigned* p, unsigned v) { return __hip_atomic_fetch_add(p, v, __ATOMIC_RELAXED, __HIP_MEMORY_SCOPE_AGENT); }
__device__ __forceinline__ unsigned xb_xcc_id() { return (unsigned)__builtin_amdgcn_s_getreg((3 << 11) | 20) & 0xFu; }
#define XB_SPIN(cond, bar) do { unsigned _sp = 0; while (cond) { __builtin_amdgcn_s_sleep(1); \
    if ((++_sp & 255u) == 0u) { if (xb_ld(&(bar)[XB_TMO])) break; if (_sp > XB_SPIN_CAP) { atomicAdd(&(bar)[XB_TMO], 1u); break; } } } } while (0)
struct XcdBarrier { unsigned* bar; unsigned x; volatile LAS unsigned* st; };
__device__ __forceinline__ XcdBarrier xcd_barrier_post(unsigned* bar, volatile LAS unsigned* st) {
    XcdBarrier b; b.bar = bar; b.x = xb_xcc_id(); b.st = st;
    if (threadIdx.x == 0) (void)xb_add(&bar[XB_XCNT(b.x)], 1u);
    return b;
}
__device__ __forceinline__ void xcd_barrier_complete(unsigned* bar, unsigned x, unsigned& nloc, unsigned& nx) {
    const unsigned G = gridDim.x * gridDim.y * gridDim.z;
    unsigned sum, cnt, mine, sp = 0u;
    for (;;) {
        sum = 0u; cnt = 0u; mine = 0u;
#pragma unroll
        for (unsigned j = 0; j < 16; ++j) { const unsigned c = xb_ld(&bar[XB_XCNT(j)]); sum += c; cnt += (c > 0u) ? 1u : 0u; mine = (j == x) ? c : mine; }
        if (sum == G) break;
        __builtin_amdgcn_s_sleep(1);
        if ((++sp & 255u) == 0u) { if (xb_ld(&bar[XB_TMO])) break; if (sp > XB_SPIN_CAP) { atomicAdd(&bar[XB_TMO], 1u); break; } }
    }
    nloc = mine > 0u ? mine : 1u; nx = cnt > 0u ? cnt : 1u;
}
__device__ __forceinline__ void xcd_barrier(const XcdBarrier& b) {
    asm volatile("s_waitcnt vmcnt(0)" ::: "memory");
    __syncthreads();
    if (threadIdx.x == 0) {
        unsigned* bar = b.bar;
        __builtin_amdgcn_s_waitcnt(0);
        unsigned nloc = b.st[0], nx = b.st[1];
        if (nloc == 0u) { xcd_barrier_complete(bar, b.x, nloc, nx); b.st[0] = nloc; b.st[1] = nx; }
        const unsigned old = xb_add(&bar[XB_XSUB(b.x)], 1u);
        const unsigned gen = old / nloc;
        if (old + 1u == (gen + 1u) * nloc) {
            __builtin_amdgcn_fence(__ATOMIC_RELEASE, "agent");
            asm volatile("s_waitcnt vmcnt(0)" ::: "memory");
            const unsigned og = xb_add(&bar[XB_TOP], 1u);
            const unsigned tg = og / nx;
            if (og + 1u == (tg + 1u) * nx) xb_add(&bar[XB_TOPGEN], 1u);
            else XB_SPIN(xb_ld(&bar[XB_TOPGEN]) == tg, bar);
            __builtin_amdgcn_fence(__ATOMIC_ACQUIRE, "agent");
            xb_add(&bar[XB_XGEN(b.x)], 1u);
            asm volatile("s_waitcnt vmcnt(0)" ::: "memory");
        } else {
            XB_SPIN(xb_ld(&bar[XB_XGEN(b.x)]) == gen, bar);
            __builtin_amdgcn_fence(__ATOMIC_ACQUIRE, "agent");
            asm volatile("s_waitcnt vmcnt(0)" ::: "memory");
        }
    }
    __syncthreads();
}

struct Args { const float* in[28]; float* out; unsigned char* ws; int ph_lo, ph_hi, dbl, pad; };
enum { I_X = 0, I_AB_WIN, I_AB_BIN, I_A_DW, I_A_DWB, I_A_LNG, I_A_LNB, I_B_DW, I_AB_WOUT, I_CD_WIN, I_CD_BIN, I_C_LNG, I_C_LNB, I_C_WS, I_C_WSB, I_D_REL, I_CD_WOUT,
       I_MIX_LNG, I_MIX_LNB, I_RG_W, I_RG_B, I_RE_W, I_RE_B, I_WGATE, I_WUP, I_WDOWN, I_FFN_LNG, I_FFN_LNB };

__device__ __forceinline__ void p0_transpose_item(const float* W, int K, int N, bf16_t* WT, int k0, int n0, int drow0, LAS float* scr, int lane) {
    const int n4 = lane & 15, kr = lane >> 4;
    f32x4 v[16];
#pragma unroll
    for (int i = 0; i < 16; ++i) v[i] = __builtin_nontemporal_load((const GAS f32x4*)(W + (size_t)(k0 + 4 * i + kr) * N + n0 + 4 * n4));
#pragma unroll
    for (int i = 0; i < 16; ++i) { const int k = 4 * i + kr; *(LAS f32x4*)(scr + k * 64 + ((4 * n4) ^ (4 * ((k >> 3) & 7)))) = v[i]; }
    LDS_WAIT(); asm volatile("" ::: "memory");
    const int c = lane & 7;
#pragma unroll
    for (int it = 0; it < 8; ++it) { const int n = (lane >> 3) + 8 * it; const LAS float* s = scr + (8 * c) * 64 + (n ^ (4 * c));
        u32x4 o; o.x = pk2(s[0 * 64], s[1 * 64]); o.y = pk2(s[2 * 64], s[3 * 64]); o.z = pk2(s[4 * 64], s[5 * 64]); o.w = pk2(s[6 * 64], s[7 * 64]);
        __builtin_nontemporal_store(o, (GAS u32x4*)(WT + (size_t)(drow0 + n) * K + k0 + 8 * c)); }
    LDS_WAIT(); asm volatile("" ::: "memory");
}
__device__ __forceinline__ void p0_transpose_item_f8(const float* W, int K, int N, unsigned char* WT8, int k0, int n0, int drow0, LAS float* scr, int lane, float scale) {
    const int n4 = lane & 15, kr = lane >> 4;
    f32x4 v[16];
#pragma unroll
    for (int i = 0; i < 16; ++i) v[i] = __builtin_nontemporal_load((const GAS f32x4*)(W + (size_t)(k0 + 4 * i + kr) * N + n0 + 4 * n4));
#pragma unroll
    for (int i = 0; i < 16; ++i) { const int k = 4 * i + kr; *(LAS f32x4*)(scr + k * 64 + ((4 * n4) ^ (4 * ((k >> 3) & 7)))) = v[i]; }
    LDS_WAIT(); asm volatile("" ::: "memory");
    const int c = lane & 3;
#pragma unroll
    for (int it = 0; it < 4; ++it) { const int n = (lane >> 2) + 16 * it; float s[16];
#pragma unroll
        for (int j = 0; j < 16; ++j) { const int k = 16 * c + j; s[j] = scr[k * 64 + (n ^ (4 * ((k >> 3) & 7)))] * scale; }
        u32x4 o; o.x = pk4_fp8(s[0], s[1], s[2], s[3]); o.y = pk4_fp8(s[4], s[5], s[6], s[7]); o.z = pk4_fp8(s[8], s[9], s[10], s[11]); o.w = pk4_fp8(s[12], s[13], s[14], s[15]);
        __builtin_nontemporal_store(o, (GAS u32x4*)(WT8 + (size_t)(drow0 + n) * K + k0 + 16 * c)); }
    LDS_WAIT(); asm volatile("" ::: "memory");
}
__device__ __forceinline__ int perm_ab(int n) {
    const int seg = n >> 9, ch = n & 511, t = ch >> 7, r = ch & 127;
    if (seg == 0) return t * 256 + r;
    if (seg == 1) return t * 256 + 128 + r;
    if (seg == 2) return 1024 + ch;
    if (seg == 3) return 1536 + t * 256 + r;
    return 1536 + t * 256 + 128 + r;
}
constexpr int MOE_W_ITEMS = NE * 3 * 128;
__device__ __forceinline__ void moe_w_item(const Args& A, int r, LAS float* scr, int lane) {
    unsigned char* ws = A.ws;
    const int mat = r >> 7, q = r & 127, le = mat / 3, kind = mat % 3;
    if (kind < 2) {
        const int nb = q % (DE / 64), kb = q / (DE / 64), n0 = 64 * nb;
        const float* src = A.in[kind == 0 ? I_WGATE : I_WUP] + (size_t)le * DM * DE;
        p0_transpose_item_f8(src, DM, DE, ws + WS_WGU + (size_t)le * DM * DM, 64 * kb, n0, (n0 >> 7) * 256 + kind * 128 + (n0 & 127), scr, lane, W8SCALE);
    } else {
        const int nb = q % (DM / 64), kb = q / (DM / 64);
        p0_transpose_item_f8(A.in[I_WDOWN] + (size_t)le * DE * DM, DE, DM, ws + WS_WD + (size_t)le * DM * DE, 64 * kb, 64 * nb, 64 * nb, scr, lane, W8SCALE);
    }
}
__device__ __forceinline__ void moe_w_ids(const Args& A, LAS unsigned char* lds, int layer, int wave, int lane, int id0, int stride, int count) {
    LAS float* scr = (LAS float*)(lds + wave * 16384);
    for (int k = 0, id = id0; k < count && id < MOE_W_ITEMS / NWAVES; ++k, id += stride) moe_w_item(A, layer * MOE_W_ITEMS + id * NWAVES + wave, scr, lane);
}
constexpr int SLACK_K5 = 2, SLACK_K6 = 2;
__device__ __forceinline__ int slack_first(int T) { return (4 * T) & 255; }
__device__ __forceinline__ int slack_done(int T) { const int f = slack_first(T); return f ? (256 - f) * (SLACK_K5 + SLACK_K6) : 0; }
__device__ __forceinline__ void moe_w_steps(const Args& A, LAS unsigned char* lds, int layer, int vcu, int wave, int lane, int s0, int s1) {
    LAS float* scr = (LAS float*)(lds + wave * 16384);
    for (int s = s0; s < s1; ++s) moe_w_item(A, layer * MOE_W_ITEMS + (s * 256 + vcu) * NWAVES + wave, scr, lane);
}
__device__ __forceinline__ void p0_prologue(const Args& A, LAS unsigned char* lds, int vcu, int G, int wave, int lane, int tid, int rp) {
    unsigned char* ws = A.ws;
    LAS float* scr = (LAS float*)(lds + wave * 16384);
    const int gw = vcu * NWAVES + wave, NGW = G * NWAVES;
    constexpr int I_IN = (DM / 64) * (NIN / 64), I_OUT = (DM / 64) * (DM / 64);
    constexpr int NITEMS = 2 * I_IN + 2 * I_OUT + (MOE_W_IN_P0 ? 2 * MOE_W_ITEMS : 0);
    for (int it_ = gw; it_ < (NITEMS << rp); it_ += NGW) {
        int r = it_ >= NITEMS ? it_ - NITEMS : it_;
        if (r < I_IN) { const int nb = r % (NIN / 64), kb = r / (NIN / 64); p0_transpose_item(A.in[I_AB_WIN], DM, NIN, (bf16_t*)(ws + WS_WIN0), 64 * kb, 64 * nb, perm_ab(64 * nb), scr, lane); continue; } r -= I_IN;
        if (r < I_IN) { const int nb = r % (NIN / 64), kb = r / (NIN / 64); p0_transpose_item(A.in[I_CD_WIN], DM, NIN, (bf16_t*)(ws + WS_WIN1), 64 * kb, 64 * nb, 64 * nb, scr, lane); continue; } r -= I_IN;
        if (r < I_OUT) { const int nb = r % (DM / 64), kb = r / (DM / 64); p0_transpose_item(A.in[I_AB_WOUT], DM, DM, (bf16_t*)(ws + WS_WOUT0), 64 * kb, 64 * nb, 64 * nb, scr, lane); continue; } r -= I_OUT;
        if (r < I_OUT) { const int nb = r % (DM / 64), kb = r / (DM / 64); p0_transpose_item(A.in[I_CD_WOUT], DM, DM, (bf16_t*)(ws + WS_WOUT1), 64 * kb, 64 * nb, 64 * nb, scr, lane); continue; } r -= I_OUT;
        moe_w_item(A, r, scr, lane);
    }
    const int gt = vcu * NTHR + tid, NGT = G * NTHR;
    { const GAS f32x4* x4 = (const GAS f32x4*)A.in[I_X]; GAS u32x4* o = (GAS u32x4*)(ws + WS_XA);
      for (int i0_ = gt; i0_ < ((M * DM / 8) << rp); i0_ += 4 * NGT) { const int i0 = i0_ & (M * DM / 8 - 1); f32x4 a[4], b[4];
#pragma unroll
          for (int j = 0; j < 4; ++j) { const int i = i0 + j * NGT; a[j] = __builtin_nontemporal_load(x4 + 2 * i); b[j] = __builtin_nontemporal_load(x4 + 2 * i + 1); }
#pragma unroll
          for (int j = 0; j < 4; ++j) { const int i = i0 + j * NGT; u32x4 w; w.x = pk2(a[j][0], a[j][1]); w.y = pk2(a[j][2], a[j][3]); w.z = pk2(b[j][0], b[j][1]); w.w = pk2(b[j][2], b[j][3]); o[i] = w; } } }
    { float* bp = (float*)(ws + WS_BIASP); for (int n = gt; n < NIN; n += NGT) bp[perm_ab(n)] = A.in[I_AB_BIN][n]; }
    { bf16_t* wr = (bf16_t*)(ws + WS_WR);
      for (int i = gt; i < 2 * 48 * DM; i += NGT) { const int l = i / (48 * DM), r = (i / DM) % 48, k = i % DM; float v = 0.f;
          if (r < 4) v = A.in[I_RG_W][((size_t)l * DM + k) * 4 + r];
          else if (r < 36) { const int g = (r - 4) >> 3, e = (r - 4) & 7; v = A.in[I_RE_W][(((size_t)l * 4 + g) * DM + k) * 8 + e]; }
          wr[i] = (bf16_t)f2bf(v); } }
    { bf16_t* sw = (bf16_t*)(ws + WS_SGUW);
      for (int i = gt; i < 8 * 128 * 128; i += NGT) { const int ii = (i >> 7) & 127, j = i & 127; const float v = ((j >> 6) <= (ii >> 6)) ? A.in[I_C_WS][i] : 0.f; sw[i] = (bf16_t)f2bf(v); } }
}

__device__ __forceinline__ void conv_phase(const Args& A, LAS unsigned char* lds, int vcu, int G, int wave, int lane, int tid, const bf16_t* H0, bf16_t* U, int rp) {
    LAS unsigned char* tileA = lds;
    LAS float* outA = (LAS float*)(lds + 63488);
    const int cp = tid & 255, pg = tid >> 8;
    float w0[31], w1[31];
#pragma unroll
    for (int t = 0; t < 31; ++t) { const f32x2 w = *(const f32x2*)(A.in[I_A_DW] + t * 512 + 2 * cp); w0[t] = w.x; w1[t] = w.y; }
    const f32x2 cb = *(const f32x2*)(A.in[I_A_DWB] + 2 * cp);
    const f32x4 g0 = *(const f32x4*)(A.in[I_A_LNG] + 4 * lane), g1 = *(const f32x4*)(A.in[I_A_LNG] + 256 + 4 * lane);
    const f32x4 b0 = *(const f32x4*)(A.in[I_A_LNB] + 4 * lane), b1 = *(const f32x4*)(A.in[I_A_LNB] + 256 + 4 * lane);
    for (int un_ = vcu; un_ < ((BATCH * (SEQ / 32)) << rp); un_ += G) { const int un = un_ & (BATCH * (SEQ / 32) - 1);
        const int b = un / (SEQ / 32), s0 = (un % (SEQ / 32)) * 32; const size_t rowb = (size_t)b * SEQ;
        { u32x4 tv[8];
#pragma unroll
          for (int k = 0; k < 8; ++k) { const int p = tid + k * NTHR, r = p >> 6, ch = p & 63, s = s0 - 30 + r; tv[k] = (u32x4){0u, 0u, 0u, 0u};
              if (p < 62 * 64 && s >= 0) tv[k] = *(const u32x4*)(H0 + (rowb + s) * H0P + ch * 8); }
#pragma unroll
          for (int k = 0; k < 8; ++k) { const int p = tid + k * NTHR, r = p >> 6, ch = p & 63; if (p < 62 * 64) *(LAS u32x4*)(tileA + r * 1024 + ch * 16) = tv[k]; } }
        __syncthreads();
#pragma unroll 1
        for (int tk = 0; tk < 2; ++tk) { const int pos0 = pg * 16 + tk * 8;
            float a0[8], a1[8];
#pragma unroll
            for (int p = 0; p < 8; ++p) { a0[p] = cb.x; a1[p] = cb.y; }
#pragma unroll
            for (int j = 0; j < 38; ++j) { const unsigned w = *(const LAS unsigned*)(tileA + (pos0 + j) * 1024 + cp * 4); const float x0 = bflo(w), x1 = bfhi(w);
#pragma unroll
                for (int p = 0; p < 8; ++p) { const int t = j - p; if (t >= 0 && t <= 30) { a0[p] += w0[t] * x0; a1[p] += w1[t] * x1; } } }
#pragma unroll
            for (int p = 0; p < 8; ++p) *(LAS f32x2*)(outA + (pos0 + p) * 512 + 2 * cp) = (f32x2){a0[p], a1[p]};
        }
        __syncthreads();
#pragma unroll 1
        for (int rr = 0; rr < 4; ++rr) { const int r = wave * 4 + rr;
            const f32x4 v0 = *(const LAS f32x4*)(outA + r * 512 + 4 * lane), v1 = *(const LAS f32x4*)(outA + r * 512 + 256 + 4 * lane);
            const float mean = wave_sum((v0[0] + v0[1]) + (v0[2] + v0[3]) + (v1[0] + v1[1]) + (v1[2] + v1[3])) * (1.f / 512.f);
            const f32x4 d0 = v0 - mean, d1 = v1 - mean;
            const float var = wave_sum((d0[0] * d0[0] + d0[1] * d0[1]) + (d0[2] * d0[2] + d0[3] * d0[3]) + (d1[0] * d1[0] + d1[1] * d1[1]) + (d1[2] * d1[2] + d1[3] * d1[3])) * (1.f / 512.f);
            const float rstd = 1.0f / sqrtf(var + LN_EPS);
            f32x4 y0 = d0 * rstd * g0 + b0, y1 = d1 * rstd * g1 + b1;
            y0 = y0 * pg8::sigm4(y0); y1 = y1 * pg8::sigm4(y1);
            bf16_t* orow = U + (rowb + s0 + r) * DM;
            *(u32x2*)(orow + 4 * lane) = (u32x2){cvt_pk_bf16(y0[0], y0[1]), cvt_pk_bf16(y0[2], y0[3])};
            *(u32x2*)(orow + 256 + 4 * lane) = (u32x2){cvt_pk_bf16(y1[0], y1[1]), cvt_pk_bf16(y1[2], y1[3])}; }
#pragma unroll
        for (int k = 0; k < 4; ++k) { const int task = tid + k * NTHR, p = task >> 6, cg = task & 63; const int s = s0 + p;
            f32x4 acc0 = (f32x4){0.f, 0.f, 0.f, 0.f}, acc1 = acc0;
#pragma unroll
            for (int t = 0; t < 3; ++t) { const int ss = s - 2 + t;
                if (ss >= 0) { const u32x4 w = *(const u32x4*)(H0 + (rowb + ss) * H0P + 1024 + cg * 8);
                    const f32x4 k0 = *(const f32x4*)(A.in[I_B_DW] + t * 512 + cg * 8), k1 = *(const f32x4*)(A.in[I_B_DW] + t * 512 + cg * 8 + 4);
                    acc0 += k0 * (f32x4){bflo(w.x), bfhi(w.x), bflo(w.y), bfhi(w.y)}; acc1 += k1 * (f32x4){bflo(w.z), bfhi(w.z), bflo(w.w), bfhi(w.w)}; } }
            const u32x4 g = *(const u32x4*)(H0 + (rowb + s) * H0P + 512 + cg * 8);
            acc0 *= (f32x4){bflo(g.x), bfhi(g.x), bflo(g.y), bfhi(g.y)}; acc1 *= (f32x4){bflo(g.z), bfhi(g.z), bflo(g.w), bfhi(g.w)};
            *(u32x4*)(U + (rowb + s) * DM + 512 + cg * 8) = pg8::pack8(acc0, acc1); }
        __syncthreads();
    }
}

__device__ __forceinline__ void router_phase(const Args& A, LAS unsigned char* lds, int vcu, int wave, int lane, int tid, int layer, const bf16_t* Z, bf16_t* X1, unsigned* cnt, int rp) {
    constexpr int RS = 2064;
    LAS unsigned char* wrl = lds;
    LAS unsigned char* xt = lds + 36 * RS;
    LAS float* lgp = (LAS float*)(lds + 36 * RS + 16 * RS);
    LAS float* lg = (LAS float*)(lds + 36 * RS + 16 * RS + 18432);
    LAS unsigned* rec = (LAS unsigned*)(lds + ROUTER_REC_OFF);
    const bf16_t* WR = (const bf16_t*)(A.ws + WS_WR) + (size_t)layer * 48 * DM;
    { u32x4 tv[9];
#pragma unroll
      for (int k = 0; k < 9; ++k) { const int p = tid + k * NTHR, r = p >> 7, ch = p & 127; tv[k] = *(const u32x4*)(WR + r * DM + ch * 8); }
#pragma unroll
      for (int k = 0; k < 9; ++k) { const int p = tid + k * NTHR, r = p >> 7, ch = p & 127; *(LAS u32x4*)(wrl + r * RS + ch * 16) = tv[k]; } }
    const float* lng = A.in[I_MIX_LNG] + layer * DM; const float* lnb = A.in[I_MIX_LNB] + layer * DM;
    const float* rgb = A.in[I_RG_B] + layer * 4; const float* reb = A.in[I_RE_B] + layer * 32;
    f32x4 g[4], bb[4];
#pragma unroll
    for (int q = 0; q < 2; ++q) { g[2 * q] = *(const f32x4*)(lng + q * 512 + lane * 8); g[2 * q + 1] = *(const f32x4*)(lng + q * 512 + lane * 8 + 4);
        bb[2 * q] = *(const f32x4*)(lnb + q * 512 + lane * 8); bb[2 * q + 1] = *(const f32x4*)(lnb + q * 512 + lane * 8 + 4); }
    const int rc0 = tid % 36, rc1 = (tid + NTHR) % 36;
    const float rbias0 = rc0 < 4 ? rgb[rc0] : reb[rc0 - 4], rbias1 = rc1 < 4 ? rgb[rc1] : reb[rc1 - 4];
    const int tok0 = vcu * 128;
    u32x4 pre[2][2];
#pragma unroll
    for (int tt = 0; tt < 2; ++tt) { const int tok = tok0 + 2 * wave + tt; pre[tt][0] = __builtin_nontemporal_load((const u32x4*)(Z + (size_t)tok * DM + lane * 8)); pre[tt][1] = __builtin_nontemporal_load((const u32x4*)(Z + (size_t)tok * DM + 512 + lane * 8)); }
    __syncthreads();
#pragma unroll 1
    for (int k_ = 0; k_ < (8 << rp); ++k_) { const int k = k_ & 7;
        u32x4 curp[2][2];
#pragma unroll
        for (int tt = 0; tt < 2; ++tt) { curp[tt][0] = pre[tt][0]; curp[tt][1] = pre[tt][1]; }
        if (k_ < (8 << rp) - 1) {
#pragma unroll
            for (int tt = 0; tt < 2; ++tt) { const int tok = tok0 + 16 * ((k + 1) & 7) + 2 * wave + tt; pre[tt][0] = __builtin_nontemporal_load((const u32x4*)(Z + (size_t)tok * DM + lane * 8)); pre[tt][1] = __builtin_nontemporal_load((const u32x4*)(Z + (size_t)tok * DM + 512 + lane * 8)); } }
#pragma unroll
        for (int tt = 0; tt < 2; ++tt) { const int tl = 2 * wave + tt, tok = tok0 + 16 * k + tl;
            const u32x4 p0 = curp[tt][0], p1 = curp[tt][1];
            f32x4 v[4] = {(f32x4){bflo(p0.x), bfhi(p0.x), bflo(p0.y), bfhi(p0.y)}, (f32x4){bflo(p0.z), bfhi(p0.z), bflo(p0.w), bfhi(p0.w)},
                          (f32x4){bflo(p1.x), bfhi(p1.x), bflo(p1.y), bfhi(p1.y)}, (f32x4){bflo(p1.z), bfhi(p1.z), bflo(p1.w), bfhi(p1.w)}};
            float s = 0.f;
#pragma unroll
            for (int j = 0; j < 4; ++j) s += (v[j][0] + v[j][1]) + (v[j][2] + v[j][3]);
            const float mean = wave_sum(s) * (1.f / DM); float s2 = 0.f;
#pragma unroll
            for (int j = 0; j < 4; ++j) { v[j] = v[j] - mean; s2 += (v[j][0] * v[j][0] + v[j][1] * v[j][1]) + (v[j][2] * v[j][2] + v[j][3] * v[j][3]); }
            const float rstd = 1.0f / sqrtf(wave_sum(s2) * (1.f / DM) + LN_EPS);
#pragma unroll
            for (int j = 0; j < 4; ++j) v[j] = v[j] * rstd * g[j] + bb[j];
            const u32x4 o0 = pg8::pack8(v[0], v[1]), o1 = pg8::pack8(v[2], v[3]);
            *(u32x4*)(X1 + (size_t)tok * DM + lane * 8) = o0; *(u32x4*)(X1 + (size_t)tok * DM + 512 + lane * 8) = o1;
            { unsigned char* xq = A.ws + WS_X1Q + (size_t)tok * DM;
              *(u32x2*)(xq + lane * 8) = (u32x2){pk4_fp8(v[0][0], v[0][1], v[0][2], v[0][3]), pk4_fp8(v[1][0], v[1][1], v[1][2], v[1][3])};
              *(u32x2*)(xq + 512 + lane * 8) = (u32x2){pk4_fp8(v[2][0], v[2][1], v[2][2], v[2][3]), pk4_fp8(v[3][0], v[3][1], v[3][2], v[3][3])}; }
            *(LAS u32x4*)(xt + tl * RS + lane * 16) = o0; *(LAS u32x4*)(xt + tl * RS + 1024 + lane * 16) = o1; }
        __syncthreads();
        {
          f32x4 acc[3]; const int fr = lane & 15, fq = lane >> 4;
#pragma unroll
          for (int nt = 0; nt < 3; ++nt) acc[nt] = (f32x4){0.f, 0.f, 0.f, 0.f};
#pragma unroll
          for (int q = 0; q < 4; ++q) { const int kk = 4 * wave + q; const bf16x8 a = *(const LAS bf16x8*)(xt + fr * RS + (32 * kk + 8 * fq) * 2);
#pragma unroll
              for (int nt = 0; nt < 3; ++nt) { int br = 16 * nt + fr; br = br < 36 ? br : 35; const bf16x8 bw = *(const LAS bf16x8*)(wrl + br * RS + (32 * kk + 8 * fq) * 2);
                  acc[nt] = __builtin_amdgcn_mfma_f32_16x16x32_bf16(a, bw, acc[nt], 0, 0, 0); } }
#pragma unroll
          for (int nt = 0; nt < 3; ++nt) if (16 * nt + fr < 36) {
#pragma unroll
              for (int r = 0; r < 4; ++r) lgp[(wave * 16 + 4 * fq + r) * 36 + 16 * nt + fr] = acc[nt][r]; } }
        __syncthreads();
        { float v = rbias0;
#pragma unroll
          for (int w = 0; w < 8; ++w) v += lgp[w * 576 + tid];
          lg[tid] = v;
          if (tid < 64) { float v1 = rbias1;
#pragma unroll
              for (int w = 0; w < 8; ++w) v1 += lgp[w * 576 + NTHR + tid];
              lg[NTHR + tid] = v1; } }
        __syncthreads();
        if (tid < 16) { const LAS float* L = lg + tid * 36; const int tok = tok0 + 16 * k + tid;
            int gi = 0; float gm = L[0];
#pragma unroll
            for (int j = 1; j < 4; ++j) { const float v = L[j]; if (v > gm) { gm = v; gi = j; } }
            float gs = 0.f;
#pragma unroll
            for (int j = 0; j < 4; ++j) gs += __expf(L[j] - gm);
            const float gtop = 1.0f / gs;
            const LAS float* Le = L + 4 + gi * 8;
            int e1 = 0; float m1 = Le[0];
#pragma unroll
            for (int j = 1; j < 8; ++j) { const float v = Le[j]; if (v > m1) { m1 = v; e1 = j; } }
            int e2 = -1; float m2 = -3.0e38f;
#pragma unroll
            for (int j = 0; j < 8; ++j) { const float v = Le[j]; if (j != e1 && v > m2) { m2 = v; e2 = j; } }
            const float q2 = __expf(m2 - m1), w1 = gtop / (1.0f + q2), w2 = gtop * q2 / (1.0f + q2);
            LAS unsigned* rp = rec + (16 * k + tid) * 8;
            rp[0] = (unsigned)(gi * 8 + e1); rp[1] = (unsigned)(tok * 2); rp[2] = __float_as_uint(w1);
            rp[4] = (unsigned)(gi * 8 + e2); rp[5] = (unsigned)(tok * 2 + 1); rp[6] = __float_as_uint(w2); }
    }
    __syncthreads();
    {
        const int e = tid >> 4, s = tid & 15; int c = 0;
#pragma unroll
        for (int r = 0; r < 16; ++r) c += (rec[(16 * s + r) * 4] == (unsigned)e) ? 1 : 0;
        int incl = c;
#pragma unroll
        for (int o = 1; o < 16; o <<= 1) { const int t = __shfl_up(incl, o, 16); if (s >= o) incl += t; }
        const int total = __shfl(incl, 15, 16);
        unsigned base = 0; if (s == 0 && total > 0) base = __hip_atomic_fetch_add(cnt + e * 64, (unsigned)total, RLX_AGENT);
        base = __shfl(base, 0, 16) + (unsigned)(incl - c);
        unsigned* list = (unsigned*)(A.ws + WS_LIST) + (size_t)e * CAP; float* roww = (float*)(A.ws + WS_ROWW) + (size_t)e * CAP;
#pragma unroll
        for (int r = 0; r < 16; ++r) { const int q = (16 * s + r) * 4; if (rec[q] == (unsigned)e) { list[base] = rec[q + 1]; roww[base] = __uint_as_float(rec[q + 2]); ++base; } } }
    __syncthreads();
}

__device__ __forceinline__ int moe_table(LAS unsigned char* lds, const unsigned* cnt, int tid) {
    LAS unsigned* tb = (LAS unsigned*)(lds + TBL_OFF);
    __syncthreads();
    if (tid < NE) tb[tid] = __hip_atomic_load(cnt + tid * 64, RLX_AGENT);
    __syncthreads();
    if (tid < 64) { const int n = tid < NE ? (((int)tb[tid] + 255) >> 8) : 0; int incl = n;
#pragma unroll
        for (int o = 1; o < 32; o <<= 1) { const int t = __shfl_up(incl, o, 64); if (tid >= o) incl += t; }
        if (tid < NE) { int T = incl - n; for (int m = 0; m < n; ++m) tb[64 + T++] = ((unsigned)tid << 16) | (unsigned)m; }
        if (tid == NE - 1) tb[32] = (unsigned)incl; }
    __syncthreads();
    return (int)tb[32];
}

template <bool FINAL, bool SKIPMOE>
__device__ __forceinline__ void combine_ln_phase(const Args& A, int vcu, int G, int wave, int lane, int layer, const bf16_t* X1, const unsigned char* YB, bf16_t* XN, float* OUT, int rp) {
    const float* lng = A.in[I_FFN_LNG] + layer * DM; const float* lnb = A.in[I_FFN_LNB] + layer * DM;
    f32x4 g[4], bb[4];
#pragma unroll
    for (int q = 0; q < 2; ++q) { g[2 * q] = *(const f32x4*)(lng + q * 512 + lane * 8); g[2 * q + 1] = *(const f32x4*)(lng + q * 512 + lane * 8 + 4);
        bb[2 * q] = *(const f32x4*)(lnb + q * 512 + lane * 8); bb[2 * q + 1] = *(const f32x4*)(lnb + q * 512 + lane * 8 + 4); }
#pragma unroll 1
    for (int tok_ = vcu * NWAVES + wave; tok_ < (M << rp); tok_ += G * NWAVES) { const int tok = tok_ & (M - 1);
        u32x4 px[2]; u32x2 py0[2], py1[2];
#pragma unroll
        for (int q = 0; q < 2; ++q) { px[q] = __builtin_nontemporal_load((const u32x4*)(X1 + (size_t)tok * DM + q * 512 + lane * 8));
            if (!SKIPMOE) { py0[q] = __builtin_nontemporal_load((const u32x2*)(YB + (size_t)(2 * tok) * DM + q * 512 + lane * 8)); py1[q] = __builtin_nontemporal_load((const u32x2*)(YB + (size_t)(2 * tok + 1) * DM + q * 512 + lane * 8)); }
            else { py0[q] = (u32x2){0u, 0u}; py1[q] = py0[q]; } }
        f32x4 v[4];
#pragma unroll
        for (int q = 0; q < 2; ++q) {
            v[2 * q] = (f32x4){bflo(px[q].x), bfhi(px[q].x), bflo(px[q].y), bfhi(px[q].y)} * ALPHA + (unpk4_fp8(py0[q].x) + unpk4_fp8(py1[q].x)) * Y8INV;
            v[2 * q + 1] = (f32x4){bflo(px[q].z), bfhi(px[q].z), bflo(px[q].w), bfhi(px[q].w)} * ALPHA + (unpk4_fp8(py0[q].y) + unpk4_fp8(py1[q].y)) * Y8INV; }
        float s = 0.f;
#pragma unroll
        for (int j = 0; j < 4; ++j) s += (v[j][0] + v[j][1]) + (v[j][2] + v[j][3]);
        const float mean = wave_sum(s) * (1.f / DM); float s2 = 0.f;
#pragma unroll
        for (int j = 0; j < 4; ++j) { v[j] = v[j] - mean; s2 += (v[j][0] * v[j][0] + v[j][1] * v[j][1]) + (v[j][2] * v[j][2] + v[j][3] * v[j][3]); }
        const float rstd = 1.0f / sqrtf(wave_sum(s2) * (1.f / DM) + LN_EPS);
#pragma unroll
        for (int j = 0; j < 4; ++j) v[j] = v[j] * rstd * g[j] + bb[j];
        if (FINAL) {
#pragma unroll
            for (int q = 0; q < 2; ++q) { __builtin_nontemporal_store(v[2 * q], (f32x4*)(OUT + (size_t)tok * DM + q * 512 + lane * 8)); __builtin_nontemporal_store(v[2 * q + 1], (f32x4*)(OUT + (size_t)tok * DM + q * 512 + lane * 8 + 4)); }
        } else {
#pragma unroll
            for (int q = 0; q < 2; ++q) *(u32x4*)(XN + (size_t)tok * DM + q * 512 + lane * 8) = pg8::pack8(v[2 * q], v[2 * q + 1]);
        }
    }
}

__device__ __forceinline__ s16x4 tr16(const LAS unsigned char* p) { return __builtin_bit_cast(s16x4, __builtin_amdgcn_ds_read_tr16_b64_v4i16((LAS s16x4*)p)); }
__device__ __forceinline__ int sgu_sw(int row) { return (row & 3) | ((row >> 1) & 4); }
__device__ __forceinline__ void sgu_unit(const Args& A, LAS unsigned char* lds, int wave, int lane, int b, int blk, const bf16_t* H1, bf16_t* U) {
    const size_t row0 = (size_t)b * SEQ + (size_t)blk * 128;
    { const f32x4 g0 = *(const f32x4*)(A.in[I_C_LNG] + lane * 8), g1 = *(const f32x4*)(A.in[I_C_LNG] + lane * 8 + 4), b0 = *(const f32x4*)(A.in[I_C_LNB] + lane * 8), b1 = *(const f32x4*)(A.in[I_C_LNB] + lane * 8 + 4);
      u32x4 pv[16];
#pragma unroll
      for (int jj = 0; jj < 16; ++jj) pv[jj] = __builtin_nontemporal_load((const u32x4*)(H1 + (row0 + wave * 16 + jj) * H1P + 512 + lane * 8));
#pragma unroll
      for (int jj = 0; jj < 16; ++jj) { const int j = wave * 16 + jj; const u32x4 p = pv[jj];
        f32x4 v0 = (f32x4){bflo(p.x), bfhi(p.x), bflo(p.y), bfhi(p.y)}, v1 = (f32x4){bflo(p.z), bfhi(p.z), bflo(p.w), bfhi(p.w)};
        const float mean = wave_sum((v0[0] + v0[1]) + (v0[2] + v0[3]) + (v1[0] + v1[1]) + (v1[2] + v1[3])) * (1.f / 512.f);
        v0 = v0 - mean; v1 = v1 - mean;
        const float var = wave_sum((v0[0] * v0[0] + v0[1] * v0[1]) + (v0[2] * v0[2] + v0[3] * v0[3]) + (v1[0] * v1[0] + v1[1] * v1[1]) + (v1[2] * v1[2] + v1[3] * v1[3])) * (1.f / 512.f);
        const float rstd = 1.0f / sqrtf(var + LN_EPS);
        v0 = v0 * rstd * g0 + b0; v1 = v1 * rstd * g1 + b1;
        *(LAS u32x4*)(lds + j * 1024 + ((lane ^ sgu_sw(j)) << 4)) = pg8::pack8(v0, v1); } }
    __syncthreads();
    { const int h = wave, fr = lane & 15, fq = lane >> 4, q = fr >> 2, p = fr & 3;
      const bf16_t* Wm = (const bf16_t*)(A.ws + WS_SGUW) + (size_t)h * 128 * 128 + (size_t)fr * 128 + 8 * fq;
      const bf16_t* Up = H1 + (row0 + fr) * H1P + h * 64 + 4 * fq;
      bf16x8 wf[4], wn[4]; u32x2 uu[4], un[4]; float bs[8];
#pragma unroll
      for (int it = 0; it < 8; ++it) bs[it] = A.in[I_C_WSB][h * 128 + 16 * it + fr];
#pragma unroll
      for (int kk = 0; kk < 4; ++kk) wf[kk] = *(const bf16x8*)(Wm + 32 * kk);
#pragma unroll
      for (int ct = 0; ct < 4; ++ct) uu[ct] = *(const u32x2*)(Up + 16 * ct);
#pragma unroll
      for (int it = 0; it < 8; ++it) { const int nk = it < 4 ? 2 : 4;
        if (it < 7) {
#pragma unroll
            for (int kk = 0; kk < 4; ++kk) wn[kk] = *(const bf16x8*)(Wm + (size_t)(16 * (it + 1)) * 128 + 32 * kk);
#pragma unroll
            for (int ct = 0; ct < 4; ++ct) un[ct] = *(const u32x2*)(Up + (size_t)(16 * (it + 1)) * H1P + 16 * ct); }
        f32x4 acc[4];
#pragma unroll
        for (int ct = 0; ct < 4; ++ct) acc[ct] = (f32x4){0.f, 0.f, 0.f, 0.f};
#pragma unroll
        for (int kk = 0; kk < 4; ++kk) if (kk < nk) {
#pragma unroll
            for (int ct = 0; ct < 4; ++ct) { const int col = h * 64 + 16 * ct + 4 * p; const int r0 = 32 * kk + 8 * fq + q, r1 = r0 + 4;
                const s16x4 lo = tr16(lds + r0 * 1024 + (((col >> 3) ^ sgu_sw(r0)) << 4) + (col & 7) * 2), hi = tr16(lds + r1 * 1024 + (((col >> 3) ^ sgu_sw(r1)) << 4) + (col & 7) * 2);
                const bf16x8 vf = (bf16x8){lo[0], lo[1], lo[2], lo[3], hi[0], hi[1], hi[2], hi[3]};
                acc[ct] = __builtin_amdgcn_mfma_f32_16x16x32_bf16(vf, wf[kk], acc[ct], 0, 0, 0); } }
        const int i = 16 * it + fr; const float bias = bs[it];
#pragma unroll
        for (int ct = 0; ct < 4; ++ct) { const int c = h * 64 + 16 * ct + 4 * fq;
            const float o0 = bflo(uu[ct].x) * (acc[ct][0] + bias), o1 = bfhi(uu[ct].x) * (acc[ct][1] + bias), o2 = bflo(uu[ct].y) * (acc[ct][2] + bias), o3 = bfhi(uu[ct].y) * (acc[ct][3] + bias);
            *(u32x2*)(U + (row0 + i) * DM + c) = (u32x2){cvt_pk_bf16(o0, o1), cvt_pk_bf16(o2, o3)}; }
#pragma unroll
        for (int kk = 0; kk < 4; ++kk) wf[kk] = wn[kk];
#pragma unroll
        for (int ct = 0; ct < 4; ++ct) uu[ct] = un[ct]; } }
    __syncthreads();
}
__device__ __forceinline__ int crow(int r, int hi) { return (r & 3) + 8 * (r >> 2) + 4 * hi; }
__device__ __forceinline__ void attn_units(const Args& A, LAS unsigned char* lds, int wave, int lane, int tid, int b, int h, int par, int nunits, const bf16_t* H1, bf16_t* U) {
    LAS unsigned char* Kb = lds; LAS unsigned char* Vb = lds + 16384; LAS float* biasL = (LAS float*)(lds + 32768);
    LAS float* wsf = (LAS float*)(lds + 36864) + wave * 64; LAS unsigned char* stg = lds + 40960 + wave * 4096;
    const int r32 = lane & 31, hi = lane >> 5;
    const size_t rowb = (size_t)b * SEQ;
    for (int i = tid; i < 513; i += NTHR) biasL[i] = A.in[I_D_REL][h * 513 + i] * LOG2E;
    const bf16_t* qsrc = H1 + (rowb + (wave >> 1) * 64 + (wave & 1) * 32 + r32) * H1P + 1024 + h * 64 + hi * 8;
    const bf16_t* ksrc = H1 + (rowb + lane) * H1P + 1536 + h * 64 + wave * 8;
    const bf16_t* vsrc = H1 + (rowb + 16 * (wave & 3) + (lane >> 2)) * H1P + 2048 + h * 64 + (wave >> 2) * 32 + (lane & 3) * 8;
    const int kdst = wave * 1024 + lane * 16, vdst = wave * 1024 + lane * 16;
    bf16x8 qr[4], qn[4]; u32x4 kreg, vreg;
    { const int cg0 = par, tl0 = 4 * cg0 - 8 > 0 ? 4 * cg0 - 8 : 0;
#pragma unroll
      for (int d0 = 0; d0 < 4; ++d0) qn[d0] = __builtin_nontemporal_load((const bf16x8*)(qsrc + (size_t)cg0 * 256 * H1P + d0 * 16));
      kreg = *(const u32x4*)(ksrc + (size_t)tl0 * 64 * H1P); vreg = *(const u32x4*)(vsrc + (size_t)tl0 * 64 * H1P); }
#pragma unroll 1
    for (int ui = 0; ui < nunits; ++ui) {
    const int cg = 2 * (ui & 3) + par, n0 = 4 * cg, n = n0 + (wave >> 1), qpos0 = n * 64 + (wave & 1) * 32;
    const int t_lo = n0 - 8 > 0 ? n0 - 8 : 0, t_hi = n0 + 3;
    const int cgn = 2 * ((ui + 1) & 3) + par, tln = 4 * cgn - 8 > 0 ? 4 * cgn - 8 : 0; const bool more = ui + 1 < nunits;
#pragma unroll
    for (int d0 = 0; d0 < 4; ++d0) qr[d0] = qn[d0];
    *(LAS u32x4*)(Kb + kdst) = kreg; *(LAS u32x4*)(Vb + vdst) = vreg;
    __syncthreads();
    float mrun = -1.0e30f, lrun = 0.f; f32x16 o[2];
#pragma unroll
    for (int r = 0; r < 16; ++r) { o[0][r] = 0.f; o[1][r] = 0.f; }
    const int vlane = ((lane >> 4) & 1) * 32 + (lane & 3) * 8 + (4 * hi + ((lane & 15) >> 2)) * 64;
#pragma unroll 1
    for (int t = t_lo; t <= t_hi; ++t) {
        const int buf = (t - t_lo) & 1;
        if (t < t_hi) { kreg = *(const u32x4*)(ksrc + (size_t)(t + 1) * 64 * H1P); vreg = *(const u32x4*)(vsrc + (size_t)(t + 1) * 64 * H1P); }
        else if (more) {
#pragma unroll
            for (int d0 = 0; d0 < 4; ++d0) qn[d0] = __builtin_nontemporal_load((const bf16x8*)(qsrc + (size_t)cgn * 256 * H1P + d0 * 16));
            kreg = *(const u32x4*)(ksrc + (size_t)tln * 64 * H1P); vreg = *(const u32x4*)(vsrc + (size_t)tln * 64 * H1P); }
        if (t >= n - 8 && t <= n) {
            const LAS unsigned char* kb = Kb + buf * 8192 + hi * 1024 + r32 * 16;
            f32x16 p0, p1;
#pragma unroll
            for (int r = 0; r < 16; ++r) { p0[r] = 0.f; p1[r] = 0.f; }
#pragma unroll
            for (int d0 = 0; d0 < 4; ++d0) { const bf16x8 b0 = *(const LAS bf16x8*)(kb + d0 * 2048), b1 = *(const LAS bf16x8*)(kb + d0 * 2048 + 512);
                p0 = __builtin_amdgcn_mfma_f32_32x32x16_bf16(b0, qr[d0], p0, 0, 0, 0); p1 = __builtin_amdgcn_mfma_f32_32x32x16_bf16(b1, qr[d0], p1, 0, 0, 0); }
            const int dbase = (qpos0 + r32) - t * 64;
            float rm = -3.0e38f;
#pragma unroll
            for (int r = 0; r < 16; ++r) { const int d0_ = dbase - crow(r, hi), d1_ = d0_ - 32;
                p0[r] += biasL[(d0_ < 256 ? d0_ : 256) + 256]; p1[r] += biasL[(d1_ < 256 ? d1_ : 256) + 256];
                rm = fmaxf(rm, fmaxf(p0[r], p1[r])); }
            rm = fmaxf(rm, __shfl_xor(rm, 32));
            const float mnew = fmaxf(mrun, rm), f = __builtin_amdgcn_exp2f(mrun - mnew); mrun = mnew;
            float ps = 0.f;
#pragma unroll
            for (int r = 0; r < 16; ++r) { p0[r] = __builtin_amdgcn_exp2f(p0[r] - mnew); p1[r] = __builtin_amdgcn_exp2f(p1[r] - mnew); ps += p0[r] + p1[r]; }
            lrun = lrun * f + ps;
            if (hi == 0) wsf[r32] = f;
            bf16x8 pa[4];
#pragma unroll
            for (int ks = 0; ks < 2; ++ks) { u32x4 w0, w1;
                w0.x = cvt_pk_bf16(p0[8 * ks + 0], p0[8 * ks + 1]); w0.y = cvt_pk_bf16(p0[8 * ks + 2], p0[8 * ks + 3]); w0.z = cvt_pk_bf16(p0[8 * ks + 4], p0[8 * ks + 5]); w0.w = cvt_pk_bf16(p0[8 * ks + 6], p0[8 * ks + 7]);
                w1.x = cvt_pk_bf16(p1[8 * ks + 0], p1[8 * ks + 1]); w1.y = cvt_pk_bf16(p1[8 * ks + 2], p1[8 * ks + 3]); w1.z = cvt_pk_bf16(p1[8 * ks + 4], p1[8 * ks + 5]); w1.w = cvt_pk_bf16(p1[8 * ks + 6], p1[8 * ks + 7]);
                pa[ks] = __builtin_bit_cast(bf16x8, w0); pa[2 + ks] = __builtin_bit_cast(bf16x8, w1); }
#pragma unroll
            for (int r = 0; r < 16; ++r) { const float fr_ = wsf[crow(r, hi)]; o[0][r] *= fr_; o[1][r] *= fr_; }
            const LAS unsigned char* vb = Vb + buf * 8192 + vlane;
#pragma unroll
            for (int dh = 0; dh < 2; ++dh)
#pragma unroll
                for (int ks = 0; ks < 4; ++ks) { const s16x4 lo = tr16(vb + dh * 4096 + ks * 1024), hh = tr16(vb + dh * 4096 + ks * 1024 + 512);
                    const bf16x8 vf = (bf16x8){lo[0], lo[1], lo[2], lo[3], hh[0], hh[1], hh[2], hh[3]};
                    o[dh] = __builtin_amdgcn_mfma_f32_32x32x16_bf16(pa[ks], vf, o[dh], 0, 0, 0); }
        }
        if (t < t_hi) { *(LAS u32x4*)(Kb + (buf ^ 1) * 8192 + kdst) = kreg; *(LAS u32x4*)(Vb + (buf ^ 1) * 8192 + vdst) = vreg; }
        __syncthreads();
    }
    lrun += __shfl_xor(lrun, 32);
    if (hi == 0) wsf[32 + r32] = 1.0f / lrun;
    bf16_t* Ow = U + (rowb + qpos0) * DM + 512 + h * 64;
#pragma unroll
    for (int r = 0; r < 16; ++r) { const int q = crow(r, hi); const float rl = wsf[32 + q];
        *(LAS bf16_t*)(stg + q * 128 + r32 * 2) = (bf16_t)f2bf(o[0][r] * rl); *(LAS bf16_t*)(stg + q * 128 + 64 + r32 * 2) = (bf16_t)f2bf(o[1][r] * rl); }
#pragma unroll
    for (int i = 0; i < 4; ++i) { const int row = i * 8 + (lane >> 3), ch = lane & 7; const u32x4 v = *(const LAS u32x4*)(stg + row * 128 + ch * 16); *(u32x4*)(Ow + (size_t)row * DM + ch * 8) = v; }
    __syncthreads();
    }
}

constexpr int NPHASE = 15;
__global__ void __launch_bounds__(NTHR, 2) hybrid_fwd(Args args) {
    extern __shared__ __attribute__((aligned(16))) unsigned char lds_raw[];
    LAS unsigned char* lds = (LAS unsigned char*)lds_raw;
    volatile LAS unsigned* MISC = (volatile LAS unsigned*)(lds + MISC_OFF);
    const int tid = threadIdx.x, lane = tid & 63, wave = __builtin_amdgcn_readfirstlane(tid >> 6);
    const int G = gridDim.x; const int bx = blockIdx.x; const int vcu = (G % 8 == 0) ? (bx % 8) * (G / 8) + bx / 8 : bx;
    unsigned char* ws = args.ws;
    gu32* ctl = (gu32*)(ws + WS_CTL);
    for (int u = tid; u < (LDS_BYTES - LDSCTL_OFF) / 4; u += NTHR) ((LAS unsigned*)(lds + LDSCTL_OFF))[u] = 0u;
    __syncthreads();
    XcdBarrier bar; bar.bar = (unsigned*)(ctl + CW_BAR); bar.x = 0; bar.st = nullptr;
    if (!MK_PER_PHASE) bar = xcd_barrier_post((unsigned*)(ctl + CW_BAR), MISC + 8);
    const int lo = args.ph_lo, hi = args.ph_hi, dblm = args.dbl;
#define IN(k) (lo <= (k) && (k) < hi)
#define DB(k) ((dblm >> (k)) & 1)
#define SEAM(k) do { if (IN(k) && IN((k) + 1)) { xcd_barrier(bar); if (dblm & 0x8000) xcd_barrier(bar); } } while (0)
    bf16_t* XA = (bf16_t*)(ws + WS_XA); bf16_t* X1 = (bf16_t*)(ws + WS_X1); bf16_t* HB = (bf16_t*)(ws + WS_H);
    bf16_t* U = (bf16_t*)args.out; bf16_t* Z = (bf16_t*)args.out + (size_t)M * DM; unsigned char* YB = ws + WS_H + 64 * MiB;
    unsigned* list = (unsigned*)(ws + WS_LIST); float* roww = (float*)(ws + WS_ROWW);

    if (IN(0)) { p0_prologue(args, lds, vcu, G, wave, lane, tid, DB(0)); } SEAM(0);
    LAS float* biasL = (LAS float*)(lds + TBL_OFF + 4096);
    if (IN(1)) { pg8::StaticOrder S; S.init(M, NIN, DM, ws + WS_WIN0, G, bx, DB(1)); pg8::EpiIn0 E{HB, biasL};
        for (int i = tid; i < NIN; i += NTHR) biasL[i] = ((const float*)(ws + WS_BIASP))[i];
        const int pre = MOE_W_IN_P0 ? 0 : (vcu >> 5) % (MOE_W_SA + 1), tot = MOE_W_IN_P0 ? 0 : MOE_W_SA;
        moe_w_steps(args, lds, 0, vcu, wave, lane, 0, pre); __syncthreads();
        pg8::gemm_phase<pg8::EpiIn0, pg8::StaticOrder, true>(lds, (const char*)XA, DM, S, E);
        moe_w_steps(args, lds, 0, vcu, wave, lane, pre, tot); } SEAM(1);
    if (IN(2)) { conv_phase(args, lds, vcu, G, wave, lane, tid, HB, U, DB(2)); } SEAM(2);
    if (IN(3)) { pg8::StaticOrder S; S.init(M, DM, DM, ws + WS_WOUT0, G, bx, DB(3)); pg8::EpiOut<false, SKIP_MIX0> E{Z, (const void*)XA};
        const int pre = MOE_W_IN_P0 ? 0 : (vcu >> 5) % (7 - MOE_W_SA), tot = MOE_W_IN_P0 ? 0 : 6 - MOE_W_SA;
        moe_w_steps(args, lds, 0, vcu, wave, lane, MOE_W_SA, MOE_W_SA + pre); __syncthreads();
        pg8::gemm_phase<pg8::EpiOut<false, SKIP_MIX0>, pg8::StaticOrder, true>(lds, (const char*)U, DM, S, E);
        moe_w_steps(args, lds, 0, vcu, wave, lane, MOE_W_SA + pre, MOE_W_SA + tot); } SEAM(3);
    if (IN(4)) { router_phase(args, lds, vcu, wave, lane, tid, 0, Z, X1, (unsigned*)(ctl + CW_CNT), DB(4)); } SEAM(4);
    if (IN(5)) { if (!SKIP_MOE0) { const int T = moe_table(lds, (const unsigned*)(ctl + CW_CNT), tid); LAS unsigned* tb = (LAS unsigned*)(lds + TBL_OFF);
        pg8::MoeOrder<true> S{tb + 64, tb, T, G, vcu, DM / 2, (const char*)(ws + WS_WGU), (size_t)DM * DM, list, DB(5)}; pg8::EpiGU E{(unsigned char*)HB};
        pg8::gemm_phase<pg8::EpiGU, pg8::MoeOrder<true>, true, true>(lds, (const char*)(ws + WS_X1Q), DM / 2, S, E);
        if (MOE_W_SLACK) { const int f = slack_first(T); if (f && vcu >= f) moe_w_ids(args, lds, 1, wave, lane, vcu - f, 256 - f, SLACK_K5); } } } SEAM(5);
    if (IN(6)) { if (!SKIP_MOE0) { LAS unsigned* tb = (LAS unsigned*)(lds + TBL_OFF); const int T = MK_PER_PHASE ? moe_table(lds, (const unsigned*)(ctl + CW_CNT), tid) : (int)tb[32];
        pg8::MoeOrder<false> S{tb + 64, tb, T, G, vcu, DE / 2, (const char*)(ws + WS_WD), (size_t)DM * DE, list, DB(6)}; pg8::EpiDown E{YB, list, roww, (LAS unsigned*)(lds + ROUTER_REC_OFF)};
        pg8::gemm_phase<pg8::EpiDown, pg8::MoeOrder<false>, true, true>(lds, (const char*)HB, DE / 2, S, E);
        if (MOE_W_SLACK) { const int f = slack_first(T); if (f && vcu >= f) moe_w_ids(args, lds, 1, wave, lane, (256 - f) * SLACK_K5 + vcu - f, 256 - f, SLACK_K6); } } } SEAM(6);
    if (IN(7)) { combine_ln_phase<false, SKIP_MOE0>(args, vcu, G, wave, lane, 0, X1, YB, XA, nullptr, DB(7)); } SEAM(7);
    if (IN(8)) { pg8::StaticOrder S; S.init(M, NIN, DM, ws + WS_WIN1, G, bx, DB(8)); pg8::EpiIn1 E{HB, biasL};
        for (int i = tid; i < NIN; i += NTHR) biasL[i] = args.in[I_CD_BIN][i];
        const int T0 = MK_PER_PHASE ? moe_table(lds, (const unsigned*)(ctl + CW_CNT), tid) : (int)((LAS unsigned*)(lds + TBL_OFF))[32];
        const int D = (MOE_W_SLACK && !SKIP_MOE0) ? slack_done(T0) : 0;
        pg8::gemm_phase<pg8::EpiIn1, pg8::StaticOrder, true>(lds, (const char*)XA, DM, S, E);
        moe_w_ids(args, lds, 1, wave, lane, D + vcu, 256, MOE_W_SA); } SEAM(8);
    if (IN(9)) { if (!SKIP_MIX1) {
        for (int un = vcu; un < ((BATCH * 16) << DB(9)); un += G) sgu_unit(args, lds, wave, lane, (un >> 4) & 15, un & 15, HB, U);
        { const int pr = vcu >> 1; if (pr < BATCH * 8) attn_units(args, lds, wave, lane, tid, pr >> 3, pr & 7, vcu & 1, 4 << DB(9), HB, U); } } } SEAM(9);
    if (IN(10)) { pg8::StaticOrder S; S.init(M, DM, DM, ws + WS_WOUT1, G, bx, DB(10)); pg8::EpiOut<false, SKIP_MIX1> E{Z, (const void*)XA};
        const int T0 = MK_PER_PHASE ? moe_table(lds, (const unsigned*)(ctl + CW_CNT), tid) : (int)((LAS unsigned*)(lds + TBL_OFF))[32];
        const int D = (MOE_W_SLACK && !SKIP_MOE0) ? slack_done(T0) : 0;
        pg8::gemm_phase<pg8::EpiOut<false, SKIP_MIX1>, pg8::StaticOrder, true>(lds, (const char*)U, DM, S, E);
        moe_w_ids(args, lds, 1, wave, lane, D + vcu + 256 * MOE_W_SA, 256, 6 - MOE_W_SA); } SEAM(10);
    if (IN(11)) { router_phase(args, lds, vcu, wave, lane, tid, 1, Z, X1, (unsigned*)(ctl + CW_CNT) + 32 * 64, DB(11)); } SEAM(11);
    if (IN(12)) { if (!SKIP_MOE1) { const int T = moe_table(lds, (const unsigned*)(ctl + CW_CNT) + 32 * 64, tid); LAS unsigned* tb = (LAS unsigned*)(lds + TBL_OFF);
        pg8::MoeOrder<true> S{tb + 64, tb, T, G, vcu, DM / 2, (const char*)(ws + WS_WGU) + (size_t)NE * DM * DM, (size_t)DM * DM, list, DB(12)}; pg8::EpiGU E{(unsigned char*)HB};
        pg8::gemm_phase<pg8::EpiGU, pg8::MoeOrder<true>, true, true>(lds, (const char*)(ws + WS_X1Q), DM / 2, S, E); } } SEAM(12);
    if (IN(13)) { if (!SKIP_MOE1) { LAS unsigned* tb = (LAS unsigned*)(lds + TBL_OFF); const int T = MK_PER_PHASE ? moe_table(lds, (const unsigned*)(ctl + CW_CNT) + 32 * 64, tid) : (int)tb[32];
        pg8::MoeOrder<false> S{tb + 64, tb, T, G, vcu, DE / 2, (const char*)(ws + WS_WD) + (size_t)NE * DM * DE, (size_t)DM * DE, list, DB(13)}; pg8::EpiDown E{YB, list, roww, (LAS unsigned*)(lds + ROUTER_REC_OFF)};
        pg8::gemm_phase<pg8::EpiDown, pg8::MoeOrder<false>, true, true>(lds, (const char*)HB, DE / 2, S, E); } } SEAM(13);
    if (IN(14)) { combine_ln_phase<true, SKIP_MOE1>(args, vcu, G, wave, lane, 1, X1, YB, nullptr, args.out, 0); }
#undef IN
#undef SEAM
}

extern "C" void kernel_launch(void* const* d_in, const int* in_sizes, int n_in, void* d_out, int out_size, void* d_ws, size_t ws_size, hipStream_t stream) {
    static int grid = 0;
    if (grid == 0) {
        if (n_in != 28 || in_sizes[0] != M * DM || out_size != M * DM || ws_size < WS_END) { fprintf(stderr, "kernel_launch: unexpected shapes / workspace (n_in %d, ws %zu); nothing launched\n", n_in, ws_size); grid = -1; return; }
        int dev = 0, cus = 0;
        if (hipGetDevice(&dev) != hipSuccess || hipDeviceGetAttribute(&cus, hipDeviceAttributeMultiprocessorCount, dev) != hipSuccess) { grid = -1; return; }
        if (hipFuncSetAttribute((const void*)hybrid_fwd, hipFuncAttributeMaxDynamicSharedMemorySize, LDS_BYTES) != hipSuccess) { fprintf(stderr, "kernel_launch: hipFuncSetAttribute failed\n"); grid = -1; return; }
        (void)hipGetLastError();
        grid = cus;
        if (grid != 256) { fprintf(stderr, "kernel_launch: built for 256 CUs, device has %d\n", cus); grid = -1; return; }
    }
    if (grid < 0) return;
    if (hipMemsetAsync((char*)d_ws + WS_CTL, 0, CTL_ZERO_BYTES, stream) != hipSuccess) return;
    Args a{};
    for (int i = 0; i < 28; ++i) a.in[i] = (const float*)d_in[i];
    a.out = (float*)d_out; a.ws = (unsigned char*)d_ws; a.dbl = DBL_MASK;
#if MK_PER_PHASE
    for (int p = 0; p < NPHASE; ++p) { a.ph_lo = p; a.ph_hi = p + 1; hipLaunchKernelGGL(hybrid_fwd, dim3(grid), dim3(NTHR), LDS_BYTES, stream, a); }
#else
    a.ph_lo = 0; a.ph_hi = NPHASE; hipLaunchKernelGGL(hybrid_fwd, dim3(grid), dim3(NTHR), LDS_BYTES, stream, a);
#ifdef EXTRA_PHASE
    a.ph_lo = EXTRA_PHASE; a.ph_hi = EXTRA_PHASE + 1; hipLaunchKernelGGL(hybrid_fwd, dim3(grid), dim3(NTHR), LDS_BYTES, stream, a);
#endif
#endif
}
```

```cpp
#include <hip/hip_runtime.h>
#include <cstdio>
#include <cstdint>

#ifndef MK_PER_PHASE
#define MK_PER_PHASE 0
#endif
#ifndef SKIP_MIX0
#define SKIP_MIX0 0
#endif
#ifndef SKIP_MOE0
#define SKIP_MOE0 0
#endif
#ifndef SKIP_MIX1
#define SKIP_MIX1 0
#endif
#ifndef SKIP_MOE1
#define SKIP_MOE1 0
#endif

#ifndef MOE_W_IN_P0
#define MOE_W_IN_P0 0
#endif
#ifndef MOE_W_SLACK
#define MOE_W_SLACK 1
#endif
#ifndef MOE_W_SA
#define MOE_W_SA 4
#endif
#ifndef DBL_MASK
#define DBL_MASK 0
#endif
#define GAS __attribute__((address_space(1)))
#define LAS __attribute__((address_space(3)))
typedef unsigned short bf16_t;
typedef short bf16x8 __attribute__((ext_vector_type(8)));
typedef short s16x4 __attribute__((ext_vector_type(4)));
typedef float f32x2 __attribute__((ext_vector_type(2)));
typedef float f32x4 __attribute__((ext_vector_type(4)));
typedef float f32x16 __attribute__((ext_vector_type(16)));
typedef unsigned u32x2 __attribute__((ext_vector_type(2)));
typedef unsigned u32x4 __attribute__((ext_vector_type(4)));
typedef GAS unsigned gu32;

constexpr int BATCH = 16, SEQ = 2048, DM = 1024, M = BATCH * SEQ;
constexpr int NIN = 2560;
constexpr int NE = 32, DE = 512, CAP = 32768;
constexpr int H0P = 1536, H1P = 2560;
constexpr float LN_EPS = 1e-5f, ALPHA = 1.4142135623730951f, LOG2E = 1.4426950408889634f;
constexpr float QSCALE = 0.125f * LOG2E;
constexpr int NWAVES = 8, NTHR = 512;

constexpr size_t MiB = 1u << 20;
constexpr size_t WS_CTL = 0, CTL_ZERO_BYTES = 128 * 1024;
constexpr size_t WS_BIASP = 1 * MiB;
constexpr size_t WS_WR = 1 * MiB + 64 * 1024;
constexpr size_t WS_SGUW = 1 * MiB + 512 * 1024;
constexpr size_t WS_LIST = 2 * MiB;
constexpr size_t WS_ROWW = 6 * MiB;
constexpr size_t WS_WIN0 = 10 * MiB, WS_WIN1 = 15 * MiB, WS_WOUT0 = 20 * MiB, WS_WOUT1 = 22 * MiB;
constexpr size_t WS_WGU = 24 * MiB;
constexpr size_t WS_WD = 88 * MiB;
constexpr size_t WS_X1Q = 120 * MiB;
constexpr size_t WS_XA = 216 * MiB;
constexpr size_t WS_X1 = 280 * MiB;
constexpr size_t WS_H = 344 * MiB;
constexpr size_t WS_END = 504 * MiB;

constexpr int CW_TMO = 0, CW_CODE = 1;
constexpr int CW_BAR = 4096;
constexpr int CW_CNT = 16384;
static_assert((size_t)(CW_CNT + 2 * 32 * 64) * 4 <= CTL_ZERO_BYTES && (size_t)(CW_BAR + 3456) * 4 <= CTL_ZERO_BYTES, "control words inside the per-call memset");

constexpr int RING_BYTES = 131072;
constexpr int LDSCTL_OFF = RING_BYTES, MISC_OFF = LDSCTL_OFF + 320;
constexpr int TBL_OFF = RING_BYTES + 1024;
constexpr int ROUTER_REC_OFF = TBL_OFF + 2048;
constexpr int LDS_BYTES = 147456;
static_assert(ROUTER_REC_OFF + 4096 <= 147456 && TBL_OFF + 4096 + 2560 * 4 <= 147456, "LDS map");

#define RLX_AGENT __ATOMIC_RELAXED, __HIP_MEMORY_SCOPE_AGENT
#define LDS_WAIT() asm volatile("s_waitcnt lgkmcnt(0)" ::: "memory")
#define VM_WAIT() asm volatile("s_waitcnt vmcnt(0)" ::: "memory")
__device__ __forceinline__ unsigned f2bf(float f) { unsigned u = __builtin_bit_cast(unsigned, f); return (u + 0x7fffu + ((u >> 16) & 1u)) >> 16; }
__device__ __forceinline__ unsigned pk2(float lo, float hi) { return f2bf(lo) | (f2bf(hi) << 16); }
typedef __bf16 bf16x2_n __attribute__((ext_vector_type(2)));
__device__ __forceinline__ unsigned cvt_pk_bf16(float lo, float hi) { const f32x2 v = {lo, hi}; const bf16x2_n b = __builtin_convertvector(v, bf16x2_n); return __builtin_bit_cast(unsigned, b); }
__device__ __forceinline__ float bflo(unsigned w) { return __uint_as_float(w << 16); }
__device__ __forceinline__ float bfhi(unsigned w) { return __uint_as_float(w & 0xffff0000u); }
template <int CTRL> __device__ __forceinline__ float dpp_f(float v) { return __builtin_bit_cast(float, __builtin_amdgcn_update_dpp(0, __builtin_bit_cast(int, v), CTRL, 0xF, 0xF, true)); }
__device__ __forceinline__ float wave_sum(float v) {
    v += dpp_f<0xB1>(v); v += dpp_f<0x4E>(v); v += dpp_f<0x141>(v); v += dpp_f<0x140>(v);
    const int vi = __builtin_bit_cast(int, v);
    const float s0 = __builtin_bit_cast(float, __builtin_amdgcn_readlane(vi, 0)), s1 = __builtin_bit_cast(float, __builtin_amdgcn_readlane(vi, 16)),
                s2 = __builtin_bit_cast(float, __builtin_amdgcn_readlane(vi, 32)), s3 = __builtin_bit_cast(float, __builtin_amdgcn_readlane(vi, 48));
    return (s0 + s1) + (s2 + s3);
}
typedef int i32x4 __attribute__((ext_vector_type(4)));
typedef int i32x8 __attribute__((ext_vector_type(8)));
constexpr float W8SCALE = 32.0f, W8INV = 1.0f / 32.0f;
__device__ __forceinline__ float clamp8(float v) { return __builtin_fminf(__builtin_fmaxf(v, -448.0f), 448.0f); }
__device__ __forceinline__ unsigned pk4_fp8(float a, float b, float c, float d) { int w = 0; w = __builtin_amdgcn_cvt_pk_fp8_f32(clamp8(a), clamp8(b), w, false); w = __builtin_amdgcn_cvt_pk_fp8_f32(clamp8(c), clamp8(d), w, true); return (unsigned)w; }
__device__ __forceinline__ f32x4 unpk4_fp8(unsigned w) { const f32x2 lo = __builtin_amdgcn_cvt_pk_f32_fp8((int)w, false), hi = __builtin_amdgcn_cvt_pk_f32_fp8((int)w, true); return (f32x4){lo[0], lo[1], hi[0], hi[1]}; }
constexpr float Y8SCALE = 64.0f, Y8INV = 1.0f / 64.0f;
__device__ __forceinline__ float fast_sigmoid(float x) { return __builtin_amdgcn_rcpf(1.0f + __builtin_amdgcn_exp2f(-x * LOG2E)); }

namespace pg8 {
constexpr int BM = 256, BK = 64, HALF = 128, HTB = HALF * BK * 2, STAGE_BYTES = 8 * HTB, NXCD = 8, WGM = 8;
__host__ __device__ __forceinline__ int lds_byte(int r, int c) { const int st = (r >> 4) * 2 + (c >> 5), rr = r & 15, cc = c & 31, ob = rr * 64 + cc * 2; return st * 1024 + (ob ^ (((ob >> 9) & 1) << 5)); }
__host__ __device__ __forceinline__ void stage_rc(int b, int& R, int& C) { const int st = b / 1024, sb = b % 1024, swz = sb ^ (((sb >> 9) & 1) << 5); R = (st >> 1) * 16 + swz / 64; C = (st & 1) * 32 + (swz % 64) / 2; }
__host__ __device__ __forceinline__ int perm32(int rho) { const int n = rho >> 4, i = rho & 15; return 8 * (i >> 2) + 4 * n + (i & 3); }

struct Unit {
    int pm, pn;
    size_t aoff;
    unsigned lbase;
    int nvalid;
    const char* B;
    int slot;
};

struct StaticOrder {
    static constexpr bool GATHER = false;
    int nM, nN, nwg, G, c, K, dsh; const char* Bt; const unsigned* list;
    __device__ void init(int Mrows, int N, int K_, const void* Bt_, int G_, int c_, int dsh_) { nM = Mrows / BM; nN = N / BM; nwg = nM * nN; G = G_; c = c_; K = K_; Bt = (const char*)Bt_; list = nullptr; dsh = dsh_; }
    __device__ __forceinline__ bool next(int i, Unit& u) const {
        const int nmine = (nwg - c + G - 1) / G; if (i >= (nmine << dsh)) return false; const long L = (long)(i >= nmine ? i - nmine : i) * G + c;
        int wgid = (int)L; { const int q = nwg / NXCD, r = nwg % NXCD, xcd = wgid % NXCD, off = wgid / NXCD; wgid = (xcd < r ? xcd * (q + 1) : r * (q + 1) + (xcd - r) * q) + off; }
        const int nig = WGM * nN, gid = wgid / nig, fm = gid * WGM, gsz = (nM - fm) < WGM ? (nM - fm) : WGM;
        u.pm = fm + ((wgid % nig) % gsz); u.pn = (wgid % nig) / gsz;
        u.aoff = (size_t)u.pm * BM * K * 2; u.B = Bt + (size_t)u.pn * BM * K * 2; u.lbase = 0; u.nvalid = BM; return true;
    }
};
template <bool GATHER_> struct MoeOrder {
    static constexpr bool GATHER = GATHER_;
    const LAS unsigned* tinfo; const LAS unsigned* cntl; int ntiles, G, c, K; const char* Bbase; size_t per_expert; const unsigned* list; int dsh;
    __device__ __forceinline__ bool next(int i, Unit& u) const {
        const int nmine = (ntiles * 4 - c + G - 1) / G; if (i >= (nmine << dsh)) return false; const int L = (i >= nmine ? i - nmine : i) * G + c;
        const int tile = L >> 2; const unsigned ti = tinfo[tile]; const int e = (int)(ti >> 16), mt = (int)(ti & 0xffffu);
        u.pm = tile; u.pn = L & 3; u.aoff = (size_t)tile * BM * K * 2; u.lbase = (unsigned)(e * CAP + mt * BM);
        const int left = (int)cntl[e] - mt * BM; u.nvalid = left < BM ? left : BM;
        u.B = Bbase + (size_t)e * per_expert + (size_t)u.pn * BM * K * 2; return true;
    }
};

#define PG8_EPI_ARGS const f32x4 (&acc)[2][2][4][2], const Unit& u, int wr, int wc, int fr, int fq

template <class Epi, class Sched, bool ALIGN_EPI, bool F8 = false>
__device__ __forceinline__ void gemm_phase(LAS unsigned char* lds, const char* Abase, const int K, const Sched& S, const Epi& E) {
    const int tid = threadIdx.x, wid = __builtin_amdgcn_readfirstlane(tid >> 6), lane = tid & 63, wr = wid >> 2, wc = wid & 3, fr = lane & 15, fq = lane >> 4;
    const int nt = K / BK;
    unsigned voffA[2], voffB[2]; int RA[2]; unsigned CA2[2];
#pragma unroll
    for (int i = 0; i < 2; ++i) { int R, C; stage_rc(tid * 16 + i * 8192, R, C);
        const int Rb = Epi::BJ8 ? (64 * (R >> 5) + 16 * ((R & 15) >> 2) + 4 * ((R >> 4) & 1) + (R & 3)) : Epi::PERM ? ((R & ~31) + perm32(R & 31)) : R;
        voffA[i] = (unsigned)(R * K + C) * 2u; voffB[i] = (unsigned)(Rb * K + C) * 2u; RA[i] = R; CA2[i] = (unsigned)C * 2u; }
    const size_t kstep = (size_t)(BK * 2);
    const size_t hstep = (size_t)HALF * K * 2, hstepB = Epi::BJ8 ? (size_t)8 * K * 2 : hstep;
    const unsigned ldsw = (unsigned)wid * 1024u;
    const int c8 = (fq >> 1) * 32 + fq * 8;
    const int aoff = F8 ? lds_byte(wr * 64 + fr, c8) : lds_byte(wr * 64 + fr, fq * 8), boff = F8 ? lds_byte(wc * 32 + fr, c8) : lds_byte(wc * 32 + fr, fq * 8);
    const int aoffh = aoff ^ 32, boffh = boff ^ 32;

#define PG8_SA(b, h) (((b) * 2 + (h)) * HTB)
#define PG8_SB(b, h) ((4 + (b) * 2 + (h)) * HTB)
#define PG8_STAGE(bufoff, gbase, voff) do { _Pragma("unroll") for (int _i = 0; _i < 2; ++_i) \
        __builtin_amdgcn_global_load_lds((const unsigned*)((const char*)(gbase) + (voff)[_i]), (LAS unsigned*)(lds + (bufoff) + ldsw + _i * 8192), 16, 0, 0); } while (0)
#define PG8_STAGE_A(bufoff, h, pd, go, kb) do { if constexpr (Sched::GATHER) { PG8_STAGE(bufoff, Abase + (kb), go[h]); } else { PG8_STAGE(bufoff, (pd) + (h) * hstep, voffA); } } while (0)
#define PG8_LDA(dst, b, h) do { if constexpr (F8) { _Pragma("unroll") for (int m = 0; m < 4; ++m) { dst##8[m].lo = *(const LAS i32x4*)(lds + PG8_SA(b, h) + aoff + m * 2048); dst##8[m].hi = *(const LAS i32x4*)(lds + PG8_SA(b, h) + aoffh + m * 2048); } } \
        else { _Pragma("unroll") for (int m = 0; m < 4; ++m) _Pragma("unroll") for (int k = 0; k < 2; ++k) dst[m][k] = *(const LAS bf16x8*)(lds + PG8_SA(b, h) + aoff + m * 2048 + k * 1024); } } while (0)
#define PG8_LDB(dst, b, h) do { if constexpr (F8) { _Pragma("unroll") for (int n = 0; n < 2; ++n) { dst##8[n].lo = *(const LAS i32x4*)(lds + PG8_SB(b, h) + boff + n * 2048); dst##8[n].hi = *(const LAS i32x4*)(lds + PG8_SB(b, h) + boffh + n * 2048); } } \
        else { _Pragma("unroll") for (int n = 0; n < 2; ++n) _Pragma("unroll") for (int k = 0; k < 2; ++k) dst[n][k] = *(const LAS bf16x8*)(lds + PG8_SB(b, h) + boff + n * 2048 + k * 1024); } } while (0)
#define PG8_MMA(ai, bj, At, Bt) do { __builtin_amdgcn_s_setprio(1); if constexpr (F8) { _Pragma("unroll") for (int m = 0; m < 4; ++m) _Pragma("unroll") for (int n = 0; n < 2; ++n) \
        asm volatile("v_mfma_scale_f32_16x16x128_f8f6f4 %0, %1, %2, %0, %3, %3 op_sel_hi:[0,0,0]" : "+v"(acc[ai][bj][m][n]) : "v"(Bt##8[n]), "v"(At##8[m]), "v"(sc8)); } else { \
        _Pragma("unroll") for (int m = 0; m < 4; ++m) _Pragma("unroll") for (int n = 0; n < 2; ++n) _Pragma("unroll") for (int k = 0; k < 2; ++k) \
        acc[ai][bj][m][n] = __builtin_amdgcn_mfma_f32_16x16x32_bf16(Bt[n][k], At[m][k], acc[ai][bj][m][n], 0, 0, 0); } __builtin_amdgcn_s_setprio(0); } while (0)
#define PG8_WAIT_V(n) asm volatile("s_waitcnt vmcnt(" #n ")" ::: "memory")
#define PG8_WAIT_L(n) asm volatile("s_waitcnt lgkmcnt(" #n ")" ::: "memory")
#define PG8_BAR __builtin_amdgcn_s_barrier()
#define PG8_SCHED __builtin_amdgcn_sched_barrier(0)
#define PG8_GOFF(dst, uu) do { _Pragma("unroll") for (int _h = 0; _h < 2; ++_h) _Pragma("unroll") for (int _i = 0; _i < 2; ++_i) { \
        int _r = _h * HALF + RA[_i]; _r = _r < (uu).nvalid ? _r : 0; const unsigned _e = S.list[(uu).lbase + _r]; dst[_h][_i] = (_e >> 1) * (unsigned)(K * 2) + CA2[_i]; } } while (0)
    Unit cur, nxt; int ui = 0;
    if (!S.next(0, cur)) return;
    f32x4 acc[2][2][4][2];
#pragma unroll
    for (int a = 0; a < 2; ++a)
#pragma unroll
        for (int b = 0; b < 2; ++b)
#pragma unroll
            for (int m = 0; m < 4; ++m)
#pragma unroll
                for (int n = 0; n < 2; ++n) { acc[a][b][m][n] = (f32x4){0.f, 0.f, 0.f, 0.f}; }
    bf16x8 At[4][2], B0[2][2], B1[2][2];
    i32x8 At8[4], B08[2], B18[2];
    int sc8 = 0x7F7F7F7F; asm volatile("" : "+v"(sc8));
    unsigned goff[2][2] = {{0u, 0u}, {0u, 0u}}, goffn[2][2] = {{0u, 0u}, {0u, 0u}}, eraw[2][2] = {{0u, 0u}, {0u, 0u}};
#define PG8_ERAW(dst, uu) do { _Pragma("unroll") for (int _h = 0; _h < 2; ++_h) _Pragma("unroll") for (int _i = 0; _i < 2; ++_i) { \
        int _r = _h * HALF + RA[_i]; _r = _r < (uu).nvalid ? _r : 0; dst[_h][_i] = S.list[(uu).lbase + _r]; } } while (0)
#define PG8_ECONV(dst, src) do { _Pragma("unroll") for (int _h = 0; _h < 2; ++_h) _Pragma("unroll") for (int _i = 0; _i < 2; ++_i) dst[_h][_i] = (src[_h][_i] >> 1) * (unsigned)(K * 2) + CA2[_i]; } while (0)
    LAS unsigned* lrow = (LAS unsigned*)(lds + ROUTER_REC_OFF);
    if constexpr (Sched::GATHER) { PG8_ERAW(eraw, cur); PG8_ECONV(goff, eraw); }
    const char* cA = Abase + cur.aoff; const char* cB = cur.B;
    cur.slot = 0; E.stage(cur, wid, lane);
    PG8_STAGE(PG8_SB(0, 0), cB, voffB); PG8_STAGE(PG8_SB(0, 1), cB + hstepB, voffB); PG8_STAGE_A(PG8_SA(0, 0), 0, cA, goff, 0); PG8_STAGE_A(PG8_SA(0, 1), 1, cA, goff, 0);
    if (wr == 1) PG8_BAR;
    PG8_WAIT_V(2); PG8_BAR;
    PG8_STAGE(PG8_SB(1, 0), cB + kstep, voffB); PG8_STAGE_A(PG8_SA(1, 0), 0, cA + kstep, goff, kstep); PG8_STAGE(PG8_SB(1, 1), cB + hstepB + kstep, voffB);
    PG8_WAIT_V(6); PG8_BAR;
    for (;;) {
        const bool has_next = S.next(ui + 1, nxt);
        const char* nA = has_next ? Abase + nxt.aoff : cA; const char* nB = has_next ? nxt.B : cB;
        if constexpr (Sched::GATHER) { if (has_next && wid < 4) __builtin_amdgcn_global_load_lds((const unsigned*)(S.list + nxt.lbase + wid * 64 + lane), (LAS unsigned*)(lrow + wid * 64), 4, 0, 0); }
#pragma unroll 1
        for (int t = 0; t < nt; t += 2) {
            const bool last = (t == nt - 2);
            const char* a1 = cA + (size_t)(t + 1) * kstep;
            const char* a2 = last ? nA : cA + (size_t)(t + 2) * kstep; const char* b2 = last ? nB : cB + (size_t)(t + 2) * kstep;
            const char* a3 = a2 + kstep; const char* b3 = b2 + kstep;
            const size_t k1 = (size_t)(t + 1) * kstep, k2 = last ? (size_t)0 : (size_t)(t + 2) * kstep, k3 = k2 + kstep;
            if constexpr (Sched::GATHER) { if (last) {
                if (has_next) { unsigned et[2][2];
#pragma unroll
                    for (int h = 0; h < 2; ++h)
#pragma unroll
                        for (int i = 0; i < 2; ++i) { int r = h * HALF + RA[i]; r = r < nxt.nvalid ? r : 0; asm volatile("" : "+v"(r)); et[h][i] = lrow[r]; }
                    PG8_ECONV(goffn, et); }
                else {
#pragma unroll
                    for (int h = 0; h < 2; ++h) { goffn[h][0] = goff[h][0]; goffn[h][1] = goff[h][1]; } } } }
            unsigned gsel[2][2];
#pragma unroll
            for (int h = 0; h < 2; ++h) { gsel[h][0] = last ? goffn[h][0] : goff[h][0]; gsel[h][1] = last ? goffn[h][1] : goff[h][1]; }
            PG8_LDB(B0, 0, 0); PG8_LDB(B1, 0, 1); PG8_SCHED; PG8_LDA(At, 0, 0); PG8_STAGE_A(PG8_SA(1, 1), 1, a1, goff, k1);
            PG8_WAIT_V(8); PG8_WAIT_L(0); PG8_BAR; PG8_MMA(0, 0, At, B0); PG8_MMA(0, 1, At, B1); PG8_BAR; PG8_SCHED;
            PG8_LDA(At, 0, 1); PG8_STAGE(PG8_SB(0, 0), b2, voffB); PG8_STAGE(PG8_SB(0, 1), b2 + hstepB, voffB); PG8_STAGE_A(PG8_SA(0, 0), 0, a2, gsel, k2);
            PG8_WAIT_V(8); PG8_WAIT_L(0); PG8_BAR; PG8_MMA(1, 0, At, B0); PG8_MMA(1, 1, At, B1); PG8_BAR; PG8_SCHED;
            PG8_LDB(B0, 1, 0); PG8_LDB(B1, 1, 1); PG8_SCHED; PG8_LDA(At, 1, 0); PG8_STAGE_A(PG8_SA(0, 1), 1, a2, gsel, k2);
            PG8_WAIT_V(8); PG8_WAIT_L(0); PG8_BAR; PG8_MMA(0, 0, At, B0); PG8_MMA(0, 1, At, B1); PG8_BAR; PG8_SCHED;
            PG8_LDA(At, 1, 1); PG8_STAGE(PG8_SB(1, 0), b3, voffB); PG8_STAGE(PG8_SB(1, 1), b3 + hstepB, voffB); PG8_STAGE_A(PG8_SA(1, 0), 0, a3, gsel, k3);
            PG8_WAIT_V(8); PG8_WAIT_L(0); PG8_BAR; PG8_MMA(1, 0, At, B0); PG8_MMA(1, 1, At, B1); PG8_BAR; PG8_SCHED;
        }
        if constexpr (ALIGN_EPI) { if (wr == 0) PG8_BAR; }
        if constexpr (F8) asm volatile("s_nop 15\n\ts_nop 15" ::: "memory");
        E(acc, cur, wr, wc, fr, fq);
        if (!has_next) break;
#pragma unroll
        for (int a = 0; a < 2; ++a)
#pragma unroll
            for (int b = 0; b < 2; ++b)
#pragma unroll
                for (int m = 0; m < 4; ++m)
#pragma unroll
                    for (int n = 0; n < 2; ++n) { acc[a][b][m][n] = (f32x4){0.f, 0.f, 0.f, 0.f}; }
        cur = nxt; cA = nA; cB = nB; ++ui;
        cur.slot = ui & 1; E.stage(cur, wid, lane);
#pragma unroll
        for (int h = 0; h < 2; ++h) { goff[h][0] = goffn[h][0]; goff[h][1] = goffn[h][1]; }
        if constexpr (ALIGN_EPI) { if (wr == 1) PG8_BAR; }
    }
    PG8_WAIT_V(0);
    if constexpr (!ALIGN_EPI) { if (wr == 0) PG8_BAR; }
    PG8_BAR;
#undef PG8_SA
#undef PG8_SB
#undef PG8_STAGE
#undef PG8_STAGE_A
#undef PG8_LDA
#undef PG8_LDB
#undef PG8_MMA
#undef PG8_WAIT_V
#undef PG8_WAIT_L
#undef PG8_BAR
#undef PG8_SCHED
#undef PG8_GOFF
#undef PG8_ERAW
#undef PG8_ECONV
}

__device__ __forceinline__ u32x4 pack8(const f32x4 v0, const f32x4 v1) { u32x4 w; w.x = cvt_pk_bf16(v0[0], v0[1]); w.y = cvt_pk_bf16(v0[2], v0[3]); w.z = cvt_pk_bf16(v1[0], v1[1]); w.w = cvt_pk_bf16(v1[2], v1[3]); return w; }
__device__ __forceinline__ f32x4 sigm4(const f32x4 g) { return (f32x4){fast_sigmoid(g[0]), fast_sigmoid(g[1]), fast_sigmoid(g[2]), fast_sigmoid(g[3])}; }

struct EpiIn0 {
    static constexpr bool PERM = true, BJ8 = false;
    bf16_t* H; const LAS float* biasp;
    __device__ __forceinline__ void stage(const Unit&, int, int) const {}
    __device__ __forceinline__ void operator()(PG8_EPI_ARGS) const {
        const int row0 = u.pm * BM + wr * 64 + fr, cin = wc * 32 + 8 * fq, pn = u.pn;
        f32x4 bv[2][2];
#pragma unroll
        for (int bj = 0; bj < 2; ++bj)
#pragma unroll
            for (int n = 0; n < 2; ++n) bv[bj][n] = *(const LAS f32x4*)(biasp + pn * BM + bj * HALF + cin + 4 * n);
        if (pn == 4 || pn == 5) {
            const int oc = 512 + (pn - 4) * 256 + cin;
#pragma unroll
            for (int ai = 0; ai < 2; ++ai)
#pragma unroll
                for (int m = 0; m < 4; ++m) { bf16_t* rowp = H + (size_t)(row0 + ai * HALF + m * 16) * H0P + oc;
#pragma unroll
                    for (int bj = 0; bj < 2; ++bj) *(u32x4*)(rowp + bj * HALF) = pack8(acc[ai][bj][m][0] + bv[bj][0], acc[ai][bj][m][1] + bv[bj][1]); }
        } else {
            const bool glu = pn < 4; const int oc = glu ? pn * 128 + cin : 1024 + (pn - 6) * 128 + cin;
#pragma unroll
            for (int ai = 0; ai < 2; ++ai)
#pragma unroll
                for (int m = 0; m < 4; ++m) { bf16_t* rowp = H + (size_t)(row0 + ai * HALF + m * 16) * H0P + oc;
                    const f32x4 a0 = acc[ai][0][m][0] + bv[0][0], a1 = acc[ai][0][m][1] + bv[0][1]; f32x4 g0 = acc[ai][1][m][0] + bv[1][0], g1 = acc[ai][1][m][1] + bv[1][1];
                    if (glu) { g0 = sigm4(g0); g1 = sigm4(g1); }
                    *(u32x4*)rowp = pack8(a0 * g0, a1 * g1); }
        }
    }
};
struct EpiIn1 {
    static constexpr bool PERM = true, BJ8 = true;
    bf16_t* H; const LAS float* bias;
    __device__ __forceinline__ void stage(const Unit&, int, int) const {}
    __device__ __forceinline__ void operator()(PG8_EPI_ARGS) const {
        const int row0 = u.pm * BM + wr * 64 + fr, col0 = u.pn * BM + wc * 64 + 16 * fq; const float sc = (u.pn == 4 || u.pn == 5) ? QSCALE : 1.0f;
        f32x4 bv[2][2];
#pragma unroll
        for (int bj = 0; bj < 2; ++bj)
#pragma unroll
            for (int n = 0; n < 2; ++n) bv[bj][n] = *(const LAS f32x4*)(bias + col0 + bj * 8 + 4 * n);
#pragma unroll
        for (int ai = 0; ai < 2; ++ai)
#pragma unroll
            for (int m = 0; m < 4; ++m) { bf16_t* rowp = H + (size_t)(row0 + ai * HALF + m * 16) * H1P + col0;
#pragma unroll
                for (int bj = 0; bj < 2; ++bj) *(u32x4*)(rowp + bj * 8) = pack8((acc[ai][bj][m][0] + bv[bj][0]) * sc, (acc[ai][bj][m][1] + bv[bj][1]) * sc); }
    }
};
template <bool RESF32, bool SKIPMIX> struct EpiOut {
    static constexpr bool PERM = true, BJ8 = true;
    bf16_t* Z; const void* res;
    __device__ __forceinline__ void stage(const Unit&, int, int) const {}
    __device__ __forceinline__ void operator()(PG8_EPI_ARGS) const {
        static_assert(!RESF32, "bf16 residual only");
        const int row0 = u.pm * BM + wr * 64 + fr, col0 = u.pn * BM + wc * 64 + 16 * fq;
        u32x4 w[2][4][2];
#pragma unroll
        for (int ai = 0; ai < 2; ++ai)
#pragma unroll
            for (int m = 0; m < 4; ++m)
#pragma unroll
                for (int bj = 0; bj < 2; ++bj) w[ai][m][bj] = __builtin_nontemporal_load((const u32x4*)((const bf16_t*)res + (size_t)(row0 + ai * HALF + m * 16) * DM + col0 + bj * 8));
#pragma unroll
        for (int ai = 0; ai < 2; ++ai)
#pragma unroll
            for (int m = 0; m < 4; ++m)
#pragma unroll
                for (int bj = 0; bj < 2; ++bj) { const size_t off = (size_t)(row0 + ai * HALF + m * 16) * DM + col0 + bj * 8; const u32x4 ww = w[ai][m][bj];
                    const f32x4 r0 = (f32x4){bflo(ww.x), bfhi(ww.x), bflo(ww.y), bfhi(ww.y)}, r1 = (f32x4){bflo(ww.z), bfhi(ww.z), bflo(ww.w), bfhi(ww.w)};
                    f32x4 v0 = r0 * ALPHA, v1 = r1 * ALPHA; if (!SKIPMIX) { v0 += acc[ai][bj][m][0]; v1 += acc[ai][bj][m][1]; }
                    *(u32x4*)(Z + off) = pack8(v0, v1); }
    }
};
struct EpiGU {
    static constexpr bool PERM = true, BJ8 = false;
    unsigned char* HH;
    __device__ __forceinline__ void stage(const Unit&, int, int) const {}
    __device__ __forceinline__ void operator()(PG8_EPI_ARGS) const {
        const int row0 = u.pm * BM + wr * 64 + fr, oc = u.pn * 128 + wc * 32 + 8 * fq;
#pragma unroll
        for (int ai = 0; ai < 2; ++ai)
#pragma unroll
            for (int m = 0; m < 4; ++m) { unsigned char* rowp = HH + (size_t)(row0 + ai * HALF + m * 16) * DE + oc;
                const f32x4 g0 = acc[ai][0][m][0] * W8INV, g1 = acc[ai][0][m][1] * W8INV;
                const f32x4 h0 = g0 * sigm4(g0) * (acc[ai][1][m][0] * W8INV), h1 = g1 * sigm4(g1) * (acc[ai][1][m][1] * W8INV);
                *(u32x2*)rowp = (u32x2){pk4_fp8(h0[0], h0[1], h0[2], h0[3]), pk4_fp8(h1[0], h1[1], h1[2], h1[3])}; }
    }
};
struct EpiDown {
    static constexpr bool PERM = true, BJ8 = true;
    unsigned char* YB; const unsigned* list; const float* roww; LAS unsigned* lrow;
    __device__ __forceinline__ void stage(const Unit& u, int wid, int lane) const {
        const unsigned* src = (wid < 4 ? list : (const unsigned*)roww) + u.lbase + (wid & 3) * 64;
        __builtin_amdgcn_global_load_lds((const unsigned*)(src + lane), (LAS unsigned*)(lrow + u.slot * 512 + wid * 64), 4, 0, 0);
    }
    __device__ __forceinline__ void operator()(PG8_EPI_ARGS) const {
        const int col0 = u.pn * BM + wc * 64 + 16 * fq;
#pragma unroll
        for (int ai = 0; ai < 2; ++ai)
#pragma unroll
            for (int m = 0; m < 4; ++m) { const int r = ai * HALF + wr * 64 + m * 16 + fr;
                if (r < u.nvalid) { const unsigned e = lrow[u.slot * 512 + r]; const float w = __uint_as_float(lrow[u.slot * 512 + 256 + r]) * (W8INV * Y8SCALE); unsigned char* rowp = YB + (size_t)e * DM + col0;
                    const f32x4 v0 = acc[ai][0][m][0] * w, v1 = acc[ai][0][m][1] * w, v2 = acc[ai][1][m][0] * w, v3 = acc[ai][1][m][1] * w;
                    *(u32x4*)rowp = (u32x4){pk4_fp8(v0[0], v0[1], v0[2], v0[3]), pk4_fp8(v1[0], v1[1], v1[2], v1[3]), pk4_fp8(v2[0], v2[1], v2[2], v2[3]), pk4_fp8(v3[0], v3[1], v3[2], v3[3])}; } }
    }
};
}

#define XB_TMO      128
#define XB_XCNT(j)  (256  + 64 * (j))
#define XB_XSUB(j)  (1280 + 64 * (j))
#define XB_XGEN(j)  (2304 + 64 * (j))
#define XB_TOP      3328
#define XB_TOPGEN   3392
#define XCD_BAR_WORDS 3456
#define XB_SPIN_CAP (1u << 18)
__device__ __forceinline__ unsigned xb_ld(unsigned* p)              { return __hip_atomic_load(p, __ATOMIC_RELAXED, __HIP_MEMORY_SCOPE_AGENT); }
__device__ __forceinline__ unsigned xb_add(unsigned* p, unsigned v) { return __hip_atomic_fetch_add(p, v, __ATOMIC_RELAXED, __HIP_MEMORY_SCOPE_AGENT); }
__device__ __forceinline__ unsigned xb_xcc_id() { return (unsigned)__builtin_amdgcn_s_getreg((3 << 11) | 20) & 0xFu; }
#define XB_SPIN(cond, bar) do { unsigned _sp = 0; while (cond) { __builtin_amdgcn_s_sleep(1); \
    if ((++_sp & 255u) == 0u) { if (xb_ld(&(bar)[XB_TMO])) break; if (_sp > XB_SPIN_CAP) { atomicAdd(&(bar)[XB_TMO], 1u); break; } } } } while (0)
struct XcdBarrier { unsigned* bar; unsigned x; volatile LAS unsigned* st; };
__device__ __forceinline__ XcdBarrier xcd_barrier_post(unsigned* bar, volatile LAS unsigned* st) {
    XcdBarrier b; b.bar = bar; b.x = xb_xcc_id(); b.st = st;
    if (threadIdx.x == 0) (void)xb_add(&bar[XB_XCNT(b.x)], 1u);
    return b;
}
__device__ __forceinline__ void xcd_barrier_complete(unsigned* bar, unsigned x, unsigned& nloc, unsigned& nx) {
    const unsigned G = gridDim.x * gridDim.y * gridDim.z;
    unsigned sum, cnt, mine, sp = 0u;
    for (;;) {
        sum = 0u; cnt = 0u; mine = 0u;
#pragma unroll
        for (unsigned j = 0; j < 16; ++j) { const unsigned c = xb_ld(&bar[XB_XCNT(j)]); sum += c; cnt += (c > 0u) ? 1u : 0u; mine = (j == x) ? c : mine; }
        if (sum == G) break;
        __builtin_amdgcn_s_sleep(1);
        if ((++sp & 255u) == 0u) { if (xb_ld(&bar[XB_TMO])) break; if (sp > XB_SPIN_CAP) { atomicAdd(&bar[XB_TMO], 1u); break; } }
    }
    nloc = mine > 0u ? mine : 1u; nx = cnt > 0u ? cnt : 1u;
}
__device__ __forceinline__ void xcd_barrier(const XcdBarrier& b) {
    asm volatile("s_waitcnt vmcnt(0)" ::: "memory");
    __syncthreads();
    if (threadIdx.x == 0) {
        unsigned* bar = b.bar;
        __builtin_amdgcn_s_waitcnt(0);
        unsigned nloc = b.st[0], nx = b.st[1];
        if (nloc == 0u) { xcd_barrier_complete(bar, b.x, nloc, nx); b.st[0] = nloc; b.st[1] = nx; }
        const unsigned old = xb_add(&bar[XB_XSUB(b.x)], 1u);
        const unsigned gen = old / nloc;
        if (old + 1u == (gen + 1u) * nloc) {
            __builtin_amdgcn_fence(__ATOMIC_RELEASE, "agent");
            asm volatile("s_waitcnt vmcnt(0)" ::: "memory");
            const unsigned og = xb_add(&bar[XB_TOP], 1u);
            const unsigned tg = og / nx;
            if (og + 1u == (tg + 1u) * nx) xb_add(&bar[XB_TOPGEN], 1u);
            else XB_SPIN(xb_ld(&bar[XB_TOPGEN]) == tg, bar);
            __builtin_amdgcn_fence(__ATOMIC_ACQUIRE, "agent");
            xb_add(&bar[XB_XGEN(b.x)], 1u);
            asm volatile("s_waitcnt vmcnt(0)" ::: "memory");
        } else {
            XB_SPIN(xb_ld(&bar[XB_XGEN(b.x)]) == gen, bar);
            __builtin_amdgcn_fence(__ATOMIC_ACQUIRE, "agent");
            asm volatile("s_waitcnt vmcnt(0)" ::: "memory");
        }
    }
    __syncthreads();
}

struct Args { const float* in[28]; float* out; unsigned char* ws; int ph_lo, ph_hi, dbl, pad; };
enum { I_X = 0, I_AB_WIN, I_AB_BIN, I_A_DW, I_A_DWB, I_A_LNG, I_A_LNB, I_B_DW, I_AB_WOUT, I_CD_WIN, I_CD_BIN, I_C_LNG, I_C_LNB, I_C_WS, I_C_WSB, I_D_REL, I_CD_WOUT,
       I_MIX_LNG, I_MIX_LNB, I_RG_W, I_RG_B, I_RE_W, I_RE_B, I_WGATE, I_WUP, I_WDOWN, I_FFN_LNG, I_FFN_LNB };

__device__ __forceinline__ void p0_transpose_item(const float* W, int K, int N, bf16_t* WT, int k0, int n0, int drow0, LAS float* scr, int lane) {
    const int n4 = lane & 15, kr = lane >> 4;
    f32x4 v[16];
#pragma unroll
    for (int i = 0; i < 16; ++i) v[i] = __builtin_nontemporal_load((const GAS f32x4*)(W + (size_t)(k0 + 4 * i + kr) * N + n0 + 4 * n4));
#pragma unroll
    for (int i = 0; i < 16; ++i) { const int k = 4 * i + kr; *(LAS f32x4*)(scr + k * 64 + ((4 * n4) ^ (4 * ((k >> 3) & 7)))) = v[i]; }
    LDS_WAIT(); asm volatile("" ::: "memory");
    const int c = lane & 7;
#pragma unroll
    for (int it = 0; it < 8; ++it) { const int n = (lane >> 3) + 8 * it; const LAS float* s = scr + (8 * c) * 64 + (n ^ (4 * c));
        u32x4 o; o.x = pk2(s[0 * 64], s[1 * 64]); o.y = pk2(s[2 * 64], s[3 * 64]); o.z = pk2(s[4 * 64], s[5 * 64]); o.w = pk2(s[6 * 64], s[7 * 64]);
        __builtin_nontemporal_store(o, (GAS u32x4*)(WT + (size_t)(drow0 + n) * K + k0 + 8 * c)); }
    LDS_WAIT(); asm volatile("" ::: "memory");
}
__device__ __forceinline__ void p0_transpose_item_f8(const float* W, int K, int N, unsigned char* WT8, int k0, int n0, int drow0, LAS float* scr, int lane, float scale) {
    const int n4 = lane & 15, kr = lane >> 4;
    f32x4 v[16];
#pragma unroll
    for (int i = 0; i < 16; ++i) v[i] = __builtin_nontemporal_load((const GAS f32x4*)(W + (size_t)(k0 + 4 * i + kr) * N + n0 + 4 * n4));
#pragma unroll
    for (int i = 0; i < 16; ++i) { const int k = 4 * i + kr; *(LAS f32x4*)(scr + k * 64 + ((4 * n4) ^ (4 * ((k >> 3) & 7)))) = v[i]; }
    LDS_WAIT(); asm volatile("" ::: "memory");
    const int c = lane & 3;
#pragma unroll
    for (int it = 0; it < 4; ++it) { const int n = (lane >> 2) + 16 * it; float s[16];
#pragma unroll
        for (int j = 0; j < 16; ++j) { const int k = 16 * c + j; s[j] = scr[k * 64 + (n ^ (4 * ((k >> 3) & 7)))] * scale; }
        u32x4 o; o.x = pk4_fp8(s[0], s[1], s[2], s[3]); o.y = pk4_fp8(s[4], s[5], s[6], s[7]); o.z = pk4_fp8(s[8], s[9], s[10], s[11]); o.w = pk4_fp8(s[12], s[13], s[14], s[15]);
        __builtin_nontemporal_store(o, (GAS u32x4*)(WT8 + (size_t)(drow0 + n) * K + k0 + 16 * c)); }
    LDS_WAIT(); asm volatile("" ::: "memory");
}
__device__ __forceinline__ int perm_ab(int n) {
    const int seg = n >> 9, ch = n & 511, t = ch >> 7, r = ch & 127;
    if (seg == 0) return t * 256 + r;
    if (seg == 1) return t * 256 + 128 + r;
    if (seg == 2) return 1024 + ch;
    if (seg == 3) return 1536 + t * 256 + r;
    return 1536 + t * 256 + 128 + r;
}
constexpr int MOE_W_ITEMS = NE * 3 * 128;
__device__ __forceinline__ void moe_w_item(const Args& A, int r, LAS float* scr, int lane) {
    unsigned char* ws = A.ws;
    const int mat = r >> 7, q = r & 127, le = mat / 3, kind = mat % 3;
    if (kind < 2) {
        const int nb = q % (DE / 64), kb = q / (DE / 64), n0 = 64 * nb;
        const float* src = A.in[kind == 0 ? I_WGATE : I_WUP] + (size_t)le * DM * DE;
        p0_transpose_item_f8(src, DM, DE, ws + WS_WGU + (size_t)le * DM * DM, 64 * kb, n0, (n0 >> 7) * 256 + kind * 128 + (n0 & 127), scr, lane, W8SCALE);
    } else {
        const int nb = q % (DM / 64), kb = q / (DM / 64);
        p0_transpose_item_f8(A.in[I_WDOWN] + (size_t)le * DE * DM, DE, DM, ws + WS_WD + (size_t)le * DM * DE, 64 * kb, 64 * nb, 64 * nb, scr, lane, W8SCALE);
    }
}
__device__ __forceinline__ void moe_w_ids(const Args& A, LAS unsigned char* lds, int layer, int wave, int lane, int id0, int stride, int count) {
    LAS float* scr = (LAS float*)(lds + wave * 16384);
    for (int k = 0, id = id0; k < count && id < MOE_W_ITEMS / NWAVES; ++k, id += stride) moe_w_item(A, layer * MOE_W_ITEMS + id * NWAVES + wave, scr, lane);
}
constexpr int SLACK_K5 = 2, SLACK_K6 = 2;
__device__ __forceinline__ int slack_first(int T) { return (4 * T) & 255; }
__device__ __forceinline__ int slack_done(int T) { const int f = slack_first(T); return f ? (256 - f) * (SLACK_K5 + SLACK_K6) : 0; }
__device__ __forceinline__ void moe_w_steps(const Args& A, LAS unsigned char* lds, int layer, int vcu, int wave, int lane, int s0, int s1) {
    LAS float* scr = (LAS float*)(lds + wave * 16384);
    for (int s = s0; s < s1; ++s) moe_w_item(A, layer * MOE_W_ITEMS + (s * 256 + vcu) * NWAVES + wave, scr, lane);
}
__device__ __forceinline__ void p0_prologue(const Args& A, LAS unsigned char* lds, int vcu, int G, int wave, int lane, int tid, int rp) {
    unsigned char* ws = A.ws;
    LAS float* scr = (LAS float*)(lds + wave * 16384);
    const int gw = vcu * NWAVES + wave, NGW = G * NWAVES;
    constexpr int I_IN = (DM / 64) * (NIN / 64), I_OUT = (DM / 64) * (DM / 64);
    constexpr int NITEMS = 2 * I_IN + 2 * I_OUT + (MOE_W_IN_P0 ? 2 * MOE_W_ITEMS : 0);
    for (int it_ = gw; it_ < (NITEMS << rp); it_ += NGW) {
        int r = it_ >= NITEMS ? it_ - NITEMS : it_;
        if (r < I_IN) { const int nb = r % (NIN / 64), kb = r / (NIN / 64); p0_transpose_item(A.in[I_AB_WIN], DM, NIN, (bf16_t*)(ws + WS_WIN0), 64 * kb, 64 * nb, perm_ab(64 * nb), scr, lane); continue; } r -= I_IN;
        if (r < I_IN) { const int nb = r % (NIN / 64), kb = r / (NIN / 64); p0_transpose_item(A.in[I_CD_WIN], DM, NIN, (bf16_t*)(ws + WS_WIN1), 64 * kb, 64 * nb, 64 * nb, scr, lane); continue; } r -= I_IN;
        if (r < I_OUT) { const int nb = r % (DM / 64), kb = r / (DM / 64); p0_transpose_item(A.in[I_AB_WOUT], DM, DM, (bf16_t*)(ws + WS_WOUT0), 64 * kb, 64 * nb, 64 * nb, scr, lane); continue; } r -= I_OUT;
        if (r < I_OUT) { const int nb = r % (DM / 64), kb = r / (DM / 64); p0_transpose_item(A.in[I_CD_WOUT], DM, DM, (bf16_t*)(ws + WS_WOUT1), 64 * kb, 64 * nb, 64 * nb, scr, lane); continue; } r -= I_OUT;
        moe_w_item(A, r, scr, lane);
    }
    const int gt = vcu * NTHR + tid, NGT = G * NTHR;
    { const GAS f32x4* x4 = (const GAS f32x4*)A.in[I_X]; GAS u32x4* o = (GAS u32x4*)(ws + WS_XA);
      for (int i0_ = gt; i0_ < ((M * DM / 8) << rp); i0_ += 4 * NGT) { const int i0 = i0_ & (M * DM / 8 - 1); f32x4 a[4], b[4];
#pragma unroll
          for (int j = 0; j < 4; ++j) { const int i = i0 + j * NGT; a[j] = __builtin_nontemporal_load(x4 + 2 * i); b[j] = __builtin_nontemporal_load(x4 + 2 * i + 1); }
#pragma unroll
          for (int j = 0; j < 4; ++j) { const int i = i0 + j * NGT; u32x4 w; w.x = pk2(a[j][0], a[j][1]); w.y = pk2(a[j][2], a[j][3]); w.z = pk2(b[j][0], b[j][1]); w.w = pk2(b[j][2], b[j][3]); o[i] = w; } } }
    { float* bp = (float*)(ws + WS_BIASP); for (int n = gt; n < NIN; n += NGT) bp[perm_ab(n)] = A.in[I_AB_BIN][n]; }
    { bf16_t* wr = (bf16_t*)(ws + WS_WR);
      for (int i = gt; i < 2 * 48 * DM; i += NGT) { const int l = i / (48 * DM), r = (i / DM) % 48, k = i % DM; float v = 0.f;
          if (r < 4) v = A.in[I_RG_W][((size_t)l * DM + k) * 4 + r];
          else if (r < 36) { const int g = (r - 4) >> 3, e = (r - 4) & 7; v = A.in[I_RE_W][(((size_t)l * 4 + g) * DM + k) * 8 + e]; }
          wr[i] = (bf16_t)f2bf(v); } }
    { bf16_t* sw = (bf16_t*)(ws + WS_SGUW);
      for (int i = gt; i < 8 * 128 * 128; i += NGT) { const int ii = (i >> 7) & 127, j = i & 127; const float v = ((j >> 6) <= (ii >> 6)) ? A.in[I_C_WS][i] : 0.f; sw[i] = (bf16_t)f2bf(v); } }
}

__device__ __forceinline__ void conv_phase(const Args& A, LAS unsigned char* lds, int vcu, int G, int wave, int lane, int tid, const bf16_t* H0, bf16_t* U, int rp) {
    LAS unsigned char* tileA = lds;
    LAS float* outA = (LAS float*)(lds + 63488);
    const int cp = tid & 255, pg = tid >> 8;
    float w0[31], w1[31];
#pragma unroll
    for (int t = 0; t < 31; ++t) { const f32x2 w = *(const f32x2*)(A.in[I_A_DW] + t * 512 + 2 * cp); w0[t] = w.x; w1[t] = w.y; }
    const f32x2 cb = *(const f32x2*)(A.in[I_A_DWB] + 2 * cp);
    const f32x4 g0 = *(const f32x4*)(A.in[I_A_LNG] + 4 * lane), g1 = *(const f32x4*)(A.in[I_A_LNG] + 256 + 4 * lane);
    const f32x4 b0 = *(const f32x4*)(A.in[I_A_LNB] + 4 * lane), b1 = *(const f32x4*)(A.in[I_A_LNB] + 256 + 4 * lane);
    for (int un_ = vcu; un_ < ((BATCH * (SEQ / 32)) << rp); un_ += G) { const int un = un_ & (BATCH * (SEQ / 32) - 1);
        const int b = un / (SEQ / 32), s0 = (un % (SEQ / 32)) * 32; const size_t rowb = (size_t)b * SEQ;
        { u32x4 tv[8];
#pragma unroll
          for (int k = 0; k < 8; ++k) { const int p = tid + k * NTHR, r = p >> 6, ch = p & 63, s = s0 - 30 + r; tv[k] = (u32x4){0u, 0u, 0u, 0u};
              if (p < 62 * 64 && s >= 0) tv[k] = *(const u32x4*)(H0 + (rowb + s) * H0P + ch * 8); }
#pragma unroll
          for (int k = 0; k < 8; ++k) { const int p = tid + k * NTHR, r = p >> 6, ch = p & 63; if (p < 62 * 64) *(LAS u32x4*)(tileA + r * 1024 + ch * 16) = tv[k]; } }
        __syncthreads();
#pragma unroll 1
        for (int tk = 0; tk < 2; ++tk) { const int pos0 = pg * 16 + tk * 8;
            float a0[8], a1[8];
#pragma unroll
            for (int p = 0; p < 8; ++p) { a0[p] = cb.x; a1[p] = cb.y; }
#pragma unroll
            for (int j = 0; j < 38; ++j) { const unsigned w = *(const LAS unsigned*)(tileA + (pos0 + j) * 1024 + cp * 4); const float x0 = bflo(w), x1 = bfhi(w);
#pragma unroll
                for (int p = 0; p < 8; ++p) { const int t = j - p; if (t >= 0 && t <= 30) { a0[p] += w0[t] * x0; a1[p] += w1[t] * x1; } } }
#pragma unroll
            for (int p = 0; p < 8; ++p) *(LAS f32x2*)(outA + (pos0 + p) * 512 + 2 * cp) = (f32x2){a0[p], a1[p]};
        }
        __syncthreads();
#pragma unroll 1
        for (int rr = 0; rr < 4; ++rr) { const int r = wave * 4 + rr;
            const f32x4 v0 = *(const LAS f32x4*)(outA + r * 512 + 4 * lane), v1 = *(const LAS f32x4*)(outA + r * 512 + 256 + 4 * lane);
            const float mean = wave_sum((v0[0] + v0[1]) + (v0[2] + v0[3]) + (v1[0] + v1[1]) + (v1[2] + v1[3])) * (1.f / 512.f);
            const f32x4 d0 = v0 - mean, d1 = v1 - mean;
            const float var = wave_sum((d0[0] * d0[0] + d0[1] * d0[1]) + (d0[2] * d0[2] + d0[3] * d0[3]) + (d1[0] * d1[0] + d1[1] * d1[1]) + (d1[2] * d1[2] + d1[3] * d1[3])) * (1.f / 512.f);
            const float rstd = 1.0f / sqrtf(var + LN_EPS);
            f32x4 y0 = d0 * rstd * g0 + b0, y1 = d1 * rstd * g1 + b1;
            y0 = y0 * pg8::sigm4(y0); y1 = y1 * pg8::sigm4(y1);
            bf16_t* orow = U + (rowb + s0 + r) * DM;
            *(u32x2*)(orow + 4 * lane) = (u32x2){cvt_pk_bf16(y0[0], y0[1]), cvt_pk_bf16(y0[2], y0[3])};
            *(u32x2*)(orow + 256 + 4 * lane) = (u32x2){cvt_pk_bf16(y1[0], y1[1]), cvt_pk_bf16(y1[2], y1[3])}; }
#pragma unroll
        for (int k = 0; k < 4; ++k) { const int task = tid + k * NTHR, p = task >> 6, cg = task & 63; const int s = s0 + p;
            f32x4 acc0 = (f32x4){0.f, 0.f, 0.f, 0.f}, acc1 = acc0;
#pragma unroll
            for (int t = 0; t < 3; ++t) { const int ss = s - 2 + t;
                if (ss >= 0) { const u32x4 w = *(const u32x4*)(H0 + (rowb + ss) * H0P + 1024 + cg * 8);
                    const f32x4 k0 = *(const f32x4*)(A.in[I_B_DW] + t * 512 + cg * 8), k1 = *(const f32x4*)(A.in[I_B_DW] + t * 512 + cg * 8 + 4);
                    acc0 += k0 * (f32x4){bflo(w.x), bfhi(w.x), bflo(w.y), bfhi(w.y)}; acc1 += k1 * (f32x4){bflo(w.z), bfhi(w.z), bflo(w.w), bfhi(w.w)}; } }
            const u32x4 g = *(const u32x4*)(H0 + (rowb + s) * H0P + 512 + cg * 8);
            acc0 *= (f32x4){bflo(g.x), bfhi(g.x), bflo(g.y), bfhi(g.y)}; acc1 *= (f32x4){bflo(g.z), bfhi(g.z), bflo(g.w), bfhi(g.w)};
            *(u32x4*)(U + (rowb + s) * DM + 512 + cg * 8) = pg8::pack8(acc0, acc1); }
        __syncthreads();
    }
}

__device__ __forceinline__ void router_preload(const Args& A, LAS unsigned char* lds, int tid, int layer) {
    constexpr int RS = 2064; LAS unsigned char* wrl = lds;
    const bf16_t* WR = (const bf16_t*)(A.ws + WS_WR) + (size_t)layer * 48 * DM;
    u32x4 tv[9];
#pragma unroll
    for (int k = 0; k < 9; ++k) { const int p = tid + k * NTHR, r = p >> 7, ch = p & 127; tv[k] = *(const u32x4*)(WR + r * DM + ch * 8); }
#pragma unroll
    for (int k = 0; k < 9; ++k) { const int p = tid + k * NTHR, r = p >> 7, ch = p & 127; *(LAS u32x4*)(wrl + r * RS + ch * 16) = tv[k]; }
}
__device__ __forceinline__ void router_phase(const Args& A, LAS unsigned char* lds, int vcu, int wave, int lane, int tid, int layer, const bf16_t* Z, bf16_t* X1, unsigned* cnt, int rp, bool preloaded) {
    constexpr int RS = 2064;
    LAS unsigned char* wrl = lds;
    LAS unsigned char* xt = lds + 36 * RS;
    LAS float* lgp = (LAS float*)(lds + 36 * RS + 16 * RS);
    LAS float* lg = (LAS float*)(lds + 36 * RS + 16 * RS + 18432);
    LAS unsigned* rec = (LAS unsigned*)(lds + ROUTER_REC_OFF);
    if (!preloaded) router_preload(A, lds, tid, layer);
    const float* lng = A.in[I_MIX_LNG] + layer * DM; const float* lnb = A.in[I_MIX_LNB] + layer * DM;
    const float* rgb = A.in[I_RG_B] + layer * 4; const float* reb = A.in[I_RE_B] + layer * 32;
    f32x4 g[4], bb[4];
#pragma unroll
    for (int q = 0; q < 2; ++q) { g[2 * q] = *(const f32x4*)(lng + q * 512 + lane * 8); g[2 * q + 1] = *(const f32x4*)(lng + q * 512 + lane * 8 + 4);
        bb[2 * q] = *(const f32x4*)(lnb + q * 512 + lane * 8); bb[2 * q + 1] = *(const f32x4*)(lnb + q * 512 + lane * 8 + 4); }
    const int rc0 = tid % 36, rc1 = (tid + NTHR) % 36;
    const float rbias0 = rc0 < 4 ? rgb[rc0] : reb[rc0 - 4], rbias1 = rc1 < 4 ? rgb[rc1] : reb[rc1 - 4];
    const int tok0 = vcu * 128;
    u32x4 pre[2][2];
#pragma unroll
    for (int tt = 0; tt < 2; ++tt) { const int tok = tok0 + 2 * wave + tt; pre[tt][0] = __builtin_nontemporal_load((const u32x4*)(Z + (size_t)tok * DM + lane * 8)); pre[tt][1] = __builtin_nontemporal_load((const u32x4*)(Z + (size_t)tok * DM + 512 + lane * 8)); }
    __syncthreads();
#pragma unroll 1
    for (int k_ = 0; k_ < (8 << rp); ++k_) { const int k = k_ & 7;
        u32x4 curp[2][2];
#pragma unroll
        for (int tt = 0; tt < 2; ++tt) { curp[tt][0] = pre[tt][0]; curp[tt][1] = pre[tt][1]; }
        if (k_ < (8 << rp) - 1) {
#pragma unroll
            for (int tt = 0; tt < 2; ++tt) { const int tok = tok0 + 16 * ((k + 1) & 7) + 2 * wave + tt; pre[tt][0] = __builtin_nontemporal_load((const u32x4*)(Z + (size_t)tok * DM + lane * 8)); pre[tt][1] = __builtin_nontemporal_load((const u32x4*)(Z + (size_t)tok * DM + 512 + lane * 8)); } }
#pragma unroll
        for (int tt = 0; tt < 2; ++tt) { const int tl = 2 * wave + tt, tok = tok0 + 16 * k + tl;
            const u32x4 p0 = curp[tt][0], p1 = curp[tt][1];
            f32x4 v[4] = {(f32x4){bflo(p0.x), bfhi(p0.x), bflo(p0.y), bfhi(p0.y)}, (f32x4){bflo(p0.z), bfhi(p0.z), bflo(p0.w), bfhi(p0.w)},
                          (f32x4){bflo(p1.x), bfhi(p1.x), bflo(p1.y), bfhi(p1.y)}, (f32x4){bflo(p1.z), bfhi(p1.z), bflo(p1.w), bfhi(p1.w)}};
            float s = 0.f;
#pragma unroll
            for (int j = 0; j < 4; ++j) s += (v[j][0] + v[j][1]) + (v[j][2] + v[j][3]);
            const float mean = wave_sum(s) * (1.f / DM); float s2 = 0.f;
#pragma unroll
            for (int j = 0; j < 4; ++j) { v[j] = v[j] - mean; s2 += (v[j][0] * v[j][0] + v[j][1] * v[j][1]) + (v[j][2] * v[j][2] + v[j][3] * v[j][3]); }
            const float rstd = 1.0f / sqrtf(wave_sum(s2) * (1.f / DM) + LN_EPS);
#pragma unroll
            for (int j = 0; j < 4; ++j) v[j] = v[j] * rstd * g[j] + bb[j];
            const u32x4 o0 = pg8::pack8(v[0], v[1]), o1 = pg8::pack8(v[2], v[3]);
            *(u32x4*)(X1 + (size_t)tok * DM + lane * 8) = o0; *(u32x4*)(X1 + (size_t)tok * DM + 512 + lane * 8) = o1;
            { unsigned char* xq = A.ws + WS_X1Q + (size_t)tok * DM;
              *(u32x2*)(xq + lane * 8) = (u32x2){pk4_fp8(v[0][0], v[0][1], v[0][2], v[0][3]), pk4_fp8(v[1][0], v[1][1], v[1][2], v[1][3])};
              *(u32x2*)(xq + 512 + lane * 8) = (u32x2){pk4_fp8(v[2][0], v[2][1], v[2][2], v[2][3]), pk4_fp8(v[3][0], v[3][1], v[3][2], v[3][3])}; }
            *(LAS u32x4*)(xt + tl * RS + lane * 16) = o0; *(LAS u32x4*)(xt + tl * RS + 1024 + lane * 16) = o1; }
        __syncthreads();
        {
          f32x4 acc[3]; const int fr = lane & 15, fq = lane >> 4;
#pragma unroll
          for (int nt = 0; nt < 3; ++nt) acc[nt] = (f32x4){0.f, 0.f, 0.f, 0.f};
#pragma unroll
          for (int q = 0; q < 4; ++q) { const int kk = 4 * wave + q; const bf16x8 a = *(const LAS bf16x8*)(xt + fr * RS + (32 * kk + 8 * fq) * 2);
#pragma unroll
              for (int nt = 0; nt < 3; ++nt) { int br = 16 * nt + fr; br = br < 36 ? br : 35; const bf16x8 bw = *(const LAS bf16x8*)(wrl + br * RS + (32 * kk + 8 * fq) * 2);
                  acc[nt] = __builtin_amdgcn_mfma_f32_16x16x32_bf16(a, bw, acc[nt], 0, 0, 0); } }
#pragma unroll
          for (int nt = 0; nt < 3; ++nt) if (16 * nt + fr < 36) {
#pragma unroll
              for (int r = 0; r < 4; ++r) lgp[(wave * 16 + 4 * fq + r) * 36 + 16 * nt + fr] = acc[nt][r]; } }
        __syncthreads();
        { float v = rbias0;
#pragma unroll
          for (int w = 0; w < 8; ++w) v += lgp[w * 576 + tid];
          lg[tid] = v;
          if (tid < 64) { float v1 = rbias1;
#pragma unroll
              for (int w = 0; w < 8; ++w) v1 += lgp[w * 576 + NTHR + tid];
              lg[NTHR + tid] = v1; } }
        __syncthreads();
        if (tid < 16) { const LAS float* L = lg + tid * 36; const int tok = tok0 + 16 * k + tid;
            int gi = 0; float gm = L[0];
#pragma unroll
            for (int j = 1; j < 4; ++j) { const float v = L[j]; if (v > gm) { gm = v; gi = j; } }
            float gs = 0.f;
#pragma unroll
            for (int j = 0; j < 4; ++j) gs += __expf(L[j] - gm);
            const float gtop = 1.0f / gs;
            const LAS float* Le = L + 4 + gi * 8;
            int e1 = 0; float m1 = Le[0];
#pragma unroll
            for (int j = 1; j < 8; ++j) { const float v = Le[j]; if (v > m1) { m1 = v; e1 = j; } }
            int e2 = -1; float m2 = -3.0e38f;
#pragma unroll
            for (int j = 0; j < 8; ++j) { const float v = Le[j]; if (j != e1 && v > m2) { m2 = v; e2 = j; } }
            const float q2 = __expf(m2 - m1), w1 = gtop / (1.0f + q2), w2 = gtop * q2 / (1.0f + q2);
            LAS unsigned* rp = rec + (16 * k + tid) * 8;
            rp[0] = (unsigned)(gi * 8 + e1); rp[1] = (unsigned)(tok * 2); rp[2] = __float_as_uint(w1);
            rp[4] = (unsigned)(gi * 8 + e2); rp[5] = (unsigned)(tok * 2 + 1); rp[6] = __float_as_uint(w2); }
    }
    __syncthreads();
    {
        const int e = tid >> 4, s = tid & 15; int c = 0;
#pragma unroll
        for (int r = 0; r < 16; ++r) c += (rec[(16 * s + r) * 4] == (unsigned)e) ? 1 : 0;
        int incl = c;
#pragma unroll
        for (int o = 1; o < 16; o <<= 1) { const int t = __shfl_up(incl, o, 16); if (s >= o) incl += t; }
        const int total = __shfl(incl, 15, 16);
        unsigned base = 0; if (s == 0 && total > 0) base = __hip_atomic_fetch_add(cnt + e * 64, (unsigned)total, RLX_AGENT);
        base = __shfl(base, 0, 16) + (unsigned)(incl - c);
        unsigned* list = (unsigned*)(A.ws + WS_LIST) + (size_t)e * CAP; float* roww = (float*)(A.ws + WS_ROWW) + (size_t)e * CAP;
#pragma unroll
        for (int r = 0; r < 16; ++r) { const int q = (16 * s + r) * 4; if (rec[q] == (unsigned)e) { list[base] = rec[q + 1]; roww[base] = __uint_as_float(rec[q + 2]); ++base; } } }
    __syncthreads();
}

__device__ __forceinline__ int moe_table(LAS unsigned char* lds, const unsigned* cnt, int tid) {
    LAS unsigned* tb = (LAS unsigned*)(lds + TBL_OFF);
    __syncthreads();
    if (tid < NE) tb[tid] = __hip_atomic_load(cnt + tid * 64, RLX_AGENT);
    __syncthreads();
    if (tid < 64) { const int n = tid < NE ? (((int)tb[tid] + 255) >> 8) : 0; int incl = n;
#pragma unroll
        for (int o = 1; o < 32; o <<= 1) { const int t = __shfl_up(incl, o, 64); if (tid >= o) incl += t; }
        if (tid < NE) { int T = incl - n; for (int m = 0; m < n; ++m) tb[64 + T++] = ((unsigned)tid << 16) | (unsigned)m; }
        if (tid == NE - 1) tb[32] = (unsigned)incl; }
    __syncthreads();
    return (int)tb[32];
}

template <bool FINAL, bool SKIPMOE>
__device__ __forceinline__ void combine_ln_phase(const Args& A, int vcu, int G, int wave, int lane, int layer, const bf16_t* X1, const unsigned char* YB, bf16_t* XN, float* OUT, int rp) {
    const float* lng = A.in[I_FFN_LNG] + layer * DM; const float* lnb = A.in[I_FFN_LNB] + layer * DM;
    f32x4 g[4], bb[4];
#pragma unroll
    for (int q = 0; q < 2; ++q) { g[2 * q] = *(const f32x4*)(lng + q * 512 + lane * 8); g[2 * q + 1] = *(const f32x4*)(lng + q * 512 + lane * 8 + 4);
        bb[2 * q] = *(const f32x4*)(lnb + q * 512 + lane * 8); bb[2 * q + 1] = *(const f32x4*)(lnb + q * 512 + lane * 8 + 4); }
#pragma unroll 1
    for (int tok_ = vcu * NWAVES + wave; tok_ < (M << rp); tok_ += G * NWAVES) { const int tok = tok_ & (M - 1);
        u32x4 px[2]; u32x2 py0[2], py1[2];
#pragma unroll
        for (int q = 0; q < 2; ++q) { px[q] = __builtin_nontemporal_load((const u32x4*)(X1 + (size_t)tok * DM + q * 512 + lane * 8));
            if (!SKIPMOE) { py0[q] = __builtin_nontemporal_load((const u32x2*)(YB + (size_t)(2 * tok) * DM + q * 512 + lane * 8)); py1[q] = __builtin_nontemporal_load((const u32x2*)(YB + (size_t)(2 * tok + 1) * DM + q * 512 + lane * 8)); }
            else { py0[q] = (u32x2){0u, 0u}; py1[q] = py0[q]; } }
        f32x4 v[4];
#pragma unroll
        for (int q = 0; q < 2; ++q) {
            v[2 * q] = (f32x4){bflo(px[q].x), bfhi(px[q].x), bflo(px[q].y), bfhi(px[q].y)} * ALPHA + (unpk4_fp8(py0[q].x) + unpk4_fp8(py1[q].x)) * Y8INV;
            v[2 * q + 1] = (f32x4){bflo(px[q].z), bfhi(px[q].z), bflo(px[q].w), bfhi(px[q].w)} * ALPHA + (unpk4_fp8(py0[q].y) + unpk4_fp8(py1[q].y)) * Y8INV; }
        float s = 0.f;
#pragma unroll
        for (int j = 0; j < 4; ++j) s += (v[j][0] + v[j][1]) + (v[j][2] + v[j][3]);
        const float mean = wave_sum(s) * (1.f / DM); float s2 = 0.f;
#pragma unroll
        for (int j = 0; j < 4; ++j) { v[j] = v[j] - mean; s2 += (v[j][0] * v[j][0] + v[j][1] * v[j][1]) + (v[j][2] * v[j][2] + v[j][3] * v[j][3]); }
        const float rstd = 1.0f / sqrtf(wave_sum(s2) * (1.f / DM) + LN_EPS);
#pragma unroll
        for (int j = 0; j < 4; ++j) v[j] = v[j] * rstd * g[j] + bb[j];
        if (FINAL) {
#pragma unroll
            for (int q = 0; q < 2; ++q) { __builtin_nontemporal_store(v[2 * q], (f32x4*)(OUT + (size_t)tok * DM + q * 512 + lane * 8)); __builtin_nontemporal_store(v[2 * q + 1], (f32x4*)(OUT + (size_t)tok * DM + q * 512 + lane * 8 + 4)); }
        } else {
#pragma unroll
            for (int q = 0; q < 2; ++q) *(u32x4*)(XN + (size_t)tok * DM + q * 512 + lane * 8) = pg8::pack8(v[2 * q], v[2 * q + 1]);
        }
    }
}

__device__ __forceinline__ s16x4 tr16(const LAS unsigned char* p) { return __builtin_bit_cast(s16x4, __builtin_amdgcn_ds_read_tr16_b64_v4i16((LAS s16x4*)p)); }
__device__ __forceinline__ int sgu_sw(int row) { return (row & 3) | ((row >> 1) & 4); }
__device__ __forceinline__ void sgu_unit(const Args& A, LAS unsigned char* lds, int wave, int lane, int b, int blk, const bf16_t* H1, bf16_t* U) {
    const size_t row0 = (size_t)b * SEQ + (size_t)blk * 128;
    { const f32x4 g0 = *(const f32x4*)(A.in[I_C_LNG] + lane * 8), g1 = *(const f32x4*)(A.in[I_C_LNG] + lane * 8 + 4), b0 = *(const f32x4*)(A.in[I_C_LNB] + lane * 8), b1 = *(const f32x4*)(A.in[I_C_LNB] + lane * 8 + 4);
      u32x4 pv[16];
#pragma unroll
      for (int jj = 0; jj < 16; ++jj) pv[jj] = __builtin_nontemporal_load((const u32x4*)(H1 + (row0 + wave * 16 + jj) * H1P + 512 + lane * 8));
#pragma unroll
      for (int jj = 0; jj < 16; ++jj) { const int j = wave * 16 + jj; const u32x4 p = pv[jj];
        f32x4 v0 = (f32x4){bflo(p.x), bfhi(p.x), bflo(p.y), bfhi(p.y)}, v1 = (f32x4){bflo(p.z), bfhi(p.z), bflo(p.w), bfhi(p.w)};
        const float mean = wave_sum((v0[0] + v0[1]) + (v0[2] + v0[3]) + (v1[0] + v1[1]) + (v1[2] + v1[3])) * (1.f / 512.f);
        v0 = v0 - mean; v1 = v1 - mean;
        const float var = wave_sum((v0[0] * v0[0] + v0[1] * v0[1]) + (v0[2] * v0[2] + v0[3] * v0[3]) + (v1[0] * v1[0] + v1[1] * v1[1]) + (v1[2] * v1[2] + v1[3] * v1[3])) * (1.f / 512.f);
        const float rstd = 1.0f / sqrtf(var + LN_EPS);
        v0 = v0 * rstd * g0 + b0; v1 = v1 * rstd * g1 + b1;
        *(LAS u32x4*)(lds + j * 1024 + ((lane ^ sgu_sw(j)) << 4)) = pg8::pack8(v0, v1); } }
    __syncthreads();
    { const int h = wave, fr = lane & 15, fq = lane >> 4, q = fr >> 2, p = fr & 3;
      const bf16_t* Wm = (const bf16_t*)(A.ws + WS_SGUW) + (size_t)h * 128 * 128 + (size_t)fr * 128 + 8 * fq;
      const bf16_t* Up = H1 + (row0 + fr) * H1P + h * 64 + 4 * fq;
      constexpr int DIST = 2, NSET = DIST + 1;
      bf16x8 wf[NSET][4]; u32x2 uu[NSET][4]; float bs[8];
#define SGU_LOAD(it_) do { _Pragma("unroll") for (int kk = 0; kk < 4; ++kk) if (kk < ((it_) < 4 ? 2 : 4)) wf[(it_) % NSET][kk] = *(const bf16x8*)(Wm + (size_t)(16 * (it_)) * 128 + 32 * kk); \
        _Pragma("unroll") for (int ct = 0; ct < 4; ++ct) uu[(it_) % NSET][ct] = *(const u32x2*)(Up + (size_t)(16 * (it_)) * H1P + 16 * ct); } while (0)
#pragma unroll
      for (int it = 0; it < 8; ++it) bs[it] = A.in[I_C_WSB][h * 128 + 16 * it + fr];
#pragma unroll
      for (int it = 0; it < DIST; ++it) SGU_LOAD(it);
#pragma unroll
      for (int it = 0; it < 8; ++it) { const int nk = it < 4 ? 2 : 4;
        if (it + DIST < 8) SGU_LOAD(it + DIST);
        f32x4 acc[4];
#pragma unroll
        for (int ct = 0; ct < 4; ++ct) acc[ct] = (f32x4){0.f, 0.f, 0.f, 0.f};
#pragma unroll
        for (int kk = 0; kk < 4; ++kk) if (kk < nk) {
#pragma unroll
            for (int ct = 0; ct < 4; ++ct) { const int col = h * 64 + 16 * ct + 4 * p; const int r0 = 32 * kk + 8 * fq + q, r1 = r0 + 4;
                const s16x4 lo = tr16(lds + r0 * 1024 + (((col >> 3) ^ sgu_sw(r0)) << 4) + (col & 7) * 2), hi = tr16(lds + r1 * 1024 + (((col >> 3) ^ sgu_sw(r1)) << 4) + (col & 7) * 2);
                const bf16x8 vf = (bf16x8){lo[0], lo[1], lo[2], lo[3], hi[0], hi[1], hi[2], hi[3]};
                acc[ct] = __builtin_amdgcn_mfma_f32_16x16x32_bf16(vf, wf[it % NSET][kk], acc[ct], 0, 0, 0); } }
        const int i = 16 * it + fr; const float bias = bs[it];
#pragma unroll
        for (int ct = 0; ct < 4; ++ct) { const int c = h * 64 + 16 * ct + 4 * fq; const u32x2 u2 = uu[it % NSET][ct];
            const float o0 = bflo(u2.x) * (acc[ct][0] + bias), o1 = bfhi(u2.x) * (acc[ct][1] + bias), o2 = bflo(u2.y) * (acc[ct][2] + bias), o3 = bfhi(u2.y) * (acc[ct][3] + bias);
            *(u32x2*)(U + (row0 + i) * DM + c) = (u32x2){cvt_pk_bf16(o0, o1), cvt_pk_bf16(o2, o3)}; } }
#undef SGU_LOAD
    }
    __syncthreads();
}
__device__ __forceinline__ int crow(int r, int hi) { return (r & 3) + 8 * (r >> 2) + 4 * hi; }
__device__ __forceinline__ void attn_units(const Args& A, LAS unsigned char* lds, int wave, int lane, int tid, int b, int h, int par, int nunits, const bf16_t* H1, bf16_t* U) {
    LAS unsigned char* Kb = lds; LAS unsigned char* Vb = lds + 16384; LAS float* biasL = (LAS float*)(lds + 32768);
    LAS float* wsf = (LAS float*)(lds + 36864) + wave * 64; LAS unsigned char* stg = lds + 40960 + wave * 4096;
    const int r32 = lane & 31, hi = lane >> 5;
    const size_t rowb = (size_t)b * SEQ;
    for (int i = tid; i < 513; i += NTHR) biasL[i] = A.in[I_D_REL][h * 513 + i] * LOG2E;
    const bf16_t* qsrc = H1 + (rowb + (wave >> 1) * 64 + (wave & 1) * 32 + r32) * H1P + 1024 + h * 64 + hi * 8;
    const bf16_t* ksrc = H1 + (rowb + lane) * H1P + 1536 + h * 64 + wave * 8;
    const bf16_t* vsrc = H1 + (rowb + 16 * (wave & 3) + (lane >> 2)) * H1P + 2048 + h * 64 + (wave >> 2) * 32 + (lane & 3) * 8;
    const int kdst = wave * 1024 + lane * 16, vdst = wave * 1024 + lane * 16;
    bf16x8 qr[4], qn[4]; u32x4 kreg, vreg;
    { const int cg0 = par, tl0 = 4 * cg0 - 8 > 0 ? 4 * cg0 - 8 : 0;
#pragma unroll
      for (int d0 = 0; d0 < 4; ++d0) qn[d0] = __builtin_nontemporal_load((const bf16x8*)(qsrc + (size_t)cg0 * 256 * H1P + d0 * 16));
      kreg = *(const u32x4*)(ksrc + (size_t)tl0 * 64 * H1P); vreg = *(const u32x4*)(vsrc + (size_t)tl0 * 64 * H1P); }
#pragma unroll 1
    for (int ui = 0; ui < nunits; ++ui) {
    const int cg = 2 * (ui & 3) + par, n0 = 4 * cg, n = n0 + (wave >> 1), qpos0 = n * 64 + (wave & 1) * 32;
    const int t_lo = n0 - 8 > 0 ? n0 - 8 : 0, t_hi = n0 + 3;
    const int cgn = 2 * ((ui + 1) & 3) + par, tln = 4 * cgn - 8 > 0 ? 4 * cgn - 8 : 0; const bool more = ui + 1 < nunits;
#pragma unroll
    for (int d0 = 0; d0 < 4; ++d0) qr[d0] = qn[d0];
    *(LAS u32x4*)(Kb + kdst) = kreg; *(LAS u32x4*)(Vb + vdst) = vreg;
    __syncthreads();
    float mrun = -1.0e30f, lrun = 0.f; f32x16 o[2];
#pragma unroll
    for (int r = 0; r < 16; ++r) { o[0][r] = 0.f; o[1][r] = 0.f; }
    const int vlane = ((lane >> 4) & 1) * 32 + (lane & 3) * 8 + (4 * hi + ((lane & 15) >> 2)) * 64;
#pragma unroll 1
    for (int t = t_lo; t <= t_hi; ++t) {
        const int buf = (t - t_lo) & 1;
        if (t < t_hi) { kreg = *(const u32x4*)(ksrc + (size_t)(t + 1) * 64 * H1P); vreg = *(const u32x4*)(vsrc + (size_t)(t + 1) * 64 * H1P); }
        else if (more) {
#pragma unroll
            for (int d0 = 0; d0 < 4; ++d0) qn[d0] = __builtin_nontemporal_load((const bf16x8*)(qsrc + (size_t)cgn * 256 * H1P + d0 * 16));
            kreg = *(const u32x4*)(ksrc + (size_t)tln * 64 * H1P); vreg = *(const u32x4*)(vsrc + (size_t)tln * 64 * H1P); }
        if (t >= n - 8 && t <= n) {
            const LAS unsigned char* kb = Kb + buf * 8192 + hi * 1024 + r32 * 16;
            f32x16 p0, p1;
#pragma unroll
            for (int r = 0; r < 16; ++r) { p0[r] = 0.f; p1[r] = 0.f; }
#pragma unroll
            for (int d0 = 0; d0 < 4; ++d0) { const bf16x8 b0 = *(const LAS bf16x8*)(kb + d0 * 2048), b1 = *(const LAS bf16x8*)(kb + d0 * 2048 + 512);
                p0 = __builtin_amdgcn_mfma_f32_32x32x16_bf16(b0, qr[d0], p0, 0, 0, 0); p1 = __builtin_amdgcn_mfma_f32_32x32x16_bf16(b1, qr[d0], p1, 0, 0, 0); }
            const int dbase = (qpos0 + r32) - t * 64;
            float rm = -3.0e38f;
#pragma unroll
            for (int r = 0; r < 16; ++r) { const int d0_ = dbase - crow(r, hi), d1_ = d0_ - 32;
                p0[r] += biasL[(d0_ < 256 ? d0_ : 256) + 256]; p1[r] += biasL[(d1_ < 256 ? d1_ : 256) + 256];
                rm = fmaxf(rm, fmaxf(p0[r], p1[r])); }
            rm = fmaxf(rm, __shfl_xor(rm, 32));
            const float mnew = fmaxf(mrun, rm), f = __builtin_amdgcn_exp2f(mrun - mnew); mrun = mnew;
            float ps = 0.f;
#pragma unroll
            for (int r = 0; r < 16; ++r) { p0[r] = __builtin_amdgcn_exp2f(p0[r] - mnew); p1[r] = __builtin_amdgcn_exp2f(p1[r] - mnew); ps += p0[r] + p1[r]; }
            lrun = lrun * f + ps;
            if (hi == 0) wsf[r32] = f;
            bf16x8 pa[4];
#pragma unroll
            for (int ks = 0; ks < 2; ++ks) { u32x4 w0, w1;
                w0.x = cvt_pk_bf16(p0[8 * ks + 0], p0[8 * ks + 1]); w0.y = cvt_pk_bf16(p0[8 * ks + 2], p0[8 * ks + 3]); w0.z = cvt_pk_bf16(p0[8 * ks + 4], p0[8 * ks + 5]); w0.w = cvt_pk_bf16(p0[8 * ks + 6], p0[8 * ks + 7]);
                w1.x = cvt_pk_bf16(p1[8 * ks + 0], p1[8 * ks + 1]); w1.y = cvt_pk_bf16(p1[8 * ks + 2], p1[8 * ks + 3]); w1.z = cvt_pk_bf16(p1[8 * ks + 4], p1[8 * ks + 5]); w1.w = cvt_pk_bf16(p1[8 * ks + 6], p1[8 * ks + 7]);
                pa[ks] = __builtin_bit_cast(bf16x8, w0); pa[2 + ks] = __builtin_bit_cast(bf16x8, w1); }
#pragma unroll
            for (int r = 0; r < 16; ++r) { const float fr_ = wsf[crow(r, hi)]; o[0][r] *= fr_; o[1][r] *= fr_; }
            const LAS unsigned char* vb = Vb + buf * 8192 + vlane;
#pragma unroll
            for (int dh = 0; dh < 2; ++dh)
#pragma unroll
                for (int ks = 0; ks < 4; ++ks) { const s16x4 lo = tr16(vb + dh * 4096 + ks * 1024), hh = tr16(vb + dh * 4096 + ks * 1024 + 512);
                    const bf16x8 vf = (bf16x8){lo[0], lo[1], lo[2], lo[3], hh[0], hh[1], hh[2], hh[3]};
                    o[dh] = __builtin_amdgcn_mfma_f32_32x32x16_bf16(pa[ks], vf, o[dh], 0, 0, 0); }
        }
        if (t < t_hi) { *(LAS u32x4*)(Kb + (buf ^ 1) * 8192 + kdst) = kreg; *(LAS u32x4*)(Vb + (buf ^ 1) * 8192 + vdst) = vreg; }
        __syncthreads();
    }
    lrun += __shfl_xor(lrun, 32);
    if (hi == 0) wsf[32 + r32] = 1.0f / lrun;
    bf16_t* Ow = U + (rowb + qpos0) * DM + 512 + h * 64;
#pragma unroll
    for (int r = 0; r < 16; ++r) { const int q = crow(r, hi); const float rl = wsf[32 + q];
        *(LAS bf16_t*)(stg + q * 128 + r32 * 2) = (bf16_t)f2bf(o[0][r] * rl); *(LAS bf16_t*)(stg + q * 128 + 64 + r32 * 2) = (bf16_t)f2bf(o[1][r] * rl); }
#pragma unroll
    for (int i = 0; i < 4; ++i) { const int row = i * 8 + (lane >> 3), ch = lane & 7; const u32x4 v = *(const LAS u32x4*)(stg + row * 128 + ch * 16); *(u32x4*)(Ow + (size_t)row * DM + ch * 8) = v; }
    __syncthreads();
    }
}

constexpr int NPHASE = 15;
__global__ void __launch_bounds__(NTHR, 2) hybrid_fwd(Args args) {
    extern __shared__ __attribute__((aligned(16))) unsigned char lds_raw[];
    LAS unsigned char* lds = (LAS unsigned char*)lds_raw;
    volatile LAS unsigned* MISC = (volatile LAS unsigned*)(lds + MISC_OFF);
    const int tid = threadIdx.x, lane = tid & 63, wave = __builtin_amdgcn_readfirstlane(tid >> 6);
    const int G = gridDim.x; const int bx = blockIdx.x; const int vcu = (G % 8 == 0) ? (bx % 8) * (G / 8) + bx / 8 : bx;
    unsigned char* ws = args.ws;
    gu32* ctl = (gu32*)(ws + WS_CTL);
    for (int u = tid; u < (LDS_BYTES - LDSCTL_OFF) / 4; u += NTHR) ((LAS unsigned*)(lds + LDSCTL_OFF))[u] = 0u;
    __syncthreads();
    XcdBarrier bar; bar.bar = (unsigned*)(ctl + CW_BAR); bar.x = 0; bar.st = nullptr;
    if (!MK_PER_PHASE) bar = xcd_barrier_post((unsigned*)(ctl + CW_BAR), MISC + 8);
    const int lo = args.ph_lo, hi = args.ph_hi, dblm = args.dbl;
#define IN(k) (lo <= (k) && (k) < hi)
#define DB(k) ((dblm >> (k)) & 1)
#define SEAM(k) do { if (IN(k) && IN((k) + 1)) { xcd_barrier(bar); if (dblm & 0x8000) xcd_barrier(bar); } } while (0)
    bf16_t* XA = (bf16_t*)(ws + WS_XA); bf16_t* X1 = (bf16_t*)(ws + WS_X1); bf16_t* HB = (bf16_t*)(ws + WS_H);
    bf16_t* U = (bf16_t*)args.out; bf16_t* Z = (bf16_t*)args.out + (size_t)M * DM; unsigned char* YB = ws + WS_H + 64 * MiB;
    unsigned* list = (unsigned*)(ws + WS_LIST); float* roww = (float*)(ws + WS_ROWW);

    if (IN(0)) { p0_prologue(args, lds, vcu, G, wave, lane, tid, DB(0)); } SEAM(0);
    LAS float* biasL = (LAS float*)(lds + TBL_OFF + 4096);
    if (IN(1)) { pg8::StaticOrder S; S.init(M, NIN, DM, ws + WS_WIN0, G, bx, DB(1)); pg8::EpiIn0 E{HB, biasL};
        for (int i = tid; i < NIN; i += NTHR) biasL[i] = ((const float*)(ws + WS_BIASP))[i];
        const int pre = MOE_W_IN_P0 ? 0 : (vcu >> 5) % (MOE_W_SA + 1), tot = MOE_W_IN_P0 ? 0 : MOE_W_SA;
        moe_w_steps(args, lds, 0, vcu, wave, lane, 0, pre); __syncthreads();
        pg8::gemm_phase<pg8::EpiIn0, pg8::StaticOrder, true>(lds, (const char*)XA, DM, S, E);
        moe_w_steps(args, lds, 0, vcu, wave, lane, pre, tot); } SEAM(1);
    if (IN(2)) { conv_phase(args, lds, vcu, G, wave, lane, tid, HB, U, DB(2)); } SEAM(2);
    if (IN(3)) { pg8::StaticOrder S; S.init(M, DM, DM, ws + WS_WOUT0, G, bx, DB(3)); pg8::EpiOut<false, SKIP_MIX0> E{Z, (const void*)XA};
        const int pre = MOE_W_IN_P0 ? 0 : (vcu >> 5) % (7 - MOE_W_SA), tot = MOE_W_IN_P0 ? 0 : 6 - MOE_W_SA;
        moe_w_steps(args, lds, 0, vcu, wave, lane, MOE_W_SA, MOE_W_SA + pre); __syncthreads();
        pg8::gemm_phase<pg8::EpiOut<false, SKIP_MIX0>, pg8::StaticOrder, true>(lds, (const char*)U, DM, S, E);
        moe_w_steps(args, lds, 0, vcu, wave, lane, MOE_W_SA + pre, MOE_W_SA + tot);
        if (IN(4)) { __syncthreads(); router_preload(args, lds, tid, 0); } } SEAM(3);
    if (IN(4)) { router_phase(args, lds, vcu, wave, lane, tid, 0, Z, X1, (unsigned*)(ctl + CW_CNT), DB(4), IN(3)); } SEAM(4);
    if (IN(5)) { if (!SKIP_MOE0) { const int T = moe_table(lds, (const unsigned*)(ctl + CW_CNT), tid); LAS unsigned* tb = (LAS unsigned*)(lds + TBL_OFF);
        pg8::MoeOrder<true> S{tb + 64, tb, T, G, vcu, DM / 2, (const char*)(ws + WS_WGU), (size_t)DM * DM, list, DB(5)}; pg8::EpiGU E{(unsigned char*)HB};
        pg8::gemm_phase<pg8::EpiGU, pg8::MoeOrder<true>, true, true>(lds, (const char*)(ws + WS_X1Q), DM / 2, S, E);
        if (MOE_W_SLACK) { const int f = slack_first(T); if (f && vcu >= f) moe_w_ids(args, lds, 1, wave, lane, vcu - f, 256 - f, SLACK_K5); } } } SEAM(5);
    if (IN(6)) { if (!SKIP_MOE0) { LAS unsigned* tb = (LAS unsigned*)(lds + TBL_OFF); const int T = MK_PER_PHASE ? moe_table(lds, (const unsigned*)(ctl + CW_CNT), tid) : (int)tb[32];
        pg8::MoeOrder<false> S{tb + 64, tb, T, G, vcu, DE / 2, (const char*)(ws + WS_WD), (size_t)DM * DE, list, DB(6)}; pg8::EpiDown E{YB, list, roww, (LAS unsigned*)(lds + ROUTER_REC_OFF)};
        pg8::gemm_phase<pg8::EpiDown, pg8::MoeOrder<false>, true, true>(lds, (const char*)HB, DE / 2, S, E);
        if (MOE_W_SLACK) { const int f = slack_first(T); if (f && vcu >= f) moe_w_ids(args, lds, 1, wave, lane, (256 - f) * SLACK_K5 + vcu - f, 256 - f, SLACK_K6); } } } SEAM(6);
    if (IN(7)) { combine_ln_phase<false, SKIP_MOE0>(args, vcu, G, wave, lane, 0, X1, YB, XA, nullptr, DB(7)); } SEAM(7);
    if (IN(8)) { pg8::StaticOrder S; S.init(M, NIN, DM, ws + WS_WIN1, G, bx, DB(8)); pg8::EpiIn1 E{HB, biasL};
        for (int i = tid; i < NIN; i += NTHR) biasL[i] = args.in[I_CD_BIN][i];
        const int T0 = MK_PER_PHASE ? moe_table(lds, (const unsigned*)(ctl + CW_CNT), tid) : (int)((LAS unsigned*)(lds + TBL_OFF))[32];
        const int D = (MOE_W_SLACK && !SKIP_MOE0) ? slack_done(T0) : 0;
        pg8::gemm_phase<pg8::EpiIn1, pg8::StaticOrder, true>(lds, (const char*)XA, DM, S, E);
        moe_w_ids(args, lds, 1, wave, lane, D + vcu, 256, MOE_W_SA); } SEAM(8);
    if (IN(9)) { if (!SKIP_MIX1) {
        for (int un = vcu; un < ((BATCH * 16) << DB(9)); un += G) sgu_unit(args, lds, wave, lane, (un >> 4) & 15, un & 15, HB, U);
        { const int pr = vcu >> 1; if (pr < BATCH * 8) attn_units(args, lds, wave, lane, tid, pr >> 3, pr & 7, vcu & 1, 4 << DB(9), HB, U); } } } SEAM(9);
    if (IN(10)) { pg8::StaticOrder S; S.init(M, DM, DM, ws + WS_WOUT1, G, bx, DB(10)); pg8::EpiOut<false, SKIP_MIX1> E{Z, (const void*)XA};
        const int T0 = MK_PER_PHASE ? moe_table(lds, (const unsigned*)(ctl + CW_CNT), tid) : (int)((LAS unsigned*)(lds + TBL_OFF))[32];
        const int D = (MOE_W_SLACK && !SKIP_MOE0) ? slack_done(T0) : 0;
        pg8::gemm_phase<pg8::EpiOut<false, SKIP_MIX1>, pg8::StaticOrder, true>(lds, (const char*)U, DM, S, E);
        moe_w_ids(args, lds, 1, wave, lane, D + vcu + 256 * MOE_W_SA, 256, 6 - MOE_W_SA);
        if (IN(11)) { __syncthreads(); router_preload(args, lds, tid, 1); } } SEAM(10);
    if (IN(11)) { router_phase(args, lds, vcu, wave, lane, tid, 1, Z, X1, (unsigned*)(ctl + CW_CNT) + 32 * 64, DB(11), IN(10)); } SEAM(11);
    if (IN(12)) { if (!SKIP_MOE1) { const int T = moe_table(lds, (const unsigned*)(ctl + CW_CNT) + 32 * 64, tid); LAS unsigned* tb = (LAS unsigned*)(lds + TBL_OFF);
        pg8::MoeOrder<true> S{tb + 64, tb, T, G, vcu, DM / 2, (const char*)(ws + WS_WGU) + (size_t)NE * DM * DM, (size_t)DM * DM, list, DB(12)}; pg8::EpiGU E{(unsigned char*)HB};
        pg8::gemm_phase<pg8::EpiGU, pg8::MoeOrder<true>, true, true>(lds, (const char*)(ws + WS_X1Q), DM / 2, S, E); } } SEAM(12);
    if (IN(13)) { if (!SKIP_MOE1) { LAS unsigned* tb = (LAS unsigned*)(lds + TBL_OFF); const int T = MK_PER_PHASE ? moe_table(lds, (const unsigned*)(ctl + CW_CNT) + 32 * 64, tid) : (int)tb[32];
        pg8::MoeOrder<false> S{tb + 64, tb, T, G, vcu, DE / 2, (const char*)(ws + WS_WD) + (size_t)NE * DM * DE, (size_t)DM * DE, list, DB(13)}; pg8::EpiDown E{YB, list, roww, (LAS unsigned*)(lds + ROUTER_REC_OFF)};
        pg8::gemm_phase<pg8::EpiDown, pg8::MoeOrder<false>, true, true>(lds, (const char*)HB, DE / 2, S, E); } } SEAM(13);
    if (IN(14)) { combine_ln_phase<true, SKIP_MOE1>(args, vcu, G, wave, lane, 1, X1, YB, nullptr, args.out, 0); }
#undef IN
#undef SEAM
}

extern "C" void kernel_launch(void* const* d_in, const int* in_sizes, int n_in, void* d_out, int out_size, void* d_ws, size_t ws_size, hipStream_t stream) {
    static int grid = 0;
    if (grid == 0) {
        if (n_in != 28 || in_sizes[0] != M * DM || out_size != M * DM || ws_size < WS_END) { fprintf(stderr, "kernel_launch: unexpected shapes / workspace (n_in %d, ws %zu); nothing launched\n", n_in, ws_size); grid = -1; return; }
        int dev = 0, cus = 0;
        if (hipGetDevice(&dev) != hipSuccess || hipDeviceGetAttribute(&cus, hipDeviceAttributeMultiprocessorCount, dev) != hipSuccess) { grid = -1; return; }
        if (hipFuncSetAttribute((const void*)hybrid_fwd, hipFuncAttributeMaxDynamicSharedMemorySize, LDS_BYTES) != hipSuccess) { fprintf(stderr, "kernel_launch: hipFuncSetAttribute failed\n"); grid = -1; return; }
        (void)hipGetLastError();
        grid = cus;
        if (grid != 256) { fprintf(stderr, "kernel_launch: built for 256 CUs, device has %d\n", cus); grid = -1; return; }
    }
    if (grid < 0) return;
    if (hipMemsetAsync((char*)d_ws + WS_CTL, 0, CTL_ZERO_BYTES, stream) != hipSuccess) return;
    Args a{};
    for (int i = 0; i < 28; ++i) a.in[i] = (const float*)d_in[i];
    a.out = (float*)d_out; a.ws = (unsigned char*)d_ws; a.dbl = DBL_MASK;
#if MK_PER_PHASE
    for (int p = 0; p < NPHASE; ++p) { a.ph_lo = p; a.ph_hi = p + 1; hipLaunchKernelGGL(hybrid_fwd, dim3(grid), dim3(NTHR), LDS_BYTES, stream, a); }
#else
    a.ph_lo = 0; a.ph_hi = NPHASE; hipLaunchKernelGGL(hybrid_fwd, dim3(grid), dim3(NTHR), LDS_BYTES, stream, a);
#ifdef EXTRA_PHASE
    a.ph_lo = EXTRA_PHASE; a.ph_hi = EXTRA_PHASE + 1; hipLaunchKernelGGL(hybrid_fwd, dim3(grid), dim3(NTHR), LDS_BYTES, stream, a);
#endif
#endif
}
```

```cpp
#include <hip/hip_runtime.h>
#include <cstdio>
#include <cstdint>

#ifndef MK_PER_PHASE
#define MK_PER_PHASE 0
#endif
#ifndef SKIP_MIX0
#define SKIP_MIX0 0
#endif
#ifndef SKIP_MOE0
#define SKIP_MOE0 0
#endif
#ifndef SKIP_MIX1
#define SKIP_MIX1 0
#endif
#ifndef SKIP_MOE1
#define SKIP_MOE1 0
#endif

#ifndef MOE_W_IN_P0
#define MOE_W_IN_P0 0
#endif
#ifndef MOE_W_SLACK
#define MOE_W_SLACK 1
#endif
#ifndef MOE_W_SA
#define MOE_W_SA 4
#endif
#ifndef DBL_MASK
#define DBL_MASK 0
#endif
#define GAS __attribute__((address_space(1)))
#define LAS __attribute__((address_space(3)))
typedef unsigned short bf16_t;
typedef short bf16x8 __attribute__((ext_vector_type(8)));
typedef short s16x4 __attribute__((ext_vector_type(4)));
typedef float f32x2 __attribute__((ext_vector_type(2)));
typedef float f32x4 __attribute__((ext_vector_type(4)));
typedef float f32x16 __attribute__((ext_vector_type(16)));
typedef unsigned u32x2 __attribute__((ext_vector_type(2)));
typedef unsigned u32x4 __attribute__((ext_vector_type(4)));
typedef GAS unsigned gu32;

constexpr int BATCH = 16, SEQ = 2048, DM = 1024, M = BATCH * SEQ;
constexpr int NIN = 2560;
constexpr int NE = 32, DE = 512, CAP = 32768;
constexpr int H0P = 1536, H1P = 2560;
constexpr float LN_EPS = 1e-5f, ALPHA = 1.4142135623730951f, LOG2E = 1.4426950408889634f;
constexpr float QSCALE = 0.125f * LOG2E;
constexpr int NWAVES = 8, NTHR = 512;

constexpr size_t MiB = 1u << 20;
constexpr size_t WS_CTL = 0, CTL_ZERO_BYTES = 128 * 1024;
constexpr size_t WS_BIASP = 1 * MiB;
constexpr size_t WS_WR = 1 * MiB + 64 * 1024;
constexpr size_t WS_SGUW = 1 * MiB + 512 * 1024;
constexpr size_t WS_LIST = 2 * MiB;
constexpr size_t WS_ROWW = 6 * MiB;
constexpr size_t WS_WIN0 = 10 * MiB, WS_WIN1 = 15 * MiB, WS_WOUT0 = 20 * MiB, WS_WOUT1 = 22 * MiB;
constexpr size_t WS_WGU = 24 * MiB;
constexpr size_t WS_WD = 88 * MiB;
constexpr size_t WS_X1Q = 120 * MiB;
constexpr size_t WS_XA = 216 * MiB;
constexpr size_t WS_X1 = 280 * MiB;
constexpr size_t WS_H = 344 * MiB;
constexpr size_t WS_END = 504 * MiB;

constexpr int CW_TMO = 0, CW_CODE = 1;
constexpr int CW_BAR = 4096;
constexpr int CW_CNT = 16384;
static_assert((size_t)(CW_CNT + 2 * 32 * 64) * 4 <= CTL_ZERO_BYTES && (size_t)(CW_BAR + 3456) * 4 <= CTL_ZERO_BYTES, "control words inside the per-call memset");

constexpr int RING_BYTES = 131072;
constexpr int LDSCTL_OFF = RING_BYTES, MISC_OFF = LDSCTL_OFF + 320;
constexpr int TBL_OFF = RING_BYTES + 1024;
constexpr int ROUTER_REC_OFF = TBL_OFF + 2048;
constexpr int LDS_BYTES = 147456;
static_assert(ROUTER_REC_OFF + 4096 <= 147456 && TBL_OFF + 4096 + 2560 * 4 <= 147456, "LDS map");

#define RLX_AGENT __ATOMIC_RELAXED, __HIP_MEMORY_SCOPE_AGENT
#define LDS_WAIT() asm volatile("s_waitcnt lgkmcnt(0)" ::: "memory")
#define VM_WAIT() asm volatile("s_waitcnt vmcnt(0)" ::: "memory")
__device__ __forceinline__ unsigned f2bf(float f) { unsigned u = __builtin_bit_cast(unsigned, f); return (u + 0x7fffu + ((u >> 16) & 1u)) >> 16; }
__device__ __forceinline__ unsigned pk2(float lo, float hi) { return f2bf(lo) | (f2bf(hi) << 16); }
typedef __bf16 bf16x2_n __attribute__((ext_vector_type(2)));
__device__ __forceinline__ unsigned cvt_pk_bf16(float lo, float hi) { const f32x2 v = {lo, hi}; const bf16x2_n b = __builtin_convertvector(v, bf16x2_n); return __builtin_bit_cast(unsigned, b); }
__device__ __forceinline__ float bflo(unsigned w) { return __uint_as_float(w << 16); }
__device__ __forceinline__ float bfhi(unsigned w) { return __uint_as_float(w & 0xffff0000u); }
template <int CTRL> __device__ __forceinline__ float dpp_f(float v) { return __builtin_bit_cast(float, __builtin_amdgcn_update_dpp(0, __builtin_bit_cast(int, v), CTRL, 0xF, 0xF, true)); }
__device__ __forceinline__ float wave_sum(float v) {
    v += dpp_f<0xB1>(v); v += dpp_f<0x4E>(v); v += dpp_f<0x141>(v); v += dpp_f<0x140>(v);
    const int vi = __builtin_bit_cast(int, v);
    const float s0 = __builtin_bit_cast(float, __builtin_amdgcn_readlane(vi, 0)), s1 = __builtin_bit_cast(float, __builtin_amdgcn_readlane(vi, 16)),
                s2 = __builtin_bit_cast(float, __builtin_amdgcn_readlane(vi, 32)), s3 = __builtin_bit_cast(float, __builtin_amdgcn_readlane(vi, 48));
    return (s0 + s1) + (s2 + s3);
}
typedef int i32x4 __attribute__((ext_vector_type(4)));
typedef int i32x8 __attribute__((ext_vector_type(8)));
constexpr float W8SCALE = 32.0f, W8INV = 1.0f / 32.0f;
__device__ __forceinline__ float clamp8(float v) { return __builtin_fminf(__builtin_fmaxf(v, -448.0f), 448.0f); }
__device__ __forceinline__ unsigned pk4_fp8(float a, float b, float c, float d) { int w = 0; w = __builtin_amdgcn_cvt_pk_fp8_f32(clamp8(a), clamp8(b), w, false); w = __builtin_amdgcn_cvt_pk_fp8_f32(clamp8(c), clamp8(d), w, true); return (unsigned)w; }
__device__ __forceinline__ f32x4 unpk4_fp8(unsigned w) { const f32x2 lo = __builtin_amdgcn_cvt_pk_f32_fp8((int)w, false), hi = __builtin_amdgcn_cvt_pk_f32_fp8((int)w, true); return (f32x4){lo[0], lo[1], hi[0], hi[1]}; }
constexpr float Y8SCALE = 64.0f, Y8INV = 1.0f / 64.0f;
__device__ __forceinline__ float fast_sigmoid(float x) { return __builtin_amdgcn_rcpf(1.0f + __builtin_amdgcn_exp2f(-x * LOG2E)); }

namespace pg8 {
constexpr int BM = 256, BK = 64, HALF = 128, HTB = HALF * BK * 2, STAGE_BYTES = 8 * HTB, NXCD = 8, WGM = 8;
__host__ __device__ __forceinline__ int lds_byte(int r, int c) { const int st = (r >> 4) * 2 + (c >> 5), rr = r & 15, cc = c & 31, ob = rr * 64 + cc * 2; return st * 1024 + (ob ^ (((ob >> 9) & 1) << 5)); }
__host__ __device__ __forceinline__ void stage_rc(int b, int& R, int& C) { const int st = b / 1024, sb = b % 1024, swz = sb ^ (((sb >> 9) & 1) << 5); R = (st >> 1) * 16 + swz / 64; C = (st & 1) * 32 + (swz % 64) / 2; }
__host__ __device__ __forceinline__ int perm32(int rho) { const int n = rho >> 4, i = rho & 15; return 8 * (i >> 2) + 4 * n + (i & 3); }

struct Unit {
    int pm, pn;
    size_t aoff;
    unsigned lbase;
    int nvalid;
    const char* B;
    int slot;
};

struct StaticOrder {
    static constexpr bool GATHER = false;
    int nM, nN, nwg, G, c, K, dsh; const char* Bt; const unsigned* list;
    __device__ void init(int Mrows, int N, int K_, const void* Bt_, int G_, int c_, int dsh_) { nM = Mrows / BM; nN = N / BM; nwg = nM * nN; G = G_; c = c_; K = K_; Bt = (const char*)Bt_; list = nullptr; dsh = dsh_; }
    __device__ __forceinline__ bool next(int i, Unit& u) const {
        const int nmine = (nwg - c + G - 1) / G; if (i >= (nmine << dsh)) return false; const long L = (long)(i >= nmine ? i - nmine : i) * G + c;
        int wgid = (int)L; { const int q = nwg / NXCD, r = nwg % NXCD, xcd = wgid % NXCD, off = wgid / NXCD; wgid = (xcd < r ? xcd * (q + 1) : r * (q + 1) + (xcd - r) * q) + off; }
        const int nig = WGM * nN, gid = wgid / nig, fm = gid * WGM, gsz = (nM - fm) < WGM ? (nM - fm) : WGM;
        u.pm = fm + ((wgid % nig) % gsz); u.pn = (wgid % nig) / gsz;
        u.aoff = (size_t)u.pm * BM * K * 2; u.B = Bt + (size_t)u.pn * BM * K * 2; u.lbase = 0; u.nvalid = BM; return true;
    }
};
template <bool GATHER_> struct MoeOrder {
    static constexpr bool GATHER = GATHER_;
    const LAS unsigned* tinfo; const LAS unsigned* cntl; int ntiles, G, c, K; const char* Bbase; size_t per_expert; const unsigned* list; int dsh;
    __device__ __forceinline__ bool next(int i, Unit& u) const {
        const int nmine = (ntiles * 4 - c + G - 1) / G; if (i >= (nmine << dsh)) return false; const int L = (i >= nmine ? i - nmine : i) * G + c;
        const int tile = L >> 2; const unsigned ti = tinfo[tile]; const int e = (int)(ti >> 16), mt = (int)(ti & 0xffffu);
        u.pm = tile; u.pn = L & 3; u.aoff = (size_t)tile * BM * K * 2; u.lbase = (unsigned)(e * CAP + mt * BM);
        const int left = (int)cntl[e] - mt * BM; u.nvalid = left < BM ? left : BM;
        u.B = Bbase + (size_t)e * per_expert + (size_t)u.pn * BM * K * 2; return true;
    }
};

#define PG8_EPI_ARGS const f32x4 (&acc)[2][2][4][2], const Unit& u, int wr, int wc, int fr, int fq

template <class Epi, class Sched, bool ALIGN_EPI, bool F8 = false>
__device__ __forceinline__ void gemm_phase(LAS unsigned char* lds, const char* Abase, const int K, const Sched& S, const Epi& E) {
    const int tid = threadIdx.x, wid = __builtin_amdgcn_readfirstlane(tid >> 6), lane = tid & 63, wr = wid >> 2, wc = wid & 3, fr = lane & 15, fq = lane >> 4;
    const int nt = K / BK;
    unsigned voffA[2], voffB[2]; int RA[2]; unsigned CA2[2];
#pragma unroll
    for (int i = 0; i < 2; ++i) { int R, C; stage_rc(tid * 16 + i * 8192, R, C);
        const int Rb = Epi::BJ8 ? (64 * (R >> 5) + 16 * ((R & 15) >> 2) + 4 * ((R >> 4) & 1) + (R & 3)) : Epi::PERM ? ((R & ~31) + perm32(R & 31)) : R;
        voffA[i] = (unsigned)(R * K + C) * 2u; voffB[i] = (unsigned)(Rb * K + C) * 2u; RA[i] = R; CA2[i] = (unsigned)C * 2u; }
    const size_t kstep = (size_t)(BK * 2);
    const size_t hstep = (size_t)HALF * K * 2, hstepB = Epi::BJ8 ? (size_t)8 * K * 2 : hstep;
    const unsigned ldsw = (unsigned)wid * 1024u;
    const int c8 = (fq >> 1) * 32 + fq * 8;
    const int aoff = F8 ? lds_byte(wr * 64 + fr, c8) : lds_byte(wr * 64 + fr, fq * 8), boff = F8 ? lds_byte(wc * 32 + fr, c8) : lds_byte(wc * 32 + fr, fq * 8);
    const int aoffh = aoff ^ 32, boffh = boff ^ 32;

#define PG8_SA(b, h) (((b) * 2 + (h)) * HTB)
#define PG8_SB(b, h) ((4 + (b) * 2 + (h)) * HTB)
#define PG8_STAGE(bufoff, gbase, voff) do { _Pragma("unroll") for (int _i = 0; _i < 2; ++_i) \
        __builtin_amdgcn_global_load_lds((const unsigned*)((const char*)(gbase) + (voff)[_i]), (LAS unsigned*)(lds + (bufoff) + ldsw + _i * 8192), 16, 0, 0); } while (0)
#define PG8_STAGE_A(bufoff, h, pd, go, kb) do { if constexpr (Sched::GATHER) { PG8_STAGE(bufoff, Abase + (kb), go[h]); } else { PG8_STAGE(bufoff, (pd) + (h) * hstep, voffA); } } while (0)
#define PG8_LDA(dst, b, h) do { if constexpr (F8) { _Pragma("unroll") for (int m = 0; m < 4; ++m) { dst##8[m].lo = *(const LAS i32x4*)(lds + PG8_SA(b, h) + aoff + m * 2048); dst##8[m].hi = *(const LAS i32x4*)(lds + PG8_SA(b, h) + aoffh + m * 2048); } } \
        else { _Pragma("unroll") for (int m = 0; m < 4; ++m) _Pragma("unroll") for (int k = 0; k < 2; ++k) dst[m][k] = *(const LAS bf16x8*)(lds + PG8_SA(b, h) + aoff + m * 2048 + k * 1024); } } while (0)
#define PG8_LDB(dst, b, h) do { if constexpr (F8) { _Pragma("unroll") for (int n = 0; n < 2; ++n) { dst##8[n].lo = *(const LAS i32x4*)(lds + PG8_SB(b, h) + boff + n * 2048); dst##8[n].hi = *(const LAS i32x4*)(lds + PG8_SB(b, h) + boffh + n * 2048); } } \
        else { _Pragma("unroll") for (int n = 0; n < 2; ++n) _Pragma("unroll") for (int k = 0; k < 2; ++k) dst[n][k] = *(const LAS bf16x8*)(lds + PG8_SB(b, h) + boff + n * 2048 + k * 1024); } } while (0)
#define PG8_MMA(ai, bj, At, Bt) do { __builtin_amdgcn_s_setprio(1); if constexpr (F8) { _Pragma("unroll") for (int m = 0; m < 4; ++m) _Pragma("unroll") for (int n = 0; n < 2; ++n) \
        asm volatile("v_mfma_scale_f32_16x16x128_f8f6f4 %0, %1, %2, %0, %3, %3 op_sel_hi:[0,0,0]" : "+v"(acc[ai][bj][m][n]) : "v"(Bt##8[n]), "v"(At##8[m]), "v"(sc8)); } else { \
        _Pragma("unroll") for (int m = 0; m < 4; ++m) _Pragma("unroll") for (int n = 0; n < 2; ++n) _Pragma("unroll") for (int k = 0; k < 2; ++k) \
        acc[ai][bj][m][n] = __builtin_amdgcn_mfma_f32_16x16x32_bf16(Bt[n][k], At[m][k], acc[ai][bj][m][n], 0, 0, 0); } __builtin_amdgcn_s_setprio(0); } while (0)
#define PG8_WAIT_V(n) asm volatile("s_waitcnt vmcnt(" #n ")" ::: "memory")
#define PG8_WAIT_L(n) asm volatile("s_waitcnt lgkmcnt(" #n ")" ::: "memory")
#define PG8_BAR __builtin_amdgcn_s_barrier()
#define PG8_SCHED __builtin_amdgcn_sched_barrier(0)
#define PG8_GOFF(dst, uu) do { _Pragma("unroll") for (int _h = 0; _h < 2; ++_h) _Pragma("unroll") for (int _i = 0; _i < 2; ++_i) { \
        int _r = _h * HALF + RA[_i]; _r = _r < (uu).nvalid ? _r : 0; const unsigned _e = S.list[(uu).lbase + _r]; dst[_h][_i] = (_e >> 1) * (unsigned)(K * 2) + CA2[_i]; } } while (0)
    Unit cur, nxt; int ui = 0;
    if (!S.next(0, cur)) return;
    f32x4 acc[2][2][4][2];
#pragma unroll
    for (int a = 0; a < 2; ++a)
#pragma unroll
        for (int b = 0; b < 2; ++b)
#pragma unroll
            for (int m = 0; m < 4; ++m)
#pragma unroll
                for (int n = 0; n < 2; ++n) { acc[a][b][m][n] = (f32x4){0.f, 0.f, 0.f, 0.f}; }
    bf16x8 At[4][2], B0[2][2], B1[2][2];
    i32x8 At8[4], B08[2], B18[2];
    int sc8 = 0x7F7F7F7F; asm volatile("" : "+v"(sc8));
    unsigned goff[2][2] = {{0u, 0u}, {0u, 0u}}, goffn[2][2] = {{0u, 0u}, {0u, 0u}}, eraw[2][2] = {{0u, 0u}, {0u, 0u}};
#define PG8_ERAW(dst, uu) do { _Pragma("unroll") for (int _h = 0; _h < 2; ++_h) _Pragma("unroll") for (int _i = 0; _i < 2; ++_i) { \
        int _r = _h * HALF + RA[_i]; _r = _r < (uu).nvalid ? _r : 0; dst[_h][_i] = S.list[(uu).lbase + _r]; } } while (0)
#define PG8_ECONV(dst, src) do { _Pragma("unroll") for (int _h = 0; _h < 2; ++_h) _Pragma("unroll") for (int _i = 0; _i < 2; ++_i) dst[_h][_i] = (src[_h][_i] >> 1) * (unsigned)(K * 2) + CA2[_i]; } while (0)
    LAS unsigned* lrow = (LAS unsigned*)(lds + ROUTER_REC_OFF);
    if constexpr (Sched::GATHER) { PG8_ERAW(eraw, cur); PG8_ECONV(goff, eraw); }
    const char* cA = Abase + cur.aoff; const char* cB = cur.B;
    cur.slot = 0; E.stage(cur, wid, lane);
    PG8_STAGE(PG8_SB(0, 0), cB, voffB); PG8_STAGE(PG8_SB(0, 1), cB + hstepB, voffB); PG8_STAGE_A(PG8_SA(0, 0), 0, cA, goff, 0); PG8_STAGE_A(PG8_SA(0, 1), 1, cA, goff, 0);
    if (wr == 1) PG8_BAR;
    PG8_WAIT_V(2); PG8_BAR;
    PG8_STAGE(PG8_SB(1, 0), cB + kstep, voffB); PG8_STAGE_A(PG8_SA(1, 0), 0, cA + kstep, goff, kstep); PG8_STAGE(PG8_SB(1, 1), cB + hstepB + kstep, voffB);
    PG8_WAIT_V(6); PG8_BAR;
    for (;;) {
        const bool has_next = S.next(ui + 1, nxt);
        const char* nA = has_next ? Abase + nxt.aoff : cA; const char* nB = has_next ? nxt.B : cB;
        if constexpr (Sched::GATHER) { if (has_next && wid < 4) __builtin_amdgcn_global_load_lds((const unsigned*)(S.list + nxt.lbase + wid * 64 + lane), (LAS unsigned*)(lrow + wid * 64), 4, 0, 0); }
#pragma unroll 1
        for (int t = 0; t < nt; t += 2) {
            const bool last = (t == nt - 2);
            const char* a1 = cA + (size_t)(t + 1) * kstep;
            const char* a2 = last ? nA : cA + (size_t)(t + 2) * kstep; const char* b2 = last ? nB : cB + (size_t)(t + 2) * kstep;
            const char* a3 = a2 + kstep; const char* b3 = b2 + kstep;
            const size_t k1 = (size_t)(t + 1) * kstep, k2 = last ? (size_t)0 : (size_t)(t + 2) * kstep, k3 = k2 + kstep;
            if constexpr (Sched::GATHER) { if (last) {
                if (has_next) { unsigned et[2][2];
#pragma unroll
                    for (int h = 0; h < 2; ++h)
#pragma unroll
                        for (int i = 0; i < 2; ++i) { int r = h * HALF + RA[i]; r = r < nxt.nvalid ? r : 0; asm volatile("" : "+v"(r)); et[h][i] = lrow[r]; }
                    PG8_ECONV(goffn, et); }
                else {
#pragma unroll
                    for (int h = 0; h < 2; ++h) { goffn[h][0] = goff[h][0]; goffn[h][1] = goff[h][1]; } } } }
            unsigned gsel[2][2];
#pragma unroll
            for (int h = 0; h < 2; ++h) { gsel[h][0] = last ? goffn[h][0] : goff[h][0]; gsel[h][1] = last ? goffn[h][1] : goff[h][1]; }
            PG8_LDB(B0, 0, 0); PG8_LDB(B1, 0, 1); PG8_SCHED; PG8_LDA(At, 0, 0); PG8_STAGE_A(PG8_SA(1, 1), 1, a1, goff, k1);
            PG8_WAIT_V(8); PG8_WAIT_L(0); PG8_BAR; PG8_MMA(0, 0, At, B0); PG8_MMA(0, 1, At, B1); PG8_BAR; PG8_SCHED;
            PG8_LDA(At, 0, 1); PG8_STAGE(PG8_SB(0, 0), b2, voffB); PG8_STAGE(PG8_SB(0, 1), b2 + hstepB, voffB); PG8_STAGE_A(PG8_SA(0, 0), 0, a2, gsel, k2);
            PG8_WAIT_V(8); PG8_WAIT_L(0); PG8_BAR; PG8_MMA(1, 0, At, B0); PG8_MMA(1, 1, At, B1); PG8_BAR; PG8_SCHED;
            PG8_LDB(B0, 1, 0); PG8_LDB(B1, 1, 1); PG8_SCHED; PG8_LDA(At, 1, 0); PG8_STAGE_A(PG8_SA(0, 1), 1, a2, gsel, k2);
            PG8_WAIT_V(8); PG8_WAIT_L(0); PG8_BAR; PG8_MMA(0, 0, At, B0); PG8_MMA(0, 1, At, B1); PG8_BAR; PG8_SCHED;
            PG8_LDA(At, 1, 1); PG8_STAGE(PG8_SB(1, 0), b3, voffB); PG8_STAGE(PG8_SB(1, 1), b3 + hstepB, voffB); PG8_STAGE_A(PG8_SA(1, 0), 0, a3, gsel, k3);
            PG8_WAIT_V(8); PG8_WAIT_L(0); PG8_BAR; PG8_MMA(1, 0, At, B0); PG8_MMA(1, 1, At, B1); PG8_BAR; PG8_SCHED;
        }
        if constexpr (ALIGN_EPI) { if (wr == 0) PG8_BAR; }
        if constexpr (F8) asm volatile("s_nop 15\n\ts_nop 15" ::: "memory");
        E(acc, cur, wr, wc, fr, fq);
        if (!has_next) break;
#pragma unroll
        for (int a = 0; a < 2; ++a)
#pragma unroll
            for (int b = 0; b < 2; ++b)
#pragma unroll
                for (int m = 0; m < 4; ++m)
#pragma unroll
                    for (int n = 0; n < 2; ++n) { acc[a][b][m][n] = (f32x4){0.f, 0.f, 0.f, 0.f}; }
        cur = nxt; cA = nA; cB = nB; ++ui;
        cur.slot = ui & 1; E.stage(cur, wid, lane);
#pragma unroll
        for (int h = 0; h < 2; ++h) { goff[h][0] = goffn[h][0]; goff[h][1] = goffn[h][1]; }
        if constexpr (ALIGN_EPI) { if (wr == 1) PG8_BAR; }
    }
    PG8_WAIT_V(0);
    if constexpr (!ALIGN_EPI) { if (wr == 0) PG8_BAR; }
    PG8_BAR;
#undef PG8_SA
#undef PG8_SB
#undef PG8_STAGE
#undef PG8_STAGE_A
#undef PG8_LDA
#undef PG8_LDB
#undef PG8_MMA
#undef PG8_WAIT_V
#undef PG8_WAIT_L
#undef PG8_BAR
#undef PG8_SCHED
#undef PG8_GOFF
#undef PG8_ERAW
#undef PG8_ECONV
}

__device__ __forceinline__ u32x4 pack8(const f32x4 v0, const f32x4 v1) { u32x4 w; w.x = cvt_pk_bf16(v0[0], v0[1]); w.y = cvt_pk_bf16(v0[2], v0[3]); w.z = cvt_pk_bf16(v1[0], v1[1]); w.w = cvt_pk_bf16(v1[2], v1[3]); return w; }
__device__ __forceinline__ f32x4 sigm4(const f32x4 g) { return (f32x4){fast_sigmoid(g[0]), fast_sigmoid(g[1]), fast_sigmoid(g[2]), fast_sigmoid(g[3])}; }

struct EpiIn0 {
    static constexpr bool PERM = true, BJ8 = false;
    bf16_t* H; const LAS float* biasp;
    __device__ __forceinline__ void stage(const Unit&, int, int) const {}
    __device__ __forceinline__ void operator()(PG8_EPI_ARGS) const {
        const int row0 = u.pm * BM + wr * 64 + fr, cin = wc * 32 + 8 * fq, pn = u.pn;
        f32x4 bv[2][2];
#pragma unroll
        for (int bj = 0; bj < 2; ++bj)
#pragma unroll
            for (int n = 0; n < 2; ++n) bv[bj][n] = *(const LAS f32x4*)(biasp + pn * BM + bj * HALF + cin + 4 * n);
        if (pn == 4 || pn == 5) {
            const int oc = 512 + (pn - 4) * 256 + cin;
#pragma unroll
            for (int ai = 0; ai < 2; ++ai)
#pragma unroll
                for (int m = 0; m < 4; ++m) { bf16_t* rowp = H + (size_t)(row0 + ai * HALF + m * 16) * H0P + oc;
#pragma unroll
                    for (int bj = 0; bj < 2; ++bj) *(u32x4*)(rowp + bj * HALF) = pack8(acc[ai][bj][m][0] + bv[bj][0], acc[ai][bj][m][1] + bv[bj][1]); }
        } else {
            const bool glu = pn < 4; const int oc = glu ? pn * 128 + cin : 1024 + (pn - 6) * 128 + cin;
#pragma unroll
            for (int ai = 0; ai < 2; ++ai)
#pragma unroll
                for (int m = 0; m < 4; ++m) { bf16_t* rowp = H + (size_t)(row0 + ai * HALF + m * 16) * H0P + oc;
                    const f32x4 a0 = acc[ai][0][m][0] + bv[0][0], a1 = acc[ai][0][m][1] + bv[0][1]; f32x4 g0 = acc[ai][1][m][0] + bv[1][0], g1 = acc[ai][1][m][1] + bv[1][1];
                    if (glu) { g0 = sigm4(g0); g1 = sigm4(g1); }
                    *(u32x4*)rowp = pack8(a0 * g0, a1 * g1); }
        }
    }
};
struct EpiIn1 {
    static constexpr bool PERM = true, BJ8 = true;
    bf16_t* H; const LAS float* bias;
    __device__ __forceinline__ void stage(const Unit&, int, int) const {}
    __device__ __forceinline__ void operator()(PG8_EPI_ARGS) const {
        const int row0 = u.pm * BM + wr * 64 + fr, col0 = u.pn * BM + wc * 64 + 16 * fq; const float sc = (u.pn == 4 || u.pn == 5) ? QSCALE : 1.0f;
        f32x4 bv[2][2];
#pragma unroll
        for (int bj = 0; bj < 2; ++bj)
#pragma unroll
            for (int n = 0; n < 2; ++n) bv[bj][n] = *(const LAS f32x4*)(bias + col0 + bj * 8 + 4 * n);
#pragma unroll
        for (int ai = 0; ai < 2; ++ai)
#pragma unroll
            for (int m = 0; m < 4; ++m) { bf16_t* rowp = H + (size_t)(row0 + ai * HALF + m * 16) * H1P + col0;
#pragma unroll
                for (int bj = 0; bj < 2; ++bj) *(u32x4*)(rowp + bj * 8) = pack8((acc[ai][bj][m][0] + bv[bj][0]) * sc, (acc[ai][bj][m][1] + bv[bj][1]) * sc); }
    }
};
template <bool RESF32, bool SKIPMIX> struct EpiOut {
    static constexpr bool PERM = true, BJ8 = true;
    bf16_t* Z; const void* res;
    __device__ __forceinline__ void stage(const Unit&, int, int) const {}
    __device__ __forceinline__ void operator()(PG8_EPI_ARGS) const {
        static_assert(!RESF32, "bf16 residual only");
        const int row0 = u.pm * BM + wr * 64 + fr, col0 = u.pn * BM + wc * 64 + 16 * fq;
        u32x4 w[2][4][2];
#pragma unroll
        for (int ai = 0; ai < 2; ++ai)
#pragma unroll
            for (int m = 0; m < 4; ++m)
#pragma unroll
                for (int bj = 0; bj < 2; ++bj) w[ai][m][bj] = __builtin_nontemporal_load((const u32x4*)((const bf16_t*)res + (size_t)(row0 + ai * HALF + m * 16) * DM + col0 + bj * 8));
#pragma unroll
        for (int ai = 0; ai < 2; ++ai)
#pragma unroll
            for (int m = 0; m < 4; ++m)
#pragma unroll
                for (int bj = 0; bj < 2; ++bj) { const size_t off = (size_t)(row0 + ai * HALF + m * 16) * DM + col0 + bj * 8; const u32x4 ww = w[ai][m][bj];
                    const f32x4 r0 = (f32x4){bflo(ww.x), bfhi(ww.x), bflo(ww.y), bfhi(ww.y)}, r1 = (f32x4){bflo(ww.z), bfhi(ww.z), bflo(ww.w), bfhi(ww.w)};
                    f32x4 v0 = r0 * ALPHA, v1 = r1 * ALPHA; if (!SKIPMIX) { v0 += acc[ai][bj][m][0]; v1 += acc[ai][bj][m][1]; }
                    *(u32x4*)(Z + off) = pack8(v0, v1); }
    }
};
struct EpiGU {
    static constexpr bool PERM = true, BJ8 = false;
    unsigned char* HH;
    __device__ __forceinline__ void stage(const Unit&, int, int) const {}
    __device__ __forceinline__ void operator()(PG8_EPI_ARGS) const {
        const int row0 = u.pm * BM + wr * 64 + fr, oc = u.pn * 128 + wc * 32 + 8 * fq;
#pragma unroll
        for (int ai = 0; ai < 2; ++ai)
#pragma unroll
            for (int m = 0; m < 4; ++m) { unsigned char* rowp = HH + (size_t)(row0 + ai * HALF + m * 16) * DE + oc;
                const f32x4 g0 = acc[ai][0][m][0] * W8INV, g1 = acc[ai][0][m][1] * W8INV;
                const f32x4 h0 = g0 * sigm4(g0) * (acc[ai][1][m][0] * W8INV), h1 = g1 * sigm4(g1) * (acc[ai][1][m][1] * W8INV);
                *(u32x2*)rowp = (u32x2){pk4_fp8(h0[0], h0[1], h0[2], h0[3]), pk4_fp8(h1[0], h1[1], h1[2], h1[3])}; }
    }
};
struct EpiDown {
    static constexpr bool PERM = true, BJ8 = true;
    unsigned char* YB; const unsigned* list; const float* roww; LAS unsigned* lrow;
    __device__ __forceinline__ void stage(const Unit& u, int wid, int lane) const {
        const unsigned* src = (wid < 4 ? list : (const unsigned*)roww) + u.lbase + (wid & 3) * 64;
        __builtin_amdgcn_global_load_lds((const unsigned*)(src + lane), (LAS unsigned*)(lrow + u.slot * 512 + wid * 64), 4, 0, 0);
    }
    __device__ __forceinline__ void operator()(PG8_EPI_ARGS) const {
        const int col0 = u.pn * BM + wc * 64 + 16 * fq;
#pragma unroll
        for (int ai = 0; ai < 2; ++ai)
#pragma unroll
            for (int m = 0; m < 4; ++m) { const int r = ai * HALF + wr * 64 + m * 16 + fr;
                if (r < u.nvalid) { const unsigned e = lrow[u.slot * 512 + r]; const float w = __uint_as_float(lrow[u.slot * 512 + 256 + r]) * (W8INV * Y8SCALE); unsigned char* rowp = YB + (size_t)e * DM + col0;
                    const f32x4 v0 = acc[ai][0][m][0] * w, v1 = acc[ai][0][m][1] * w, v2 = acc[ai][1][m][0] * w, v3 = acc[ai][1][m][1] * w;
                    *(u32x4*)rowp = (u32x4){pk4_fp8(v0[0], v0[1], v0[2], v0[3]), pk4_fp8(v1[0], v1[1], v1[2], v1[3]), pk4_fp8(v2[0], v2[1], v2[2], v2[3]), pk4_fp8(v3[0], v3[1], v3[2], v3[3])}; } }
    }
};
}

#define XB_TMO      128
#define XB_XCNT(j)  (256  + 64 * (j))
#define XB_XSUB(j)  (1280 + 64 * (j))
#define XB_XGEN(j)  (2304 + 64 * (j))
#define XB_TOP      3328
#define XB_TOPGEN   3392
#define XCD_BAR_WORDS 3456
#define XB_SPIN_CAP (1u << 18)
__device__ __forceinline__ unsigned xb_ld(unsigned* p)              { return __hip_atomic_load(p, __ATOMIC_RELAXED, __HIP_MEMORY_SCOPE_AGENT); }
__device__ __forceinline__ unsigned xb_add(unsigned* p, unsigned v) { return __hip_atomic_fetch_add(p, v, __ATOMIC_RELAXED, __HIP_MEMORY_SCOPE_AGENT); }
__device__ __forceinline__ unsigned xb_xcc_id() { return (unsigned)__builtin_amdgcn_s_getreg((3 << 11) | 20) & 0xFu; }
#define XB_SPIN(cond, bar) do { unsigned _sp = 0; while (cond) { __builtin_amdgcn_s_sleep(1); \
    if ((++_sp & 255u) == 0u) { if (xb_ld(&(bar)[XB_TMO])) break; if (_sp > XB_SPIN_CAP) { atomicAdd(&(bar)[XB_TMO], 1u); break; } } } } while (0)
struct XcdBarrier { unsigned* bar; unsigned x; volatile LAS unsigned* st; };
__device__ __forceinline__ XcdBarrier xcd_barrier_post(unsigned* bar, volatile LAS unsigned* st) {
    XcdBarrier b; b.bar = bar; b.x = xb_xcc_id(); b.st = st;
    if (threadIdx.x == 0) (void)xb_add(&bar[XB_XCNT(b.x)], 1u);
    return b;
}
__device__ __forceinline__ void xcd_barrier_complete(unsigned* bar, unsigned x, unsigned& nloc, unsigned& nx) {
    const unsigned G = gridDim.x * gridDim.y * gridDim.z;
    unsigned sum, cnt, mine, sp = 0u;
    for (;;) {
        sum = 0u; cnt = 0u; mine = 0u;
#pragma unroll
        for (unsigned j = 0; j < 16; ++j) { const unsigned c = xb_ld(&bar[XB_XCNT(j)]); sum += c; cnt += (c > 0u) ? 1u : 0u; mine = (j == x) ? c : mine; }
        if (sum == G) break;
        __builtin_amdgcn_s_sleep(1);
        if ((++sp & 255u) == 0u) { if (xb_ld(&bar[XB_TMO])) break; if (sp > XB_SPIN_CAP) { atomicAdd(&bar[XB_TMO], 1u); break; } }
    }
    nloc = mine > 0u ? mine : 1u; nx = cnt > 0u ? cnt : 1u;
}
__device__ __forceinline__ void xcd_barrier(const XcdBarrier& b) {
    asm volatile("s_waitcnt vmcnt(0)" ::: "memory");
    __syncthreads();
    if (threadIdx.x == 0) {
        unsigned* bar = b.bar;
        __builtin_amdgcn_s_waitcnt(0);
        unsigned nloc = b.st[0], nx = b.st[1];
        if (nloc == 0u) { xcd_barrier_complete(bar, b.x, nloc, nx); b.st[0] = nloc; b.st[1] = nx; }
        const unsigned old = xb_add(&bar[XB_XSUB(b.x)], 1u);
        const unsigned gen = old / nloc;
        if (old + 1u == (gen + 1u) * nloc) {
            __builtin_amdgcn_fence(__ATOMIC_RELEASE, "agent");
            asm volatile("s_waitcnt vmcnt(0)" ::: "memory");
            const unsigned og = xb_add(&bar[XB_TOP], 1u);
            const unsigned tg = og / nx;
            if (og + 1u == (tg + 1u) * nx) xb_add(&bar[XB_TOPGEN], 1u);
            else XB_SPIN(xb_ld(&bar[XB_TOPGEN]) == tg, bar);
            __builtin_amdgcn_fence(__ATOMIC_ACQUIRE, "agent");
            xb_add(&bar[XB_XGEN(b.x)], 1u);
            asm volatile("s_waitcnt vmcnt(0)" ::: "memory");
        } else {
            XB_SPIN(xb_ld(&bar[XB_XGEN(b.x)]) == gen, bar);
            __builtin_amdgcn_fence(__ATOMIC_ACQUIRE, "agent");
            asm volatile("s_waitcnt vmcnt(0)" ::: "memory");
        }
    }
    __syncthreads();
}

struct Args { const float* in[28]; float* out; unsigned char* ws; int ph_lo, ph_hi, dbl, pad; };
enum { I_X = 0, I_AB_WIN, I_AB_BIN, I_A_DW, I_A_DWB, I_A_LNG, I_A_LNB, I_B_DW, I_AB_WOUT, I_CD_WIN, I_CD_BIN, I_C_LNG, I_C_LNB, I_C_WS, I_C_WSB, I_D_REL, I_CD_WOUT,
       I_MIX_LNG, I_MIX_LNB, I_RG_W, I_RG_B, I_RE_W, I_RE_B, I_WGATE, I_WUP, I_WDOWN, I_FFN_LNG, I_FFN_LNB };

__device__ __forceinline__ void p0_transpose_item(const float* W, int K, int N, bf16_t* WT, int k0, int n0, int drow0, LAS float* scr, int lane) {
    const int n4 = lane & 15, kr = lane >> 4;
    f32x4 v[16];
#pragma unroll
    for (int i = 0; i < 16; ++i) v[i] = __builtin_nontemporal_load((const GAS f32x4*)(W + (size_t)(k0 + 4 * i + kr) * N + n0 + 4 * n4));
#pragma unroll
    for (int i = 0; i < 16; ++i) { const int k = 4 * i + kr; *(LAS f32x4*)(scr + k * 64 + ((4 * n4) ^ (4 * ((k >> 3) & 7)))) = v[i]; }
    LDS_WAIT(); asm volatile("" ::: "memory");
    const int c = lane & 7;
#pragma unroll
    for (int it = 0; it < 8; ++it) { const int n = (lane >> 3) + 8 * it; const LAS float* s = scr + (8 * c) * 64 + (n ^ (4 * c));
        u32x4 o; o.x = pk2(s[0 * 64], s[1 * 64]); o.y = pk2(s[2 * 64], s[3 * 64]); o.z = pk2(s[4 * 64], s[5 * 64]); o.w = pk2(s[6 * 64], s[7 * 64]);
        __builtin_nontemporal_store(o, (GAS u32x4*)(WT + (size_t)(drow0 + n) * K + k0 + 8 * c)); }
    LDS_WAIT(); asm volatile("" ::: "memory");
}
__device__ __forceinline__ void p0_transpose_item_f8(const float* W, int K, int N, unsigned char* WT8, int k0, int n0, int drow0, LAS float* scr, int lane, float scale) {
    const int n4 = lane & 15, kr = lane >> 4;
    f32x4 v[16];
#pragma unroll
    for (int i = 0; i < 16; ++i) v[i] = __builtin_nontemporal_load((const GAS f32x4*)(W + (size_t)(k0 + 4 * i + kr) * N + n0 + 4 * n4));
#pragma unroll
    for (int i = 0; i < 16; ++i) { const int k = 4 * i + kr; *(LAS f32x4*)(scr + k * 64 + ((4 * n4) ^ (4 * ((k >> 3) & 7)))) = v[i]; }
    LDS_WAIT(); asm volatile("" ::: "memory");
    const int c = lane & 3;
#pragma unroll
    for (int it = 0; it < 4; ++it) { const int n = (lane >> 2) + 16 * it; float s[16];
#pragma unroll
        for (int j = 0; j < 16; ++j) { const int k = 16 * c + j; s[j] = scr[k * 64 + (n ^ (4 * ((k >> 3) & 7)))] * scale; }
        u32x4 o; o.x = pk4_fp8(s[0], s[1], s[2], s[3]); o.y = pk4_fp8(s[4], s[5], s[6], s[7]); o.z = pk4_fp8(s[8], s[9], s[10], s[11]); o.w = pk4_fp8(s[12], s[13], s[14], s[15]);
        __builtin_nontemporal_store(o, (GAS u32x4*)(WT8 + (size_t)(drow0 + n) * K + k0 + 16 * c)); }
    LDS_WAIT(); asm volatile("" ::: "memory");
}
__device__ __forceinline__ int perm_ab(int n) {
    const int seg = n >> 9, ch = n & 511, t = ch >> 7, r = ch & 127;
    if (seg == 0) return t * 256 + r;
    if (seg == 1) return t * 256 + 128 + r;
    if (seg == 2) return 1024 + ch;
    if (seg == 3) return 1536 + t * 256 + r;
    return 1536 + t * 256 + 128 + r;
}
constexpr int MOE_W_ITEMS = NE * 3 * 128;
__device__ __forceinline__ void moe_w_item(const Args& A, int r, LAS float* scr, int lane) {
    unsigned char* ws = A.ws;
    const int mat = r >> 7, q = r & 127, le = mat / 3, kind = mat % 3;
    if (kind < 2) {
        const int nb = q % (DE / 64), kb = q / (DE / 64), n0 = 64 * nb;
        const float* src = A.in[kind == 0 ? I_WGATE : I_WUP] + (size_t)le * DM * DE;
        p0_transpose_item_f8(src, DM, DE, ws + WS_WGU + (size_t)le * DM * DM, 64 * kb, n0, (n0 >> 7) * 256 + kind * 128 + (n0 & 127), scr, lane, W8SCALE);
    } else {
        const int nb = q % (DM / 64), kb = q / (DM / 64);
        p0_transpose_item_f8(A.in[I_WDOWN] + (size_t)le * DE * DM, DE, DM, ws + WS_WD + (size_t)le * DM * DE, 64 * kb, 64 * nb, 64 * nb, scr, lane, W8SCALE);
    }
}
__device__ __forceinline__ void moe_w_ids(const Args& A, LAS unsigned char* lds, int layer, int wave, int lane, int id0, int stride, int count) {
    LAS float* scr = (LAS float*)(lds + wave * 16384);
    for (int k = 0, id = id0; k < count && id < MOE_W_ITEMS / NWAVES; ++k, id += stride) moe_w_item(A, layer * MOE_W_ITEMS + id * NWAVES + wave, scr, lane);
}
constexpr int SLACK_K5 = 2, SLACK_K6 = 2;
__device__ __forceinline__ int slack_first(int T) { return (4 * T) & 255; }
__device__ __forceinline__ int slack_done(int T) { const int f = slack_first(T); return f ? (256 - f) * (SLACK_K5 + SLACK_K6) : 0; }
__device__ __forceinline__ void moe_w_steps(const Args& A, LAS unsigned char* lds, int layer, int vcu, int wave, int lane, int s0, int s1) {
    LAS float* scr = (LAS float*)(lds + wave * 16384);
    for (int s = s0; s < s1; ++s) moe_w_item(A, layer * MOE_W_ITEMS + (s * 256 + vcu) * NWAVES + wave, scr, lane);
}
__device__ __forceinline__ void p0_prologue(const Args& A, LAS unsigned char* lds, int vcu, int G, int wave, int lane, int tid, int rp) {
    unsigned char* ws = A.ws;
    LAS float* scr = (LAS float*)(lds + wave * 16384);
    const int gw = vcu * NWAVES + wave, NGW = G * NWAVES;
    constexpr int I_IN = (DM / 64) * (NIN / 64), I_OUT = (DM / 64) * (DM / 64);
    constexpr int NITEMS = 2 * I_IN + 2 * I_OUT + (MOE_W_IN_P0 ? 2 * MOE_W_ITEMS : 0);
    for (int it_ = gw; it_ < (NITEMS << rp); it_ += NGW) {
        int r = it_ >= NITEMS ? it_ - NITEMS : it_;
        if (r < I_IN) { const int nb = r % (NIN / 64), kb = r / (NIN / 64); p0_transpose_item(A.in[I_AB_WIN], DM, NIN, (bf16_t*)(ws + WS_WIN0), 64 * kb, 64 * nb, perm_ab(64 * nb), scr, lane); continue; } r -= I_IN;
        if (r < I_IN) { const int nb = r % (NIN / 64), kb = r / (NIN / 64); p0_transpose_item(A.in[I_CD_WIN], DM, NIN, (bf16_t*)(ws + WS_WIN1), 64 * kb, 64 * nb, 64 * nb, scr, lane); continue; } r -= I_IN;
        if (r < I_OUT) { const int nb = r % (DM / 64), kb = r / (DM / 64); p0_transpose_item(A.in[I_AB_WOUT], DM, DM, (bf16_t*)(ws + WS_WOUT0), 64 * kb, 64 * nb, 64 * nb, scr, lane); continue; } r -= I_OUT;
        if (r < I_OUT) { const int nb = r % (DM / 64), kb = r / (DM / 64); p0_transpose_item(A.in[I_CD_WOUT], DM, DM, (bf16_t*)(ws + WS_WOUT1), 64 * kb, 64 * nb, 64 * nb, scr, lane); continue; } r -= I_OUT;
        moe_w_item(A, r, scr, lane);
    }
    const int gt = vcu * NTHR + tid, NGT = G * NTHR;
    { const GAS f32x4* x4 = (const GAS f32x4*)A.in[I_X]; GAS u32x4* o = (GAS u32x4*)(ws + WS_XA);
      for (int i0_ = gt; i0_ < ((M * DM / 8) << rp); i0_ += 4 * NGT) { const int i0 = i0_ & (M * DM / 8 - 1); f32x4 a[4], b[4];
#pragma unroll
          for (int j = 0; j < 4; ++j) { const int i = i0 + j * NGT; a[j] = __builtin_nontemporal_load(x4 + 2 * i); b[j] = __builtin_nontemporal_load(x4 + 2 * i + 1); }
#pragma unroll
          for (int j = 0; j < 4; ++j) { const int i = i0 + j * NGT; u32x4 w; w.x = pk2(a[j][0], a[j][1]); w.y = pk2(a[j][2], a[j][3]); w.z = pk2(b[j][0], b[j][1]); w.w = pk2(b[j][2], b[j][3]); o[i] = w; } } }
    { float* bp = (float*)(ws + WS_BIASP); for (int n = gt; n < NIN; n += NGT) bp[perm_ab(n)] = A.in[I_AB_BIN][n]; }
    { bf16_t* wr = (bf16_t*)(ws + WS_WR);
      for (int i = gt; i < 2 * 48 * DM; i += NGT) { const int l = i / (48 * DM), r = (i / DM) % 48, k = i % DM; float v = 0.f;
          if (r < 4) v = A.in[I_RG_W][((size_t)l * DM + k) * 4 + r];
          else if (r < 36) { const int g = (r - 4) >> 3, e = (r - 4) & 7; v = A.in[I_RE_W][(((size_t)l * 4 + g) * DM + k) * 8 + e]; }
          wr[i] = (bf16_t)f2bf(v); } }
    { bf16_t* sw = (bf16_t*)(ws + WS_SGUW);
      for (int i = gt; i < 8 * 128 * 128; i += NGT) { const int ii = (i >> 7) & 127, j = i & 127; const float v = ((j >> 6) <= (ii >> 6)) ? A.in[I_C_WS][i] : 0.f; sw[i] = (bf16_t)f2bf(v); } }
}

__device__ __forceinline__ void conv_phase(const Args& A, LAS unsigned char* lds, int vcu, int G, int wave, int lane, int tid, const bf16_t* H0, bf16_t* U, int rp) {
    LAS unsigned char* tileA = lds;
    LAS float* outA = (LAS float*)(lds + 63488);
    const int cp = tid & 255, pg = tid >> 8;
    float w0[31], w1[31];
#pragma unroll
    for (int t = 0; t < 31; ++t) { const f32x2 w = *(const f32x2*)(A.in[I_A_DW] + t * 512 + 2 * cp); w0[t] = w.x; w1[t] = w.y; }
    const f32x2 cb = *(const f32x2*)(A.in[I_A_DWB] + 2 * cp);
    const f32x4 g0 = *(const f32x4*)(A.in[I_A_LNG] + 4 * lane), g1 = *(const f32x4*)(A.in[I_A_LNG] + 256 + 4 * lane);
    const f32x4 b0 = *(const f32x4*)(A.in[I_A_LNB] + 4 * lane), b1 = *(const f32x4*)(A.in[I_A_LNB] + 256 + 4 * lane);
    for (int un_ = vcu; un_ < ((BATCH * (SEQ / 32)) << rp); un_ += G) { const int un = un_ & (BATCH * (SEQ / 32) - 1);
        const int b = un / (SEQ / 32), s0 = (un % (SEQ / 32)) * 32; const size_t rowb = (size_t)b * SEQ;
        { u32x4 tv[8];
#pragma unroll
          for (int k = 0; k < 8; ++k) { const int p = tid + k * NTHR, r = p >> 6, ch = p & 63, s = s0 - 30 + r; tv[k] = (u32x4){0u, 0u, 0u, 0u};
              if (p < 62 * 64 && s >= 0) tv[k] = *(const u32x4*)(H0 + (rowb + s) * H0P + ch * 8); }
#pragma unroll
          for (int k = 0; k < 8; ++k) { const int p = tid + k * NTHR, r = p >> 6, ch = p & 63; if (p < 62 * 64) *(LAS u32x4*)(tileA + r * 1024 + ch * 16) = tv[k]; } }
        __syncthreads();
#pragma unroll 1
        for (int tk = 0; tk < 2; ++tk) { const int pos0 = pg * 16 + tk * 8;
            float a0[8], a1[8];
#pragma unroll
            for (int p = 0; p < 8; ++p) { a0[p] = cb.x; a1[p] = cb.y; }
#pragma unroll
            for (int j = 0; j < 38; ++j) { const unsigned w = *(const LAS unsigned*)(tileA + (pos0 + j) * 1024 + cp * 4); const float x0 = bflo(w), x1 = bfhi(w);
#pragma unroll
                for (int p = 0; p < 8; ++p) { const int t = j - p; if (t >= 0 && t <= 30) { a0[p] += w0[t] * x0; a1[p] += w1[t] * x1; } } }
#pragma unroll
            for (int p = 0; p < 8; ++p) *(LAS f32x2*)(outA + (pos0 + p) * 512 + 2 * cp) = (f32x2){a0[p], a1[p]};
        }
        __syncthreads();
#pragma unroll 1
        for (int rr = 0; rr < 4; ++rr) { const int r = wave * 4 + rr;
            const f32x4 v0 = *(const LAS f32x4*)(outA + r * 512 + 4 * lane), v1 = *(const LAS f32x4*)(outA + r * 512 + 256 + 4 * lane);
            const float mean = wave_sum((v0[0] + v0[1]) + (v0[2] + v0[3]) + (v1[0] + v1[1]) + (v1[2] + v1[3])) * (1.f / 512.f);
            const f32x4 d0 = v0 - mean, d1 = v1 - mean;
            const float var = wave_sum((d0[0] * d0[0] + d0[1] * d0[1]) + (d0[2] * d0[2] + d0[3] * d0[3]) + (d1[0] * d1[0] + d1[1] * d1[1]) + (d1[2] * d1[2] + d1[3] * d1[3])) * (1.f / 512.f);
            const float rstd = 1.0f / sqrtf(var + LN_EPS);
            f32x4 y0 = d0 * rstd * g0 + b0, y1 = d1 * rstd * g1 + b1;
            y0 = y0 * pg8::sigm4(y0); y1 = y1 * pg8::sigm4(y1);
            bf16_t* orow = U + (rowb + s0 + r) * DM;
            *(u32x2*)(orow + 4 * lane) = (u32x2){cvt_pk_bf16(y0[0], y0[1]), cvt_pk_bf16(y0[2], y0[3])};
            *(u32x2*)(orow + 256 + 4 * lane) = (u32x2){cvt_pk_bf16(y1[0], y1[1]), cvt_pk_bf16(y1[2], y1[3])}; }
#pragma unroll
        for (int k = 0; k < 4; ++k) { const int task = tid + k * NTHR, p = task >> 6, cg = task & 63; const int s = s0 + p;
            f32x4 acc0 = (f32x4){0.f, 0.f, 0.f, 0.f}, acc1 = acc0;
#pragma unroll
            for (int t = 0; t < 3; ++t) { const int ss = s - 2 + t;
                if (ss >= 0) { const u32x4 w = *(const u32x4*)(H0 + (rowb + ss) * H0P + 1024 + cg * 8);
                    const f32x4 k0 = *(const f32x4*)(A.in[I_B_DW] + t * 512 + cg * 8), k1 = *(const f32x4*)(A.in[I_B_DW] + t * 512 + cg * 8 + 4);
                    acc0 += k0 * (f32x4){bflo(w.x), bfhi(w.x), bflo(w.y), bfhi(w.y)}; acc1 += k1 * (f32x4){bflo(w.z), bfhi(w.z), bflo(w.w), bfhi(w.w)}; } }
            const u32x4 g = *(const u32x4*)(H0 + (rowb + s) * H0P + 512 + cg * 8);
            acc0 *= (f32x4){bflo(g.x), bfhi(g.x), bflo(g.y), bfhi(g.y)}; acc1 *= (f32x4){bflo(g.z), bfhi(g.z), bflo(g.w), bfhi(g.w)};
            *(u32x4*)(U + (rowb + s) * DM + 512 + cg * 8) = pg8::pack8(acc0, acc1); }
        __syncthreads();
    }
}

__device__ __forceinline__ void router_preload(const Args& A, LAS unsigned char* lds, int tid, int layer) {
    constexpr int RS = 2064; LAS unsigned char* wrl = lds;
    const bf16_t* WR = (const bf16_t*)(A.ws + WS_WR) + (size_t)layer * 48 * DM;
    u32x4 tv[9];
#pragma unroll
    for (int k = 0; k < 9; ++k) { const int p = tid + k * NTHR, r = p >> 7, ch = p & 127; tv[k] = *(const u32x4*)(WR + r * DM + ch * 8); }
#pragma unroll
    for (int k = 0; k < 9; ++k) { const int p = tid + k * NTHR, r = p >> 7, ch = p & 127; *(LAS u32x4*)(wrl + r * RS + ch * 16) = tv[k]; }
}
__device__ __forceinline__ void router_phase(const Args& A, LAS unsigned char* lds, int vcu, int wave, int lane, int tid, int layer, const bf16_t* Z, bf16_t* X1, unsigned* cnt, int rp, bool preloaded) {
    constexpr int RS = 2064;
    LAS unsigned char* wrl = lds;
    LAS unsigned char* xt = lds + 36 * RS;
    LAS float* lgp = (LAS float*)(lds + 36 * RS + 16 * RS);
    LAS float* lg = (LAS float*)(lds + 36 * RS + 16 * RS + 18432);
    LAS unsigned* rec = (LAS unsigned*)(lds + ROUTER_REC_OFF);
    if (!preloaded) router_preload(A, lds, tid, layer);
    const float* lng = A.in[I_MIX_LNG] + layer * DM; const float* lnb = A.in[I_MIX_LNB] + layer * DM;
    const float* rgb = A.in[I_RG_B] + layer * 4; const float* reb = A.in[I_RE_B] + layer * 32;
    f32x4 g[4], bb[4];
#pragma unroll
    for (int q = 0; q < 2; ++q) { g[2 * q] = *(const f32x4*)(lng + q * 512 + lane * 8); g[2 * q + 1] = *(const f32x4*)(lng + q * 512 + lane * 8 + 4);
        bb[2 * q] = *(const f32x4*)(lnb + q * 512 + lane * 8); bb[2 * q + 1] = *(const f32x4*)(lnb + q * 512 + lane * 8 + 4); }
    const int rc0 = tid % 36, rc1 = (tid + NTHR) % 36;
    const float rbias0 = rc0 < 4 ? rgb[rc0] : reb[rc0 - 4], rbias1 = rc1 < 4 ? rgb[rc1] : reb[rc1 - 4];
    const int tok0 = vcu * 128;
    u32x4 pre[2][2];
#pragma unroll
    for (int tt = 0; tt < 2; ++tt) { const int tok = tok0 + 2 * wave + tt; pre[tt][0] = __builtin_nontemporal_load((const u32x4*)(Z + (size_t)tok * DM + lane * 8)); pre[tt][1] = __builtin_nontemporal_load((const u32x4*)(Z + (size_t)tok * DM + 512 + lane * 8)); }
    __syncthreads();
#pragma unroll 1
    for (int k_ = 0; k_ < (8 << rp); ++k_) { const int k = k_ & 7;
        u32x4 curp[2][2];
#pragma unroll
        for (int tt = 0; tt < 2; ++tt) { curp[tt][0] = pre[tt][0]; curp[tt][1] = pre[tt][1]; }
        if (k_ < (8 << rp) - 1) {
#pragma unroll
            for (int tt = 0; tt < 2; ++tt) { const int tok = tok0 + 16 * ((k + 1) & 7) + 2 * wave + tt; pre[tt][0] = __builtin_nontemporal_load((const u32x4*)(Z + (size_t)tok * DM + lane * 8)); pre[tt][1] = __builtin_nontemporal_load((const u32x4*)(Z + (size_t)tok * DM + 512 + lane * 8)); } }
#pragma unroll
        for (int tt = 0; tt < 2; ++tt) { const int tl = 2 * wave + tt, tok = tok0 + 16 * k + tl;
            const u32x4 p0 = curp[tt][0], p1 = curp[tt][1];
            f32x4 v[4] = {(f32x4){bflo(p0.x), bfhi(p0.x), bflo(p0.y), bfhi(p0.y)}, (f32x4){bflo(p0.z), bfhi(p0.z), bflo(p0.w), bfhi(p0.w)},
                          (f32x4){bflo(p1.x), bfhi(p1.x), bflo(p1.y), bfhi(p1.y)}, (f32x4){bflo(p1.z), bfhi(p1.z), bflo(p1.w), bfhi(p1.w)}};
            float s = 0.f;
#pragma unroll
            for (int j = 0; j < 4; ++j) s += (v[j][0] + v[j][1]) + (v[j][2] + v[j][3]);
            const float mean = wave_sum(s) * (1.f / DM); float s2 = 0.f;
#pragma unroll
            for (int j = 0; j < 4; ++j) { v[j] = v[j] - mean; s2 += (v[j][0] * v[j][0] + v[j][1] * v[j][1]) + (v[j][2] * v[j][2] + v[j][3] * v[j][3]); }
            const float rstd = 1.0f / sqrtf(wave_sum(s2) * (1.f / DM) + LN_EPS);
#pragma unroll
            for (int j = 0; j < 4; ++j) v[j] = v[j] * rstd * g[j] + bb[j];
            const u32x4 o0 = pg8::pack8(v[0], v[1]), o1 = pg8::pack8(v[2], v[3]);
            *(u32x4*)(X1 + (size_t)tok * DM + lane * 8) = o0; *(u32x4*)(X1 + (size_t)tok * DM + 512 + lane * 8) = o1;
            { unsigned char* xq = A.ws + WS_X1Q + (size_t)tok * DM;
              *(u32x2*)(xq + lane * 8) = (u32x2){pk4_fp8(v[0][0], v[0][1], v[0][2], v[0][3]), pk4_fp8(v[1][0], v[1][1], v[1][2], v[1][3])};
              *(u32x2*)(xq + 512 + lane * 8) = (u32x2){pk4_fp8(v[2][0], v[2][1], v[2][2], v[2][3]), pk4_fp8(v[3][0], v[3][1], v[3][2], v[3][3])}; }
            *(LAS u32x4*)(xt + tl * RS + lane * 16) = o0; *(LAS u32x4*)(xt + tl * RS + 1024 + lane * 16) = o1; }
        __syncthreads();
        {
          f32x4 acc[3]; const int fr = lane & 15, fq = lane >> 4;
#pragma unroll
          for (int nt = 0; nt < 3; ++nt) acc[nt] = (f32x4){0.f, 0.f, 0.f, 0.f};
#pragma unroll
          for (int q = 0; q < 4; ++q) { const int kk = 4 * wave + q; const bf16x8 a = *(const LAS bf16x8*)(xt + fr * RS + (32 * kk + 8 * fq) * 2);
#pragma unroll
              for (int nt = 0; nt < 3; ++nt) { int br = 16 * nt + fr; br = br < 36 ? br : 35; const bf16x8 bw = *(const LAS bf16x8*)(wrl + br * RS + (32 * kk + 8 * fq) * 2);
                  acc[nt] = __builtin_amdgcn_mfma_f32_16x16x32_bf16(a, bw, acc[nt], 0, 0, 0); } }
#pragma unroll
          for (int nt = 0; nt < 3; ++nt) if (16 * nt + fr < 36) {
#pragma unroll
              for (int r = 0; r < 4; ++r) lgp[(wave * 16 + 4 * fq + r) * 36 + 16 * nt + fr] = acc[nt][r]; } }
        __syncthreads();
        { float v = rbias0;
#pragma unroll
          for (int w = 0; w < 8; ++w) v += lgp[w * 576 + tid];
          lg[tid] = v;
          if (tid < 64) { float v1 = rbias1;
#pragma unroll
              for (int w = 0; w < 8; ++w) v1 += lgp[w * 576 + NTHR + tid];
              lg[NTHR + tid] = v1; } }
        __syncthreads();
        if (tid < 16) { const LAS float* L = lg + tid * 36; const int tok = tok0 + 16 * k + tid;
            int gi = 0; float gm = L[0];
#pragma unroll
            for (int j = 1; j < 4; ++j) { const float v = L[j]; if (v > gm) { gm = v; gi = j; } }
            float gs = 0.f;
#pragma unroll
            for (int j = 0; j < 4; ++j) gs += __expf(L[j] - gm);
            const float gtop = 1.0f / gs;
            const LAS float* Le = L + 4 + gi * 8;
            int e1 = 0; float m1 = Le[0];
#pragma unroll
            for (int j = 1; j < 8; ++j) { const float v = Le[j]; if (v > m1) { m1 = v; e1 = j; } }
            int e2 = -1; float m2 = -3.0e38f;
#pragma unroll
            for (int j = 0; j < 8; ++j) { const float v = Le[j]; if (j != e1 && v > m2) { m2 = v; e2 = j; } }
            const float q2 = __expf(m2 - m1), w1 = gtop / (1.0f + q2), w2 = gtop * q2 / (1.0f + q2);
            LAS unsigned* rp = rec + (16 * k + tid) * 8;
            rp[0] = (unsigned)(gi * 8 + e1); rp[1] = (unsigned)(tok * 2); rp[2] = __float_as_uint(w1);
            rp[4] = (unsigned)(gi * 8 + e2); rp[5] = (unsigned)(tok * 2 + 1); rp[6] = __float_as_uint(w2); }
    }
    __syncthreads();
    {
        const int e = tid >> 4, s = tid & 15; int c = 0;
#pragma unroll
        for (int r = 0; r < 16; ++r) c += (rec[(16 * s + r) * 4] == (unsigned)e) ? 1 : 0;
        int incl = c;
#pragma unroll
        for (int o = 1; o < 16; o <<= 1) { const int t = __shfl_up(incl, o, 16); if (s >= o) incl += t; }
        const int total = __shfl(incl, 15, 16);
        unsigned base = 0; if (s == 0 && total > 0) base = __hip_atomic_fetch_add(cnt + e * 64, (unsigned)total, RLX_AGENT);
        base = __shfl(base, 0, 16) + (unsigned)(incl - c);
        unsigned* list = (unsigned*)(A.ws + WS_LIST) + (size_t)e * CAP; float* roww = (float*)(A.ws + WS_ROWW) + (size_t)e * CAP;
#pragma unroll
        for (int r = 0; r < 16; ++r) { const int q = (16 * s + r) * 4; if (rec[q] == (unsigned)e) { list[base] = rec[q + 1]; roww[base] = __uint_as_float(rec[q + 2]); ++base; } } }
    __syncthreads();
}

__device__ __forceinline__ int moe_table(LAS unsigned char* lds, const unsigned* cnt, int tid) {
    LAS unsigned* tb = (LAS unsigned*)(lds + TBL_OFF);
    __syncthreads();
    if (tid < NE) tb[tid] = __hip_atomic_load(cnt + tid * 64, RLX_AGENT);
    __syncthreads();
    if (tid < 64) { const int n = tid < NE ? (((int)tb[tid] + 255) >> 8) : 0; int incl = n;
#pragma unroll
        for (int o = 1; o < 32; o <<= 1) { const int t = __shfl_up(incl, o, 64); if (tid >= o) incl += t; }
        if (tid < NE) { int T = incl - n; for (int m = 0; m < n; ++m) tb[64 + T++] = ((unsigned)tid << 16) | (unsigned)m; }
        if (tid == NE - 1) tb[32] = (unsigned)incl; }
    __syncthreads();
    return (int)tb[32];
}

template <bool FINAL, bool SKIPMOE>
__device__ __forceinline__ void combine_ln_phase(const Args& A, int vcu, int G, int wave, int lane, int layer, const bf16_t* X1, const unsigned char* YB, bf16_t* XN, float* OUT, int rp) {
    const float* lng = A.in[I_FFN_LNG] + layer * DM; const float* lnb = A.in[I_FFN_LNB] + layer * DM;
    f32x4 g[4], bb[4];
#pragma unroll
    for (int q = 0; q < 2; ++q) { g[2 * q] = *(const f32x4*)(lng + q * 512 + lane * 8); g[2 * q + 1] = *(const f32x4*)(lng + q * 512 + lane * 8 + 4);
        bb[2 * q] = *(const f32x4*)(lnb + q * 512 + lane * 8); bb[2 * q + 1] = *(const f32x4*)(lnb + q * 512 + lane * 8 + 4); }
#pragma unroll 1
    for (int tok_ = vcu * NWAVES + wave; tok_ < (M << rp); tok_ += G * NWAVES) { const int tok = tok_ & (M - 1);
        u32x4 px[2]; u32x2 py0[2], py1[2];
#pragma unroll
        for (int q = 0; q < 2; ++q) { px[q] = __builtin_nontemporal_load((const u32x4*)(X1 + (size_t)tok * DM + q * 512 + lane * 8));
            if (!SKIPMOE) { py0[q] = __builtin_nontemporal_load((const u32x2*)(YB + (size_t)(2 * tok) * DM + q * 512 + lane * 8)); py1[q] = __builtin_nontemporal_load((const u32x2*)(YB + (size_t)(2 * tok + 1) * DM + q * 512 + lane * 8)); }
            else { py0[q] = (u32x2){0u, 0u}; py1[q] = py0[q]; } }
        f32x4 v[4];
#pragma unroll
        for (int q = 0; q < 2; ++q) {
            v[2 * q] = (f32x4){bflo(px[q].x), bfhi(px[q].x), bflo(px[q].y), bfhi(px[q].y)} * ALPHA + (unpk4_fp8(py0[q].x) + unpk4_fp8(py1[q].x)) * Y8INV;
            v[2 * q + 1] = (f32x4){bflo(px[q].z), bfhi(px[q].z), bflo(px[q].w), bfhi(px[q].w)} * ALPHA + (unpk4_fp8(py0[q].y) + unpk4_fp8(py1[q].y)) * Y8INV; }
        float s = 0.f;
#pragma unroll
        for (int j = 0; j < 4; ++j) s += (v[j][0] + v[j][1]) + (v[j][2] + v[j][3]);
        const float mean = wave_sum(s) * (1.f / DM); float s2 = 0.f;
#pragma unroll
        for (int j = 0; j < 4; ++j) { v[j] = v[j] - mean; s2 += (v[j][0] * v[j][0] + v[j][1] * v[j][1]) + (v[j][2] * v[j][2] + v[j][3] * v[j][3]); }
        const float rstd = 1.0f / sqrtf(wave_sum(s2) * (1.f / DM) + LN_EPS);
#pragma unroll
        for (int j = 0; j < 4; ++j) v[j] = v[j] * rstd * g[j] + bb[j];
        if (FINAL) {
#pragma unroll
            for (int q = 0; q < 2; ++q) { __builtin_nontemporal_store(v[2 * q], (f32x4*)(OUT + (size_t)tok * DM + q * 512 + lane * 8)); __builtin_nontemporal_store(v[2 * q + 1], (f32x4*)(OUT + (size_t)tok * DM + q * 512 + lane * 8 + 4)); }
        } else {
#pragma unroll
            for (int q = 0; q < 2; ++q) *(u32x4*)(XN + (size_t)tok * DM + q * 512 + lane * 8) = pg8::pack8(v[2 * q], v[2 * q + 1]);
        }
    }
}

__device__ __forceinline__ s16x4 tr16(const LAS unsigned char* p) { return __builtin_bit_cast(s16x4, __builtin_amdgcn_ds_read_tr16_b64_v4i16((LAS s16x4*)p)); }
__device__ __forceinline__ int sgu_sw(int row) { return (row & 3) | ((row >> 1) & 4); }
__device__ __forceinline__ void sgu_unit(const Args& A, LAS unsigned char* lds, int wave, int lane, int b, int blk, const bf16_t* H1, bf16_t* U) {
    const size_t row0 = (size_t)b * SEQ + (size_t)blk * 128;
    { const f32x4 g0 = *(const f32x4*)(A.in[I_C_LNG] + lane * 8), g1 = *(const f32x4*)(A.in[I_C_LNG] + lane * 8 + 4), b0 = *(const f32x4*)(A.in[I_C_LNB] + lane * 8), b1 = *(const f32x4*)(A.in[I_C_LNB] + lane * 8 + 4);
      u32x4 pv[16];
#pragma unroll
      for (int jj = 0; jj < 16; ++jj) pv[jj] = __builtin_nontemporal_load((const u32x4*)(H1 + (row0 + wave * 16 + jj) * H1P + 512 + lane * 8));
#pragma unroll
      for (int jj = 0; jj < 16; ++jj) { const int j = wave * 16 + jj; const u32x4 p = pv[jj];
        f32x4 v0 = (f32x4){bflo(p.x), bfhi(p.x), bflo(p.y), bfhi(p.y)}, v1 = (f32x4){bflo(p.z), bfhi(p.z), bflo(p.w), bfhi(p.w)};
        const float mean = wave_sum((v0[0] + v0[1]) + (v0[2] + v0[3]) + (v1[0] + v1[1]) + (v1[2] + v1[3])) * (1.f / 512.f);
        v0 = v0 - mean; v1 = v1 - mean;
        const float var = wave_sum((v0[0] * v0[0] + v0[1] * v0[1]) + (v0[2] * v0[2] + v0[3] * v0[3]) + (v1[0] * v1[0] + v1[1] * v1[1]) + (v1[2] * v1[2] + v1[3] * v1[3])) * (1.f / 512.f);
        const float rstd = 1.0f / sqrtf(var + LN_EPS);
        v0 = v0 * rstd * g0 + b0; v1 = v1 * rstd * g1 + b1;
        *(LAS u32x4*)(lds + j * 1024 + ((lane ^ sgu_sw(j)) << 4)) = pg8::pack8(v0, v1); } }
    __syncthreads();
    { const int h = wave, fr = lane & 15, fq = lane >> 4, q = fr >> 2, p = fr & 3;
      const bf16_t* Wm = (const bf16_t*)(A.ws + WS_SGUW) + (size_t)h * 128 * 128 + (size_t)fr * 128 + 8 * fq;
      const bf16_t* Up = H1 + (row0 + fr) * H1P + h * 64 + 16 * fq;
      constexpr int DIST = 2, NSET = DIST + 1;
      bf16x8 wf[NSET][4]; u32x4 uu[NSET][2]; float bs[8];
#define SGU_LOAD(it_) do { _Pragma("unroll") for (int kk = 0; kk < 4; ++kk) if (kk < ((it_) < 4 ? 2 : 4)) wf[(it_) % NSET][kk] = *(const bf16x8*)(Wm + (size_t)(16 * (it_)) * 128 + 32 * kk); \
        _Pragma("unroll") for (int c2 = 0; c2 < 2; ++c2) uu[(it_) % NSET][c2] = *(const u32x4*)(Up + (size_t)(16 * (it_)) * H1P + 8 * c2); } while (0)
#pragma unroll
      for (int it = 0; it < 8; ++it) bs[it] = A.in[I_C_WSB][h * 128 + 16 * it + fr];
#pragma unroll
      for (int it = 0; it < DIST; ++it) SGU_LOAD(it);
#pragma unroll
      for (int it = 0; it < 8; ++it) { const int nk = it < 4 ? 2 : 4;
        if (it + DIST < 8) SGU_LOAD(it + DIST);
        f32x4 acc[4];
#pragma unroll
        for (int ct = 0; ct < 4; ++ct) acc[ct] = (f32x4){0.f, 0.f, 0.f, 0.f};
#pragma unroll
        for (int kk = 0; kk < 4; ++kk) if (kk < nk) {
#pragma unroll
            for (int ct = 0; ct < 4; ++ct) { const int col = h * 64 + 16 * p + 4 * ct; const int r0 = 32 * kk + 8 * fq + q, r1 = r0 + 4;
                const s16x4 lo = tr16(lds + r0 * 1024 + (((col >> 3) ^ sgu_sw(r0)) << 4) + (col & 7) * 2), hi = tr16(lds + r1 * 1024 + (((col >> 3) ^ sgu_sw(r1)) << 4) + (col & 7) * 2);
                const bf16x8 vf = (bf16x8){lo[0], lo[1], lo[2], lo[3], hi[0], hi[1], hi[2], hi[3]};
                acc[ct] = __builtin_amdgcn_mfma_f32_16x16x32_bf16(vf, wf[it % NSET][kk], acc[ct], 0, 0, 0); } }
        const int i = 16 * it + fr; const float bias = bs[it];
#pragma unroll
        for (int c2 = 0; c2 < 2; ++c2) { const int c = h * 64 + 16 * fq + 8 * c2; const u32x4 u4 = uu[it % NSET][c2]; const f32x4 a0 = acc[2 * c2], a1 = acc[2 * c2 + 1];
            const float o0 = bflo(u4.x) * (a0[0] + bias), o1 = bfhi(u4.x) * (a0[1] + bias), o2 = bflo(u4.y) * (a0[2] + bias), o3 = bfhi(u4.y) * (a0[3] + bias);
            const float o4 = bflo(u4.z) * (a1[0] + bias), o5 = bfhi(u4.z) * (a1[1] + bias), o6 = bflo(u4.w) * (a1[2] + bias), o7 = bfhi(u4.w) * (a1[3] + bias);
            *(u32x4*)(U + (row0 + i) * DM + c) = (u32x4){cvt_pk_bf16(o0, o1), cvt_pk_bf16(o2, o3), cvt_pk_bf16(o4, o5), cvt_pk_bf16(o6, o7)}; } }
#undef SGU_LOAD
    }
    __syncthreads();
}
__device__ __forceinline__ int crow(int r, int hi) { return (r & 3) + 8 * (r >> 2) + 4 * hi; }
__device__ __forceinline__ void attn_units(const Args& A, LAS unsigned char* lds, int wave, int lane, int tid, int b, int h, int par, int nunits, const bf16_t* H1, bf16_t* U) {
    LAS unsigned char* Kb = lds; LAS unsigned char* Vb = lds + 16384; LAS float* biasL = (LAS float*)(lds + 32768);
    LAS float* wsf = (LAS float*)(lds + 36864) + wave * 64; LAS unsigned char* stg = lds + 40960 + wave * 4096;
    const int r32 = lane & 31, hi = lane >> 5;
    const size_t rowb = (size_t)b * SEQ;
    for (int i = tid; i < 513; i += NTHR) biasL[i] = A.in[I_D_REL][h * 513 + i] * LOG2E;
    const bf16_t* qsrc = H1 + (rowb + (wave >> 1) * 64 + (wave & 1) * 32 + r32) * H1P + 1024 + h * 64 + hi * 8;
    const bf16_t* ksrc = H1 + (rowb + lane) * H1P + 1536 + h * 64 + wave * 8;
    const bf16_t* vsrc = H1 + (rowb + 16 * (wave & 3) + (lane >> 2)) * H1P + 2048 + h * 64 + (wave >> 2) * 32 + (lane & 3) * 8;
    const int kdst = wave * 1024 + lane * 16, vdst = wave * 1024 + lane * 16;
    bf16x8 qr[4], qn[4]; u32x4 kreg, vreg;
    { const int cg0 = par, tl0 = 4 * cg0 - 8 > 0 ? 4 * cg0 - 8 : 0;
#pragma unroll
      for (int d0 = 0; d0 < 4; ++d0) qn[d0] = __builtin_nontemporal_load((const bf16x8*)(qsrc + (size_t)cg0 * 256 * H1P + d0 * 16));
      kreg = *(const u32x4*)(ksrc + (size_t)tl0 * 64 * H1P); vreg = *(const u32x4*)(vsrc + (size_t)tl0 * 64 * H1P); }
#pragma unroll 1
    for (int ui = 0; ui < nunits; ++ui) {
    const int cg = 2 * (ui & 3) + par, n0 = 4 * cg, n = n0 + (wave >> 1), qpos0 = n * 64 + (wave & 1) * 32;
    const int t_lo = n0 - 8 > 0 ? n0 - 8 : 0, t_hi = n0 + 3;
    const int cgn = 2 * ((ui + 1) & 3) + par, tln = 4 * cgn - 8 > 0 ? 4 * cgn - 8 : 0; const bool more = ui + 1 < nunits;
#pragma unroll
    for (int d0 = 0; d0 < 4; ++d0) qr[d0] = qn[d0];
    *(LAS u32x4*)(Kb + kdst) = kreg; *(LAS u32x4*)(Vb + vdst) = vreg;
    __syncthreads();
    float mrun = -1.0e30f, lrun = 0.f; f32x16 o[2];
#pragma unroll
    for (int r = 0; r < 16; ++r) { o[0][r] = 0.f; o[1][r] = 0.f; }
    const int vlane = ((lane >> 4) & 1) * 32 + (lane & 3) * 8 + (4 * hi + ((lane & 15) >> 2)) * 64;
#pragma unroll 1
    for (int t = t_lo; t <= t_hi; ++t) {
        const int buf = (t - t_lo) & 1;
        if (t < t_hi) { kreg = *(const u32x4*)(ksrc + (size_t)(t + 1) * 64 * H1P); vreg = *(const u32x4*)(vsrc + (size_t)(t + 1) * 64 * H1P); }
        else if (more) {
#pragma unroll
            for (int d0 = 0; d0 < 4; ++d0) qn[d0] = __builtin_nontemporal_load((const bf16x8*)(qsrc + (size_t)cgn * 256 * H1P + d0 * 16));
            kreg = *(const u32x4*)(ksrc + (size_t)tln * 64 * H1P); vreg = *(const u32x4*)(vsrc + (size_t)tln * 64 * H1P); }
        if (t >= n - 8 && t <= n) {
            const LAS unsigned char* kb = Kb + buf * 8192 + hi * 1024 + r32 * 16;
            f32x16 p0, p1;
#pragma unroll
            for (int r = 0; r < 16; ++r) { p0[r] = 0.f; p1[r] = 0.f; }
#pragma unroll
            for (int d0 = 0; d0 < 4; ++d0) { const bf16x8 b0 = *(const LAS bf16x8*)(kb + d0 * 2048), b1 = *(const LAS bf16x8*)(kb + d0 * 2048 + 512);
                p0 = __builtin_amdgcn_mfma_f32_32x32x16_bf16(b0, qr[d0], p0, 0, 0, 0); p1 = __builtin_amdgcn_mfma_f32_32x32x16_bf16(b1, qr[d0], p1, 0, 0, 0); }
            const int dbase = (qpos0 + r32) - t * 64;
            float rm = -3.0e38f;
#pragma unroll
            for (int r = 0; r < 16; ++r) { const int d0_ = dbase - crow(r, hi), d1_ = d0_ - 32;
                p0[r] += biasL[(d0_ < 256 ? d0_ : 256) + 256]; p1[r] += biasL[(d1_ < 256 ? d1_ : 256) + 256];
                rm = fmaxf(rm, fmaxf(p0[r], p1[r])); }
            rm = fmaxf(rm, __shfl_xor(rm, 32));
            const float mnew = fmaxf(mrun, rm), f = __builtin_amdgcn_exp2f(mrun - mnew); mrun = mnew;
            float ps = 0.f;
#pragma unroll
            for (int r = 0; r < 16; ++r) { p0[r] = __builtin_amdgcn_exp2f(p0[r] - mnew); p1[r] = __builtin_amdgcn_exp2f(p1[r] - mnew); ps += p0[r] + p1[r]; }
            lrun = lrun * f + ps;
            if (hi == 0) wsf[r32] = f;
            bf16x8 pa[4];
#pragma unroll
            for (int ks = 0; ks < 2; ++ks) { u32x4 w0, w1;
                w0.x = cvt_pk_bf16(p0[8 * ks + 0], p0[8 * ks + 1]); w0.y = cvt_pk_bf16(p0[8 * ks + 2], p0[8 * ks + 3]); w0.z = cvt_pk_bf16(p0[8 * ks + 4], p0[8 * ks + 5]); w0.w = cvt_pk_bf16(p0[8 * ks + 6], p0[8 * ks + 7]);
                w1.x = cvt_pk_bf16(p1[8 * ks + 0], p1[8 * ks + 1]); w1.y = cvt_pk_bf16(p1[8 * ks + 2], p1[8 * ks + 3]); w1.z = cvt_pk_bf16(p1[8 * ks + 4], p1[8 * ks + 5]); w1.w = cvt_pk_bf16(p1[8 * ks + 6], p1[8 * ks + 7]);
                pa[ks] = __builtin_bit_cast(bf16x8, w0); pa[2 + ks] = __builtin_bit_cast(bf16x8, w1); }
#pragma unroll
            for (int r = 0; r < 16; ++r) { const float fr_ = wsf[crow(r, hi)]; o[0][r] *= fr_; o[1][r] *= fr_; }
            const LAS unsigned char* vb = Vb + buf * 8192 + vlane;
#pragma unroll
            for (int dh = 0; dh < 2; ++dh)
#pragma unroll
                for (int ks = 0; ks < 4; ++ks) { const s16x4 lo = tr16(vb + dh * 4096 + ks * 1024), hh = tr16(vb + dh * 4096 + ks * 1024 + 512);
                    const bf16x8 vf = (bf16x8){lo[0], lo[1], lo[2], lo[3], hh[0], hh[1], hh[2], hh[3]};
                    o[dh] = __builtin_amdgcn_mfma_f32_32x32x16_bf16(pa[ks], vf, o[dh], 0, 0, 0); }
        }
        if (t < t_hi) { *(LAS u32x4*)(Kb + (buf ^ 1) * 8192 + kdst) = kreg; *(LAS u32x4*)(Vb + (buf ^ 1) * 8192 + vdst) = vreg; }
        __syncthreads();
    }
    lrun += __shfl_xor(lrun, 32);
    if (hi == 0) wsf[32 + r32] = 1.0f / lrun;
    bf16_t* Ow = U + (rowb + qpos0) * DM + 512 + h * 64;
#pragma unroll
    for (int r = 0; r < 16; ++r) { const int q = crow(r, hi); const float rl = wsf[32 + q];
        *(LAS bf16_t*)(stg + q * 128 + r32 * 2) = (bf16_t)f2bf(o[0][r] * rl); *(LAS bf16_t*)(stg + q * 128 + 64 + r32 * 2) = (bf16_t)f2bf(o[1][r] * rl); }
#pragma unroll
    for (int i = 0; i < 4; ++i) { const int row = i * 8 + (lane >> 3), ch = lane & 7; const u32x4 v = *(const LAS u32x4*)(stg + row * 128 + ch * 16); *(u32x4*)(Ow + (size_t)row * DM + ch * 8) = v; }
    __syncthreads();
    }
}

constexpr int NPHASE = 15;
__global__ void __launch_bounds__(NTHR, 2) hybrid_fwd(Args args) {
    extern __shared__ __attribute__((aligned(16))) unsigned char lds_raw[];
    LAS unsigned char* lds = (LAS unsigned char*)lds_raw;
    volatile LAS unsigned* MISC = (volatile LAS unsigned*)(lds + MISC_OFF);
    const int tid = threadIdx.x, lane = tid & 63, wave = __builtin_amdgcn_readfirstlane(tid >> 6);
    const int G = gridDim.x; const int bx = blockIdx.x; const int vcu = (G % 8 == 0) ? (bx % 8) * (G / 8) + bx / 8 : bx;
    unsigned char* ws = args.ws;
    gu32* ctl = (gu32*)(ws + WS_CTL);
    for (int u = tid; u < (LDS_BYTES - LDSCTL_OFF) / 4; u += NTHR) ((LAS unsigned*)(lds + LDSCTL_OFF))[u] = 0u;
    __syncthreads();
    XcdBarrier bar; bar.bar = (unsigned*)(ctl + CW_BAR); bar.x = 0; bar.st = nullptr;
    if (!MK_PER_PHASE) bar = xcd_barrier_post((unsigned*)(ctl + CW_BAR), MISC + 8);
    const int lo = args.ph_lo, hi = args.ph_hi, dblm = args.dbl;
#define IN(k) (lo <= (k) && (k) < hi)
#define DB(k) ((dblm >> (k)) & 1)
#define SEAM(k) do { if (IN(k) && IN((k) + 1)) { xcd_barrier(bar); if (dblm & 0x8000) xcd_barrier(bar); } } while (0)
    bf16_t* XA = (bf16_t*)(ws + WS_XA); bf16_t* X1 = (bf16_t*)(ws + WS_X1); bf16_t* HB = (bf16_t*)(ws + WS_H);
    bf16_t* U = (bf16_t*)args.out; bf16_t* Z = (bf16_t*)args.out + (size_t)M * DM; unsigned char* YB = ws + WS_H + 64 * MiB;
    unsigned* list = (unsigned*)(ws + WS_LIST); float* roww = (float*)(ws + WS_ROWW);

    if (IN(0)) { p0_prologue(args, lds, vcu, G, wave, lane, tid, DB(0)); } SEAM(0);
    LAS float* biasL = (LAS float*)(lds + TBL_OFF + 4096);
    if (IN(1)) { pg8::StaticOrder S; S.init(M, NIN, DM, ws + WS_WIN0, G, bx, DB(1)); pg8::EpiIn0 E{HB, biasL};
        for (int i = tid; i < NIN; i += NTHR) biasL[i] = ((const float*)(ws + WS_BIASP))[i];
        const int pre = MOE_W_IN_P0 ? 0 : (vcu >> 5) % (MOE_W_SA + 1), tot = MOE_W_IN_P0 ? 0 : MOE_W_SA;
        moe_w_steps(args, lds, 0, vcu, wave, lane, 0, pre); __syncthreads();
        pg8::gemm_phase<pg8::EpiIn0, pg8::StaticOrder, true>(lds, (const char*)XA, DM, S, E);
        moe_w_steps(args, lds, 0, vcu, wave, lane, pre, tot); } SEAM(1);
    if (IN(2)) { conv_phase(args, lds, vcu, G, wave, lane, tid, HB, U, DB(2)); } SEAM(2);
    if (IN(3)) { pg8::StaticOrder S; S.init(M, DM, DM, ws + WS_WOUT0, G, bx, DB(3)); pg8::EpiOut<false, SKIP_MIX0> E{Z, (const void*)XA};
        const int pre = MOE_W_IN_P0 ? 0 : (vcu >> 5) % (7 - MOE_W_SA), tot = MOE_W_IN_P0 ? 0 : 6 - MOE_W_SA;
        moe_w_steps(args, lds, 0, vcu, wave, lane, MOE_W_SA, MOE_W_SA + pre); __syncthreads();
        pg8::gemm_phase<pg8::EpiOut<false, SKIP_MIX0>, pg8::StaticOrder, true>(lds, (const char*)U, DM, S, E);
        moe_w_steps(args, lds, 0, vcu, wave, lane, MOE_W_SA + pre, MOE_W_SA + tot);
        if (IN(4)) { __syncthreads(); router_preload(args, lds, tid, 0); } } SEAM(3);
    if (IN(4)) { router_phase(args, lds, vcu, wave, lane, tid, 0, Z, X1, (unsigned*)(ctl + CW_CNT), DB(4), IN(3)); } SEAM(4);
    if (IN(5)) { if (!SKIP_MOE0) { const int T = moe_table(lds, (const unsigned*)(ctl + CW_CNT), tid); LAS unsigned* tb = (LAS unsigned*)(lds + TBL_OFF);
        pg8::MoeOrder<true> S{tb + 64, tb, T, G, vcu, DM / 2, (const char*)(ws + WS_WGU), (size_t)DM * DM, list, DB(5)}; pg8::EpiGU E{(unsigned char*)HB};
        pg8::gemm_phase<pg8::EpiGU, pg8::MoeOrder<true>, true, true>(lds, (const char*)(ws + WS_X1Q), DM / 2, S, E);
        if (MOE_W_SLACK) { const int f = slack_first(T); if (f && vcu >= f) moe_w_ids(args, lds, 1, wave, lane, vcu - f, 256 - f, SLACK_K5); } } } SEAM(5);
    if (IN(6)) { if (!SKIP_MOE0) { LAS unsigned* tb = (LAS unsigned*)(lds + TBL_OFF); const int T = MK_PER_PHASE ? moe_table(lds, (const unsigned*)(ctl + CW_CNT), tid) : (int)tb[32];
        pg8::MoeOrder<false> S{tb + 64, tb, T, G, vcu, DE / 2, (const char*)(ws + WS_WD), (size_t)DM * DE, list, DB(6)}; pg8::EpiDown E{YB, list, roww, (LAS unsigned*)(lds + ROUTER_REC_OFF)};
        pg8::gemm_phase<pg8::EpiDown, pg8::MoeOrder<false>, true, true>(lds, (const char*)HB, DE / 2, S, E);
        if (MOE_W_SLACK) { const int f = slack_first(T); if (f && vcu >= f) moe_w_ids(args, lds, 1, wave, lane, (256 - f) * SLACK_K5 + vcu - f, 256 - f, SLACK_K6); } } } SEAM(6);
    if (IN(7)) { combine_ln_phase<false, SKIP_MOE0>(args, vcu, G, wave, lane, 0, X1, YB, XA, nullptr, DB(7)); } SEAM(7);
    if (IN(8)) { pg8::StaticOrder S; S.init(M, NIN, DM, ws + WS_WIN1, G, bx, DB(8)); pg8::EpiIn1 E{HB, biasL};
        for (int i = tid; i < NIN; i += NTHR) biasL[i] = args.in[I_CD_BIN][i];
        const int T0 = MK_PER_PHASE ? moe_table(lds, (const unsigned*)(ctl + CW_CNT), tid) : (int)((LAS unsigned*)(lds + TBL_OFF))[32];
        const int D = (MOE_W_SLACK && !SKIP_MOE0) ? slack_done(T0) : 0;
        pg8::gemm_phase<pg8::EpiIn1, pg8::StaticOrder, true>(lds, (const char*)XA, DM, S, E);
        moe_w_ids(args, lds, 1, wave, lane, D + vcu, 256, MOE_W_SA); } SEAM(8);
    if (IN(9)) { if (!SKIP_MIX1) {
        for (int un = vcu; un < ((BATCH * 16) << DB(9)); un += G) sgu_unit(args, lds, wave, lane, (un >> 4) & 15, un & 15, HB, U);
        { const int pr = vcu >> 1; if (pr < BATCH * 8) attn_units(args, lds, wave, lane, tid, pr >> 3, pr & 7, vcu & 1, 4 << DB(9), HB, U); } } } SEAM(9);
    if (IN(10)) { pg8::StaticOrder S; S.init(M, DM, DM, ws + WS_WOUT1, G, bx, DB(10)); pg8::EpiOut<false, SKIP_MIX1> E{Z, (const void*)XA};
        const int T0 = MK_PER_PHASE ? moe_table(lds, (const unsigned*)(ctl + CW_CNT), tid) : (int)((LAS unsigned*)(lds + TBL_OFF))[32];
        const int D = (MOE_W_SLACK && !SKIP_MOE0) ? slack_done(T0) : 0;
        pg8::gemm_phase<pg8::EpiOut<false, SKIP_MIX1>, pg8::StaticOrder, true>(lds, (const char*)U, DM, S, E);
        moe_w_ids(args, lds, 1, wave, lane, D + vcu + 256 * MOE_W_SA, 256, 6 - MOE_W_SA);
        if (IN(11)) { __syncthreads(); router_preload(args, lds, tid, 1); } } SEAM(10);
    if (IN(11)) { router_phase(args, lds, vcu, wave, lane, tid, 1, Z, X1, (unsigned*)(ctl + CW_CNT) + 32 * 64, DB(11), IN(10)); } SEAM(11);
    if (IN(12)) { if (!SKIP_MOE1) { const int T = moe_table(lds, (const unsigned*)(ctl + CW_CNT) + 32 * 64, tid); LAS unsigned* tb = (LAS unsigned*)(lds + TBL_OFF);
        pg8::MoeOrder<true> S{tb + 64, tb, T, G, vcu, DM / 2, (const char*)(ws + WS_WGU) + (size_t)NE * DM * DM, (size_t)DM * DM, list, DB(12)}; pg8::EpiGU E{(unsigned char*)HB};
        pg8::gemm_phase<pg8::EpiGU, pg8::MoeOrder<true>, true, true>(lds, (const char*)(ws + WS_X1Q), DM / 2, S, E); } } SEAM(12);
    if (IN(13)) { if (!SKIP_MOE1) { LAS unsigned* tb = (LAS unsigned*)(lds + TBL_OFF); const int T = MK_PER_PHASE ? moe_table(lds, (const unsigned*)(ctl + CW_CNT) + 32 * 64, tid) : (int)tb[32];
        pg8::MoeOrder<false> S{tb + 64, tb, T, G, vcu, DE / 2, (const char*)(ws + WS_WD) + (size_t)NE * DM * DE, (size_t)DM * DE, list, DB(13)}; pg8::EpiDown E{YB, list, roww, (LAS unsigned*)(lds + ROUTER_REC_OFF)};
        pg8::gemm_phase<pg8::EpiDown, pg8::MoeOrder<false>, true, true>(lds, (const char*)HB, DE / 2, S, E); } } SEAM(13);
    if (IN(14)) { combine_ln_phase<true, SKIP_MOE1>(args, vcu, G, wave, lane, 1, X1, YB, nullptr, args.out, 0); }
#undef IN
#undef SEAM
}

extern "C" void kernel_launch(void* const* d_in, const int* in_sizes, int n_in, void* d_out, int out_size, void* d_ws, size_t ws_size, hipStream_t stream) {
    static int grid = 0;
    if (grid == 0) {
        if (n_in != 28 || in_sizes[0] != M * DM || out_size != M * DM || ws_size < WS_END) { fprintf(stderr, "kernel_launch: unexpected shapes / workspace (n_in %d, ws %zu); nothing launched\n", n_in, ws_size); grid = -1; return; }
        int dev = 0, cus = 0;
        if (hipGetDevice(&dev) != hipSuccess || hipDeviceGetAttribute(&cus, hipDeviceAttributeMultiprocessorCount, dev) != hipSuccess) { grid = -1; return; }
        if (hipFuncSetAttribute((const void*)hybrid_fwd, hipFuncAttributeMaxDynamicSharedMemorySize, LDS_BYTES) != hipSuccess) { fprintf(stderr, "kernel_launch: hipFuncSetAttribute failed\n"); grid = -1; return; }
        (void)hipGetLastError();
        grid = cus;
        if (grid != 256) { fprintf(stderr, "kernel_launch: built for 256 CUs, device has %d\n", cus); grid = -1; return; }
    }
    if (grid < 0) return;
    if (hipMemsetAsync((char*)d_ws + WS_CTL, 0, CTL_ZERO_BYTES, stream) != hipSuccess) return;
    Args a{};
    for (int i = 0; i < 28; ++i) a.in[i] = (const float*)d_in[i];
    a.out = (float*)d_out; a.ws = (unsigned char*)d_ws; a.dbl = DBL_MASK;
#if MK_PER_PHASE
    for (int p = 0; p < NPHASE; ++p) { a.ph_lo = p; a.ph_hi = p + 1; hipLaunchKernelGGL(hybrid_fwd, dim3(grid), dim3(NTHR), LDS_BYTES, stream, a); }
#else
    a.ph_lo = 0; a.ph_hi = NPHASE; hipLaunchKernelGGL(hybrid_fwd, dim3(grid), dim3(NTHR), LDS_BYTES, stream, a);
#ifdef EXTRA_PHASE
    a.ph_lo = EXTRA_PHASE; a.ph_hi = EXTRA_PHASE + 1; hipLaunchKernelGGL(hybrid_fwd, dim3(grid), dim3(NTHR), LDS_BYTES, stream, a);
#endif
#endif
}
```

```cpp
#include <hip/hip_runtime.h>
#include <cstdio>
#include <cstdint>

#ifndef MK_PER_PHASE
#define MK_PER_PHASE 0
#endif
#ifndef SKIP_MIX0
#define SKIP_MIX0 0
#endif
#ifndef SKIP_MOE0
#define SKIP_MOE0 0
#endif
#ifndef SKIP_MIX1
#define SKIP_MIX1 0
#endif
#ifndef SKIP_MOE1
#define SKIP_MOE1 0
#endif

#ifndef MOE_W_IN_P0
#define MOE_W_IN_P0 0
#endif
#ifndef MOE_W_SLACK
#define MOE_W_SLACK 1
#endif
#ifndef MOE_W_SA
#define MOE_W_SA 4
#endif
#ifndef DBL_MASK
#define DBL_MASK 0
#endif
#define GAS __attribute__((address_space(1)))
#define LAS __attribute__((address_space(3)))
typedef unsigned short bf16_t;
typedef short bf16x8 __attribute__((ext_vector_type(8)));
typedef short s16x4 __attribute__((ext_vector_type(4)));
typedef float f32x2 __attribute__((ext_vector_type(2)));
typedef float f32x4 __attribute__((ext_vector_type(4)));
typedef float f32x16 __attribute__((ext_vector_type(16)));
typedef unsigned u32x2 __attribute__((ext_vector_type(2)));
typedef unsigned u32x4 __attribute__((ext_vector_type(4)));
typedef GAS unsigned gu32;

constexpr int BATCH = 16, SEQ = 2048, DM = 1024, M = BATCH * SEQ;
constexpr int NIN = 2560;
constexpr int NE = 32, DE = 512, CAP = 32768;
constexpr int H0P = 1536, H1P = 2560;
constexpr float LN_EPS = 1e-5f, ALPHA = 1.4142135623730951f, LOG2E = 1.4426950408889634f;
constexpr float QSCALE = 0.125f * LOG2E;
constexpr int NWAVES = 8, NTHR = 512;

constexpr size_t MiB = 1u << 20;
constexpr size_t WS_CTL = 0, CTL_ZERO_BYTES = 128 * 1024;
constexpr size_t WS_BIASP = 1 * MiB;
constexpr size_t WS_WR = 1 * MiB + 64 * 1024;
constexpr size_t WS_SGUW = 1 * MiB + 512 * 1024;
constexpr size_t WS_LIST = 2 * MiB;
constexpr size_t WS_ROWW = 6 * MiB;
constexpr size_t WS_WIN0 = 10 * MiB, WS_WIN1 = 15 * MiB, WS_WOUT0 = 20 * MiB, WS_WOUT1 = 22 * MiB;
constexpr size_t WS_WGU = 24 * MiB;
constexpr size_t WS_WD = 88 * MiB;
constexpr size_t WS_X1Q = 120 * MiB;
constexpr size_t WS_XA = 216 * MiB;
constexpr size_t WS_X1 = 280 * MiB;
constexpr size_t WS_H = 344 * MiB;
constexpr size_t WS_END = 504 * MiB;

constexpr int CW_TMO = 0, CW_CODE = 1;
constexpr int CW_BAR = 4096;
constexpr int CW_CNT = 16384;
static_assert((size_t)(CW_CNT + 2 * 32 * 64) * 4 <= CTL_ZERO_BYTES && (size_t)(CW_BAR + 3456) * 4 <= CTL_ZERO_BYTES, "control words inside the per-call memset");

constexpr int RING_BYTES = 131072;
constexpr int LDSCTL_OFF = RING_BYTES, MISC_OFF = LDSCTL_OFF + 320;
constexpr int TBL_OFF = RING_BYTES + 1024;
constexpr int ROUTER_REC_OFF = TBL_OFF + 2048;
constexpr int LDS_BYTES = 147456;
static_assert(ROUTER_REC_OFF + 4096 <= 147456 && TBL_OFF + 4096 + 2560 * 4 <= 147456, "LDS map");

#define RLX_AGENT __ATOMIC_RELAXED, __HIP_MEMORY_SCOPE_AGENT
#define LDS_WAIT() asm volatile("s_waitcnt lgkmcnt(0)" ::: "memory")
#define VM_WAIT() asm volatile("s_waitcnt vmcnt(0)" ::: "memory")
__device__ __forceinline__ unsigned f2bf(float f) { unsigned u = __builtin_bit_cast(unsigned, f); return (u + 0x7fffu + ((u >> 16) & 1u)) >> 16; }
__device__ __forceinline__ unsigned pk2(float lo, float hi) { return f2bf(lo) | (f2bf(hi) << 16); }
typedef __bf16 bf16x2_n __attribute__((ext_vector_type(2)));
__device__ __forceinline__ unsigned cvt_pk_bf16(float lo, float hi) { const f32x2 v = {lo, hi}; const bf16x2_n b = __builtin_convertvector(v, bf16x2_n); return __builtin_bit_cast(unsigned, b); }
__device__ __forceinline__ float bflo(unsigned w) { return __uint_as_float(w << 16); }
__device__ __forceinline__ float bfhi(unsigned w) { return __uint_as_float(w & 0xffff0000u); }
template <int CTRL> __device__ __forceinline__ float dpp_f(float v) { return __builtin_bit_cast(float, __builtin_amdgcn_update_dpp(0, __builtin_bit_cast(int, v), CTRL, 0xF, 0xF, true)); }
__device__ __forceinline__ float wave_sum(float v) {
    v += dpp_f<0xB1>(v); v += dpp_f<0x4E>(v); v += dpp_f<0x141>(v); v += dpp_f<0x140>(v);
    const int vi = __builtin_bit_cast(int, v);
    const float s0 = __builtin_bit_cast(float, __builtin_amdgcn_readlane(vi, 0)), s1 = __builtin_bit_cast(float, __builtin_amdgcn_readlane(vi, 16)),
                s2 = __builtin_bit_cast(float, __builtin_amdgcn_readlane(vi, 32)), s3 = __builtin_bit_cast(float, __builtin_amdgcn_readlane(vi, 48));
    return (s0 + s1) + (s2 + s3);
}
typedef int i32x4 __attribute__((ext_vector_type(4)));
typedef int i32x8 __attribute__((ext_vector_type(8)));
constexpr float W8SCALE = 32.0f, W8INV = 1.0f / 32.0f;
__device__ __forceinline__ float clamp8(float v) { return __builtin_fminf(__builtin_fmaxf(v, -448.0f), 448.0f); }
__device__ __forceinline__ unsigned pk4_fp8(float a, float b, float c, float d) { int w = 0; w = __builtin_amdgcn_cvt_pk_fp8_f32(clamp8(a), clamp8(b), w, false); w = __builtin_amdgcn_cvt_pk_fp8_f32(clamp8(c), clamp8(d), w, true); return (unsigned)w; }
__device__ __forceinline__ f32x4 unpk4_fp8(unsigned w) { const f32x2 lo = __builtin_amdgcn_cvt_pk_f32_fp8((int)w, false), hi = __builtin_amdgcn_cvt_pk_f32_fp8((int)w, true); return (f32x4){lo[0], lo[1], hi[0], hi[1]}; }
constexpr float Y8SCALE = 64.0f, Y8INV = 1.0f / 64.0f;
__device__ __forceinline__ float fast_sigmoid(float x) { return __builtin_amdgcn_rcpf(1.0f + __builtin_amdgcn_exp2f(-x * LOG2E)); }

namespace pg8 {
constexpr int BM = 256, BK = 64, HALF = 128, HTB = HALF * BK * 2, STAGE_BYTES = 8 * HTB, NXCD = 8, WGM = 8;
__host__ __device__ __forceinline__ int lds_byte(int r, int c) { const int st = (r >> 4) * 2 + (c >> 5), rr = r & 15, cc = c & 31, ob = rr * 64 + cc * 2; return st * 1024 + (ob ^ (((ob >> 9) & 1) << 5)); }
__host__ __device__ __forceinline__ void stage_rc(int b, int& R, int& C) { const int st = b / 1024, sb = b % 1024, swz = sb ^ (((sb >> 9) & 1) << 5); R = (st >> 1) * 16 + swz / 64; C = (st & 1) * 32 + (swz % 64) / 2; }
__host__ __device__ __forceinline__ int perm32(int rho) { const int n = rho >> 4, i = rho & 15; return 8 * (i >> 2) + 4 * n + (i & 3); }

struct Unit {
    int pm, pn;
    size_t aoff;
    unsigned lbase;
    int nvalid;
    const char* B;
    int slot;
};

struct StaticOrder {
    static constexpr bool GATHER = false;
    int nM, nN, nwg, G, c, K, dsh; const char* Bt; const unsigned* list;
    __device__ void init(int Mrows, int N, int K_, const void* Bt_, int G_, int c_, int dsh_) { nM = Mrows / BM; nN = N / BM; nwg = nM * nN; G = G_; c = c_; K = K_; Bt = (const char*)Bt_; list = nullptr; dsh = dsh_; }
    __device__ __forceinline__ bool next(int i, Unit& u) const {
        const int nmine = (nwg - c + G - 1) / G; if (i >= (nmine << dsh)) return false; const long L = (long)(i >= nmine ? i - nmine : i) * G + c;
        int wgid = (int)L; { const int q = nwg / NXCD, r = nwg % NXCD, xcd = wgid % NXCD, off = wgid / NXCD; wgid = (xcd < r ? xcd * (q + 1) : r * (q + 1) + (xcd - r) * q) + off; }
        const int nig = WGM * nN, gid = wgid / nig, fm = gid * WGM, gsz = (nM - fm) < WGM ? (nM - fm) : WGM;
        u.pm = fm + ((wgid % nig) % gsz); u.pn = (wgid % nig) / gsz;
        u.aoff = (size_t)u.pm * BM * K * 2; u.B = Bt + (size_t)u.pn * BM * K * 2; u.lbase = 0; u.nvalid = BM; return true;
    }
};
template <bool GATHER_> struct MoeOrder {
    static constexpr bool GATHER = GATHER_;
    const LAS unsigned* tinfo; const LAS unsigned* cntl; int ntiles, G, c, K; const char* Bbase; size_t per_expert; const unsigned* list; int dsh;
    __device__ __forceinline__ bool next(int i, Unit& u) const {
        const int nmine = (ntiles * 4 - c + G - 1) / G; if (i >= (nmine << dsh)) return false; const int L = (i >= nmine ? i - nmine : i) * G + c;
        const int tile = L >> 2; const unsigned ti = tinfo[tile]; const int e = (int)(ti >> 16), mt = (int)(ti & 0xffffu);
        u.pm = tile; u.pn = L & 3; u.aoff = (size_t)tile * BM * K * 2; u.lbase = (unsigned)(e * CAP + mt * BM);
        const int left = (int)cntl[e] - mt * BM; u.nvalid = left < BM ? left : BM;
        u.B = Bbase + (size_t)e * per_expert + (size_t)u.pn * BM * K * 2; return true;
    }
};

#define PG8_EPI_ARGS const f32x4 (&acc)[2][2][4][2], const Unit& u, int wr, int wc, int fr, int fq

template <class Epi, class Sched, bool ALIGN_EPI, bool F8 = false>
__device__ __forceinline__ void gemm_phase(LAS unsigned char* lds, const char* Abase, const int K, const Sched& S, const Epi& E) {
    const int tid = threadIdx.x, wid = __builtin_amdgcn_readfirstlane(tid >> 6), lane = tid & 63, wr = wid >> 2, wc = wid & 3, fr = lane & 15, fq = lane >> 4;
    const int nt = K / BK;
    unsigned voffA[2], voffB[2]; int RA[2]; unsigned CA2[2];
#pragma unroll
    for (int i = 0; i < 2; ++i) { int R, C; stage_rc(tid * 16 + i * 8192, R, C);
        const int Rb = Epi::BJ8 ? (64 * (R >> 5) + 16 * ((R & 15) >> 2) + 4 * ((R >> 4) & 1) + (R & 3)) : Epi::PERM ? ((R & ~31) + perm32(R & 31)) : R;
        voffA[i] = (unsigned)(R * K + C) * 2u; voffB[i] = (unsigned)(Rb * K + C) * 2u; RA[i] = R; CA2[i] = (unsigned)C * 2u; }
    const size_t kstep = (size_t)(BK * 2);
    const size_t hstep = (size_t)HALF * K * 2, hstepB = Epi::BJ8 ? (size_t)8 * K * 2 : hstep;
    const unsigned ldsw = (unsigned)wid * 1024u;
    const int c8 = (fq >> 1) * 32 + fq * 8;
    const int aoff = F8 ? lds_byte(wr * 64 + fr, c8) : lds_byte(wr * 64 + fr, fq * 8), boff = F8 ? lds_byte(wc * 32 + fr, c8) : lds_byte(wc * 32 + fr, fq * 8);
    const int aoffh = aoff ^ 32, boffh = boff ^ 32;

#define PG8_SA(b, h) (((b) * 2 + (h)) * HTB)
#define PG8_SB(b, h) ((4 + (b) * 2 + (h)) * HTB)
#define PG8_STAGE(bufoff, gbase, voff) do { _Pragma("unroll") for (int _i = 0; _i < 2; ++_i) \
        __builtin_amdgcn_global_load_lds((const unsigned*)((const char*)(gbase) + (voff)[_i]), (LAS unsigned*)(lds + (bufoff) + ldsw + _i * 8192), 16, 0, 0); } while (0)
#define PG8_STAGE_A(bufoff, h, pd, go, kb) do { if constexpr (Sched::GATHER) { PG8_STAGE(bufoff, Abase + (kb), go[h]); } else { PG8_STAGE(bufoff, (pd) + (h) * hstep, voffA); } } while (0)
#define PG8_LDA(dst, b, h) do { if constexpr (F8) { _Pragma("unroll") for (int m = 0; m < 4; ++m) { dst##8[m].lo = *(const LAS i32x4*)(lds + PG8_SA(b, h) + aoff + m * 2048); dst##8[m].hi = *(const LAS i32x4*)(lds + PG8_SA(b, h) + aoffh + m * 2048); } } \
        else { _Pragma("unroll") for (int m = 0; m < 4; ++m) _Pragma("unroll") for (int k = 0; k < 2; ++k) dst[m][k] = *(const LAS bf16x8*)(lds + PG8_SA(b, h) + aoff + m * 2048 + k * 1024); } } while (0)
#define PG8_LDB(dst, b, h) do { if constexpr (F8) { _Pragma("unroll") for (int n = 0; n < 2; ++n) { dst##8[n].lo = *(const LAS i32x4*)(lds + PG8_SB(b, h) + boff + n * 2048); dst##8[n].hi = *(const LAS i32x4*)(lds + PG8_SB(b, h) + boffh + n * 2048); } } \
        else { _Pragma("unroll") for (int n = 0; n < 2; ++n) _Pragma("unroll") for (int k = 0; k < 2; ++k) dst[n][k] = *(const LAS bf16x8*)(lds + PG8_SB(b, h) + boff + n * 2048 + k * 1024); } } while (0)
#define PG8_MMA(ai, bj, At, Bt) do { __builtin_amdgcn_s_setprio(1); if constexpr (F8) { _Pragma("unroll") for (int m = 0; m < 4; ++m) _Pragma("unroll") for (int n = 0; n < 2; ++n) \
        asm volatile("v_mfma_scale_f32_16x16x128_f8f6f4 %0, %1, %2, %0, %3, %3 op_sel_hi:[0,0,0]" : "+v"(acc[ai][bj][m][n]) : "v"(Bt##8[n]), "v"(At##8[m]), "v"(sc8)); } else { \
        _Pragma("unroll") for (int m = 0; m < 4; ++m) _Pragma("unroll") for (int n = 0; n < 2; ++n) _Pragma("unroll") for (int k = 0; k < 2; ++k) \
        acc[ai][bj][m][n] = __builtin_amdgcn_mfma_f32_16x16x32_bf16(Bt[n][k], At[m][k], acc[ai][bj][m][n], 0, 0, 0); } __builtin_amdgcn_s_setprio(0); } while (0)
#define PG8_WAIT_V(n) asm volatile("s_waitcnt vmcnt(" #n ")" ::: "memory")
#define PG8_WAIT_L(n) asm volatile("s_waitcnt lgkmcnt(" #n ")" ::: "memory")
#define PG8_BAR __builtin_amdgcn_s_barrier()
#define PG8_SCHED __builtin_amdgcn_sched_barrier(0)
#define PG8_GOFF(dst, uu) do { _Pragma("unroll") for (int _h = 0; _h < 2; ++_h) _Pragma("unroll") for (int _i = 0; _i < 2; ++_i) { \
        int _r = _h * HALF + RA[_i]; _r = _r < (uu).nvalid ? _r : 0; const unsigned _e = S.list[(uu).lbase + _r]; dst[_h][_i] = (_e >> 1) * (unsigned)(K * 2) + CA2[_i]; } } while (0)
    Unit cur, nxt; int ui = 0;
    if (!S.next(0, cur)) return;
    f32x4 acc[2][2][4][2];
#pragma unroll
    for (int a = 0; a < 2; ++a)
#pragma unroll
        for (int b = 0; b < 2; ++b)
#pragma unroll
            for (int m = 0; m < 4; ++m)
#pragma unroll
                for (int n = 0; n < 2; ++n) { acc[a][b][m][n] = (f32x4){0.f, 0.f, 0.f, 0.f}; }
    bf16x8 At[4][2], B0[2][2], B1[2][2];
    i32x8 At8[4], B08[2], B18[2];
    int sc8 = 0x7F7F7F7F; asm volatile("" : "+v"(sc8));
    unsigned goff[2][2] = {{0u, 0u}, {0u, 0u}}, goffn[2][2] = {{0u, 0u}, {0u, 0u}}, eraw[2][2] = {{0u, 0u}, {0u, 0u}};
#define PG8_ERAW(dst, uu) do { _Pragma("unroll") for (int _h = 0; _h < 2; ++_h) _Pragma("unroll") for (int _i = 0; _i < 2; ++_i) { \
        int _r = _h * HALF + RA[_i]; _r = _r < (uu).nvalid ? _r : 0; dst[_h][_i] = S.list[(uu).lbase + _r]; } } while (0)
#define PG8_ECONV(dst, src) do { _Pragma("unroll") for (int _h = 0; _h < 2; ++_h) _Pragma("unroll") for (int _i = 0; _i < 2; ++_i) dst[_h][_i] = (src[_h][_i] >> 1) * (unsigned)(K * 2) + CA2[_i]; } while (0)
    LAS unsigned* lrow = (LAS unsigned*)(lds + ROUTER_REC_OFF);
    if constexpr (Sched::GATHER) { PG8_ERAW(eraw, cur); PG8_ECONV(goff, eraw); }
    const char* cA = Abase + cur.aoff; const char* cB = cur.B;
    cur.slot = 0; E.stage(cur, wid, lane);
    PG8_STAGE(PG8_SB(0, 0), cB, voffB); PG8_STAGE(PG8_SB(0, 1), cB + hstepB, voffB); PG8_STAGE_A(PG8_SA(0, 0), 0, cA, goff, 0); PG8_STAGE_A(PG8_SA(0, 1), 1, cA, goff, 0);
    if (wr == 1) PG8_BAR;
    PG8_WAIT_V(2); PG8_BAR;
    PG8_STAGE(PG8_SB(1, 0), cB + kstep, voffB); PG8_STAGE_A(PG8_SA(1, 0), 0, cA + kstep, goff, kstep); PG8_STAGE(PG8_SB(1, 1), cB + hstepB + kstep, voffB);
    PG8_WAIT_V(6); PG8_BAR;
    for (;;) {
        const bool has_next = S.next(ui + 1, nxt);
        const char* nA = has_next ? Abase + nxt.aoff : cA; const char* nB = has_next ? nxt.B : cB;
        if constexpr (Sched::GATHER) { if (has_next && wid < 4) __builtin_amdgcn_global_load_lds((const unsigned*)(S.list + nxt.lbase + wid * 64 + lane), (LAS unsigned*)(lrow + wid * 64), 4, 0, 0); }
#pragma unroll 1
        for (int t = 0; t < nt; t += 2) {
            const bool last = (t == nt - 2);
            const char* a1 = cA + (size_t)(t + 1) * kstep;
            const char* a2 = last ? nA : cA + (size_t)(t + 2) * kstep; const char* b2 = last ? nB : cB + (size_t)(t + 2) * kstep;
            const char* a3 = a2 + kstep; const char* b3 = b2 + kstep;
            const size_t k1 = (size_t)(t + 1) * kstep, k2 = last ? (size_t)0 : (size_t)(t + 2) * kstep, k3 = k2 + kstep;
            if constexpr (Sched::GATHER) { if (last) {
                if (has_next) { unsigned et[2][2];
#pragma unroll
                    for (int h = 0; h < 2; ++h)
#pragma unroll
                        for (int i = 0; i < 2; ++i) { int r = h * HALF + RA[i]; r = r < nxt.nvalid ? r : 0; asm volatile("" : "+v"(r)); et[h][i] = lrow[r]; }
                    PG8_ECONV(goffn, et); }
                else {
#pragma unroll
                    for (int h = 0; h < 2; ++h) { goffn[h][0] = goff[h][0]; goffn[h][1] = goff[h][1]; } } } }
            unsigned gsel[2][2];
#pragma unroll
            for (int h = 0; h < 2; ++h) { gsel[h][0] = last ? goffn[h][0] : goff[h][0]; gsel[h][1] = last ? goffn[h][1] : goff[h][1]; }
            PG8_LDB(B0, 0, 0); PG8_LDB(B1, 0, 1); PG8_SCHED; PG8_LDA(At, 0, 0); PG8_STAGE_A(PG8_SA(1, 1), 1, a1, goff, k1);
            PG8_WAIT_V(8); PG8_WAIT_L(0); PG8_BAR; PG8_MMA(0, 0, At, B0); PG8_MMA(0, 1, At, B1); PG8_BAR; PG8_SCHED;
            PG8_LDA(At, 0, 1); PG8_STAGE(PG8_SB(0, 0), b2, voffB); PG8_STAGE(PG8_SB(0, 1), b2 + hstepB, voffB); PG8_STAGE_A(PG8_SA(0, 0), 0, a2, gsel, k2);
            PG8_WAIT_V(8); PG8_WAIT_L(0); PG8_BAR; PG8_MMA(1, 0, At, B0); PG8_MMA(1, 1, At, B1); PG8_BAR; PG8_SCHED;
            PG8_LDB(B0, 1, 0); PG8_LDB(B1, 1, 1); PG8_SCHED; PG8_LDA(At, 1, 0); PG8_STAGE_A(PG8_SA(0, 1), 1, a2, gsel, k2);
            PG8_WAIT_V(8); PG8_WAIT_L(0); PG8_BAR; PG8_MMA(0, 0, At, B0); PG8_MMA(0, 1, At, B1); PG8_BAR; PG8_SCHED;
            PG8_LDA(At, 1, 1); PG8_STAGE(PG8_SB(1, 0), b3, voffB); PG8_STAGE(PG8_SB(1, 1), b3 + hstepB, voffB); PG8_STAGE_A(PG8_SA(1, 0), 0, a3, gsel, k3);
            PG8_WAIT_V(8); PG8_WAIT_L(0); PG8_BAR; PG8_MMA(1, 0, At, B0); PG8_MMA(1, 1, At, B1); PG8_BAR; PG8_SCHED;
        }
        if constexpr (ALIGN_EPI) { if (wr == 0) PG8_BAR; }
        if constexpr (F8) asm volatile("s_nop 15\n\ts_nop 15" ::: "memory");
        E(acc, cur, wr, wc, fr, fq);
        if (!has_next) break;
#pragma unroll
        for (int a = 0; a < 2; ++a)
#pragma unroll
            for (int b = 0; b < 2; ++b)
#pragma unroll
                for (int m = 0; m < 4; ++m)
#pragma unroll
                    for (int n = 0; n < 2; ++n) { acc[a][b][m][n] = (f32x4){0.f, 0.f, 0.f, 0.f}; }
        cur = nxt; cA = nA; cB = nB; ++ui;
        cur.slot = ui & 1; E.stage(cur, wid, lane);
#pragma unroll
        for (int h = 0; h < 2; ++h) { goff[h][0] = goffn[h][0]; goff[h][1] = goffn[h][1]; }
        if constexpr (ALIGN_EPI) { if (wr == 1) PG8_BAR; }
    }
    PG8_WAIT_V(0);
    if constexpr (!ALIGN_EPI) { if (wr == 0) PG8_BAR; }
    PG8_BAR;
#undef PG8_SA
#undef PG8_SB
#undef PG8_STAGE
#undef PG8_STAGE_A
#undef PG8_LDA
#undef PG8_LDB
#undef PG8_MMA
#undef PG8_WAIT_V
#undef PG8_WAIT_L
#undef PG8_BAR
#undef PG8_SCHED
#undef PG8_GOFF
#undef PG8_ERAW
#undef PG8_ECONV
}

__device__ __forceinline__ u32x4 pack8(const f32x4 v0, const f32x4 v1) { u32x4 w; w.x = cvt_pk_bf16(v0[0], v0[1]); w.y = cvt_pk_bf16(v0[2], v0[3]); w.z = cvt_pk_bf16(v1[0], v1[1]); w.w = cvt_pk_bf16(v1[2], v1[3]); return w; }
__device__ __forceinline__ f32x4 sigm4(const f32x4 g) { return (f32x4){fast_sigmoid(g[0]), fast_sigmoid(g[1]), fast_sigmoid(g[2]), fast_sigmoid(g[3])}; }

struct EpiIn0 {
    static constexpr bool PERM = true, BJ8 = false;
    bf16_t* H; const LAS float* biasp;
    __device__ __forceinline__ void stage(const Unit&, int, int) const {}
    __device__ __forceinline__ void operator()(PG8_EPI_ARGS) const {
        const int row0 = u.pm * BM + wr * 64 + fr, cin = wc * 32 + 8 * fq, pn = u.pn;
        f32x4 bv[2][2];
#pragma unroll
        for (int bj = 0; bj < 2; ++bj)
#pragma unroll
            for (int n = 0; n < 2; ++n) bv[bj][n] = *(const LAS f32x4*)(biasp + pn * BM + bj * HALF + cin + 4 * n);
        if (pn == 4 || pn == 5) {
            const int oc = 512 + (pn - 4) * 256 + cin;
#pragma unroll
            for (int ai = 0; ai < 2; ++ai)
#pragma unroll
                for (int m = 0; m < 4; ++m) { bf16_t* rowp = H + (size_t)(row0 + ai * HALF + m * 16) * H0P + oc;
#pragma unroll
                    for (int bj = 0; bj < 2; ++bj) *(u32x4*)(rowp + bj * HALF) = pack8(acc[ai][bj][m][0] + bv[bj][0], acc[ai][bj][m][1] + bv[bj][1]); }
        } else {
            const bool glu = pn < 4; const int oc = glu ? pn * 128 + cin : 1024 + (pn - 6) * 128 + cin;
#pragma unroll
            for (int ai = 0; ai < 2; ++ai)
#pragma unroll
                for (int m = 0; m < 4; ++m) { bf16_t* rowp = H + (size_t)(row0 + ai * HALF + m * 16) * H0P + oc;
                    const f32x4 a0 = acc[ai][0][m][0] + bv[0][0], a1 = acc[ai][0][m][1] + bv[0][1]; f32x4 g0 = acc[ai][1][m][0] + bv[1][0], g1 = acc[ai][1][m][1] + bv[1][1];
                    if (glu) { g0 = sigm4(g0); g1 = sigm4(g1); }
                    *(u32x4*)rowp = pack8(a0 * g0, a1 * g1); }
        }
    }
};
struct EpiIn1 {
    static constexpr bool PERM = true, BJ8 = true;
    bf16_t* H; const LAS float* bias;
    __device__ __forceinline__ void stage(const Unit&, int, int) const {}
    __device__ __forceinline__ void operator()(PG8_EPI_ARGS) const {
        const int row0 = u.pm * BM + wr * 64 + fr, col0 = u.pn * BM + wc * 64 + 16 * fq; const float sc = (u.pn == 4 || u.pn == 5) ? QSCALE : 1.0f;
        f32x4 bv[2][2];
#pragma unroll
        for (int bj = 0; bj < 2; ++bj)
#pragma unroll
            for (int n = 0; n < 2; ++n) bv[bj][n] = *(const LAS f32x4*)(bias + col0 + bj * 8 + 4 * n);
#pragma unroll
        for (int ai = 0; ai < 2; ++ai)
#pragma unroll
            for (int m = 0; m < 4; ++m) { bf16_t* rowp = H + (size_t)(row0 + ai * HALF + m * 16) * H1P + col0;
#pragma unroll
                for (int bj = 0; bj < 2; ++bj) *(u32x4*)(rowp + bj * 8) = pack8((acc[ai][bj][m][0] + bv[bj][0]) * sc, (acc[ai][bj][m][1] + bv[bj][1]) * sc); }
    }
};
template <bool RESF32, bool SKIPMIX> struct EpiOut {
    static constexpr bool PERM = true, BJ8 = true;
    bf16_t* Z; const void* res;
    __device__ __forceinline__ void stage(const Unit&, int, int) const {}
    __device__ __forceinline__ void operator()(PG8_EPI_ARGS) const {
        static_assert(!RESF32, "bf16 residual only");
        const int row0 = u.pm * BM + wr * 64 + fr, col0 = u.pn * BM + wc * 64 + 16 * fq;
        u32x4 w[2][4][2];
#pragma unroll
        for (int ai = 0; ai < 2; ++ai)
#pragma unroll
            for (int m = 0; m < 4; ++m)
#pragma unroll
                for (int bj = 0; bj < 2; ++bj) w[ai][m][bj] = __builtin_nontemporal_load((const u32x4*)((const bf16_t*)res + (size_t)(row0 + ai * HALF + m * 16) * DM + col0 + bj * 8));
#pragma unroll
        for (int ai = 0; ai < 2; ++ai)
#pragma unroll
            for (int m = 0; m < 4; ++m)
#pragma unroll
                for (int bj = 0; bj < 2; ++bj) { const size_t off = (size_t)(row0 + ai * HALF + m * 16) * DM + col0 + bj * 8; const u32x4 ww = w[ai][m][bj];
                    const f32x4 r0 = (f32x4){bflo(ww.x), bfhi(ww.x), bflo(ww.y), bfhi(ww.y)}, r1 = (f32x4){bflo(ww.z), bfhi(ww.z), bflo(ww.w), bfhi(ww.w)};
                    f32x4 v0 = r0 * ALPHA, v1 = r1 * ALPHA; if (!SKIPMIX) { v0 += acc[ai][bj][m][0]; v1 += acc[ai][bj][m][1]; }
                    *(u32x4*)(Z + off) = pack8(v0, v1); }
    }
};
struct EpiGU {
    static constexpr bool PERM = true, BJ8 = false;
    unsigned char* HH;
    __device__ __forceinline__ void stage(const Unit&, int, int) const {}
    __device__ __forceinline__ void operator()(PG8_EPI_ARGS) const {
        const int row0 = u.pm * BM + wr * 64 + fr, oc = u.pn * 128 + wc * 32 + 8 * fq;
#pragma unroll
        for (int ai = 0; ai < 2; ++ai)
#pragma unroll
            for (int m = 0; m < 4; ++m) { unsigned char* rowp = HH + (size_t)(row0 + ai * HALF + m * 16) * DE + oc;
                const f32x4 g0 = acc[ai][0][m][0] * W8INV, g1 = acc[ai][0][m][1] * W8INV;
                const f32x4 h0 = g0 * sigm4(g0) * (acc[ai][1][m][0] * W8INV), h1 = g1 * sigm4(g1) * (acc[ai][1][m][1] * W8INV);
                *(u32x2*)rowp = (u32x2){pk4_fp8(h0[0], h0[1], h0[2], h0[3]), pk4_fp8(h1[0], h1[1], h1[2], h1[3])}; }
    }
};
struct EpiDown {
    static constexpr bool PERM = true, BJ8 = true;
    unsigned char* YB; const unsigned* list; const float* roww; LAS unsigned* lrow;
    __device__ __forceinline__ void stage(const Unit& u, int wid, int lane) const {
        const unsigned* src = (wid < 4 ? list : (const unsigned*)roww) + u.lbase + (wid & 3) * 64;
        __builtin_amdgcn_global_load_lds((const unsigned*)(src + lane), (LAS unsigned*)(lrow + u.slot * 512 + wid * 64), 4, 0, 0);
    }
    __device__ __forceinline__ void operator()(PG8_EPI_ARGS) const {
        const int col0 = u.pn * BM + wc * 64 + 16 * fq;
#pragma unroll
        for (int ai = 0; ai < 2; ++ai)
#pragma unroll
            for (int m = 0; m < 4; ++m) { const int r = ai * HALF + wr * 64 + m * 16 + fr;
                if (r < u.nvalid) { const unsigned e = lrow[u.slot * 512 + r]; const float w = __uint_as_float(lrow[u.slot * 512 + 256 + r]) * (W8INV * Y8SCALE); unsigned char* rowp = YB + (size_t)e * DM + col0;
                    const f32x4 v0 = acc[ai][0][m][0] * w, v1 = acc[ai][0][m][1] * w, v2 = acc[ai][1][m][0] * w, v3 = acc[ai][1][m][1] * w;
                    *(u32x4*)rowp = (u32x4){pk4_fp8(v0[0], v0[1], v0[2], v0[3]), pk4_fp8(v1[0], v1[1], v1[2], v1[3]), pk4_fp8(v2[0], v2[1], v2[2], v2[3]), pk4_fp8(v3[0], v3[1], v3[2], v3[3])}; } }
    }
};
}

#define XB_TMO      128
#define XB_XCNT(j)  (256  + 64 * (j))
#define XB_XSUB(j)  (1280 + 64 * (j))
#define XB_XGEN(j)  (2304 + 64 * (j))
#define XB_TOP      3328
#define XB_TOPGEN   3392
#define XCD_BAR_WORDS 3456
#define XB_SPIN_CAP (1u << 18)
__device__ __forceinline__ unsigned xb_ld(unsigned* p)              { return __hip_atomic_load(p, __ATOMIC_RELAXED, __HIP_MEMORY_SCOPE_AGENT); }
__device__ __forceinline__ unsigned xb_add(unsigned* p, unsigned v) { return __hip_atomic_fetch_add(p, v, __ATOMIC_RELAXED, __HIP_MEMORY_SCOPE_AGENT); }
__device__ __forceinline__ unsigned xb_xcc_id() { return (unsigned)__builtin_amdgcn_s_getreg((3 << 11) | 20) & 0xFu; }
#define XB_SPIN(cond, bar) do { unsigned _sp = 0; while (cond) { __builtin_amdgcn_s_sleep(1); \
    if ((++_sp & 255u) == 0u) { if (xb_ld(&(bar)[XB_TMO])) break; if (_sp > XB_SPIN_CAP) { atomicAdd(&(bar)[XB_TMO], 1u); break; } } } } while (0)
struct XcdBarrier { unsigned* bar; unsigned x; volatile LAS unsigned* st; };
__device__ __forceinline__ XcdBarrier xcd_barrier_post(unsigned* bar, volatile LAS unsigned* st) {
    XcdBarrier b; b.bar = bar; b.x = xb_xcc_id(); b.st = st;
    if (threadIdx.x == 0) (void)xb_add(&bar[XB_XCNT(b.x)], 1u);
    return b;
}
__device__ __forceinline__ void xcd_barrier_complete(unsigned* bar, unsigned x, unsigned& nloc, unsigned& nx) {
    const unsigned G = gridDim.x * gridDim.y * gridDim.z;
    unsigned sum, cnt, mine, sp = 0u;
    for (;;) {
        sum = 0u; cnt = 0u; mine = 0u;
#pragma unroll
        for (unsigned j = 0; j < 16; ++j) { const unsigned c = xb_ld(&bar[XB_XCNT(j)]); sum += c; cnt += (c > 0u) ? 1u : 0u; mine = (j == x) ? c : mine; }
        if (sum == G) break;
        __builtin_amdgcn_s_sleep(1);
        if ((++sp & 255u) == 0u) { if (xb_ld(&bar[XB_TMO])) break; if (sp > XB_SPIN_CAP) { atomicAdd(&bar[XB_TMO], 1u); break; } }
    }
    nloc = mine > 0u ? mine : 1u; nx = cnt > 0u ? cnt : 1u;
}
__device__ __forceinline__ void xcd_barrier(const XcdBarrier& b) {
    asm volatile("s_waitcnt vmcnt(0)" ::: "memory");
    __syncthreads();
    if (threadIdx.x == 0) {
        unsigned* bar = b.bar;
        __builtin_amdgcn_s_waitcnt(0);
        unsigned nloc = b.st[0], nx = b.st[1];
        if (nloc == 0u) { xcd_barrier_complete(bar, b.x, nloc, nx); b.st[0] = nloc; b.st[1] = nx; }
        const unsigned old = xb_add(&bar[XB_XSUB(b.x)], 1u);
        const unsigned gen = old / nloc;
        if (old + 1u == (gen + 1u) * nloc) {
            __builtin_amdgcn_fence(__ATOMIC_RELEASE, "agent");
            asm volatile("s_waitcnt vmcnt(0)" ::: "memory");
            const unsigned og = xb_add(&bar[XB_TOP], 1u);
            const unsigned tg = og / nx;
            if (og + 1u == (tg + 1u) * nx) xb_add(&bar[XB_TOPGEN], 1u);
            else XB_SPIN(xb_ld(&bar[XB_TOPGEN]) == tg, bar);
            __builtin_amdgcn_fence(__ATOMIC_ACQUIRE, "agent");
            xb_add(&bar[XB_XGEN(b.x)], 1u);
            asm volatile("s_waitcnt vmcnt(0)" ::: "memory");
        } else {
            XB_SPIN(xb_ld(&bar[XB_XGEN(b.x)]) == gen, bar);
            __builtin_amdgcn_fence(__ATOMIC_ACQUIRE, "agent");
            asm volatile("s_waitcnt vmcnt(0)" ::: "memory");
        }
    }
    __syncthreads();
}

struct Args { const float* in[28]; float* out; unsigned char* ws; int ph_lo, ph_hi, dbl, pad; };
enum { I_X = 0, I_AB_WIN, I_AB_BIN, I_A_DW, I_A_DWB, I_A_LNG, I_A_LNB, I_B_DW, I_AB_WOUT, I_CD_WIN, I_CD_BIN, I_C_LNG, I_C_LNB, I_C_WS, I_C_WSB, I_D_REL, I_CD_WOUT,
       I_MIX_LNG, I_MIX_LNB, I_RG_W, I_RG_B, I_RE_W, I_RE_B, I_WGATE, I_WUP, I_WDOWN, I_FFN_LNG, I_FFN_LNB };

__device__ __forceinline__ void p0_transpose_item(const float* W, int K, int N, bf16_t* WT, int k0, int n0, int drow0, LAS float* scr, int lane) {
    const int n4 = lane & 15, kr = lane >> 4;
    f32x4 v[16];
#pragma unroll
    for (int i = 0; i < 16; ++i) v[i] = __builtin_nontemporal_load((const GAS f32x4*)(W + (size_t)(k0 + 4 * i + kr) * N + n0 + 4 * n4));
#pragma unroll
    for (int i = 0; i < 16; ++i) { const int k = 4 * i + kr; *(LAS f32x4*)(scr + k * 64 + ((4 * n4) ^ (4 * ((k >> 3) & 7)))) = v[i]; }
    LDS_WAIT(); asm volatile("" ::: "memory");
    const int c = lane & 7;
#pragma unroll
    for (int it = 0; it < 8; ++it) { const int n = (lane >> 3) + 8 * it; const LAS float* s = scr + (8 * c) * 64 + (n ^ (4 * c));
        u32x4 o; o.x = pk2(s[0 * 64], s[1 * 64]); o.y = pk2(s[2 * 64], s[3 * 64]); o.z = pk2(s[4 * 64], s[5 * 64]); o.w = pk2(s[6 * 64], s[7 * 64]);
        __builtin_nontemporal_store(o, (GAS u32x4*)(WT + (size_t)(drow0 + n) * K + k0 + 8 * c)); }
    LDS_WAIT(); asm volatile("" ::: "memory");
}
__device__ __forceinline__ void p0_transpose_item_f8(const float* W, int K, int N, unsigned char* WT8, int k0, int n0, int drow0, LAS float* scr, int lane, float scale) {
    const int n4 = lane & 15, kr = lane >> 4;
    f32x4 v[16];
#pragma unroll
    for (int i = 0; i < 16; ++i) v[i] = __builtin_nontemporal_load((const GAS f32x4*)(W + (size_t)(k0 + 4 * i + kr) * N + n0 + 4 * n4));
#pragma unroll
    for (int i = 0; i < 16; ++i) { const int k = 4 * i + kr; *(LAS f32x4*)(scr + k * 64 + ((4 * n4) ^ (4 * ((k >> 3) & 7)))) = v[i]; }
    LDS_WAIT(); asm volatile("" ::: "memory");
    const int c = lane & 3;
#pragma unroll
    for (int it = 0; it < 4; ++it) { const int n = (lane >> 2) + 16 * it; float s[16];
#pragma unroll
        for (int j = 0; j < 16; ++j) { const int k = 16 * c + j; s[j] = scr[k * 64 + (n ^ (4 * ((k >> 3) & 7)))] * scale; }
        u32x4 o; o.x = pk4_fp8(s[0], s[1], s[2], s[3]); o.y = pk4_fp8(s[4], s[5], s[6], s[7]); o.z = pk4_fp8(s[8], s[9], s[10], s[11]); o.w = pk4_fp8(s[12], s[13], s[14], s[15]);
        __builtin_nontemporal_store(o, (GAS u32x4*)(WT8 + (size_t)(drow0 + n) * K + k0 + 16 * c)); }
    LDS_WAIT(); asm volatile("" ::: "memory");
}
__device__ __forceinline__ int perm_ab(int n) {
    const int seg = n >> 9, ch = n & 511, t = ch >> 7, r = ch & 127;
    if (seg == 0) return t * 256 + r;
    if (seg == 1) return t * 256 + 128 + r;
    if (seg == 2) return 1024 + ch;
    if (seg == 3) return 1536 + t * 256 + r;
    return 1536 + t * 256 + 128 + r;
}
constexpr int MOE_W_ITEMS = NE * 3 * 128;
__device__ __forceinline__ void moe_w_item(const Args& A, int r, LAS float* scr, int lane) {
    unsigned char* ws = A.ws;
    const int mat = r >> 7, q = r & 127, le = mat / 3, kind = mat % 3;
    if (kind < 2) {
        const int nb = q % (DE / 64), kb = q / (DE / 64), n0 = 64 * nb;
        const float* src = A.in[kind == 0 ? I_WGATE : I_WUP] + (size_t)le * DM * DE;
        p0_transpose_item_f8(src, DM, DE, ws + WS_WGU + (size_t)le * DM * DM, 64 * kb, n0, (n0 >> 7) * 256 + kind * 128 + (n0 & 127), scr, lane, W8SCALE);
    } else {
        const int nb = q % (DM / 64), kb = q / (DM / 64);
        p0_transpose_item_f8(A.in[I_WDOWN] + (size_t)le * DE * DM, DE, DM, ws + WS_WD + (size_t)le * DM * DE, 64 * kb, 64 * nb, 64 * nb, scr, lane, W8SCALE);
    }
}
__device__ __forceinline__ void moe_w_ids(const Args& A, LAS unsigned char* lds, int layer, int wave, int lane, int id0, int stride, int count) {
    LAS float* scr = (LAS float*)(lds + wave * 16384);
    for (int k = 0, id = id0; k < count && id < MOE_W_ITEMS / NWAVES; ++k, id += stride) moe_w_item(A, layer * MOE_W_ITEMS + id * NWAVES + wave, scr, lane);
}
constexpr int SLACK_K5 = 2, SLACK_K6 = 2;
__device__ __forceinline__ int slack_first(int T) { return (4 * T) & 255; }
__device__ __forceinline__ int slack_done(int T) { const int f = slack_first(T); return f ? (256 - f) * (SLACK_K5 + SLACK_K6) : 0; }
__device__ __forceinline__ void moe_w_steps(const Args& A, LAS unsigned char* lds, int layer, int vcu, int wave, int lane, int s0, int s1) {
    LAS float* scr = (LAS float*)(lds + wave * 16384);
    for (int s = s0; s < s1; ++s) moe_w_item(A, layer * MOE_W_ITEMS + (s * 256 + vcu) * NWAVES + wave, scr, lane);
}
__device__ __forceinline__ void p0_prologue(const Args& A, LAS unsigned char* lds, int vcu, int G, int wave, int lane, int tid, int rp) {
    unsigned char* ws = A.ws;
    LAS float* scr = (LAS float*)(lds + wave * 16384);
    const int gw = vcu * NWAVES + wave, NGW = G * NWAVES;
    constexpr int I_IN = (DM / 64) * (NIN / 64), I_OUT = (DM / 64) * (DM / 64);
    constexpr int NITEMS = 2 * I_IN + 2 * I_OUT + (MOE_W_IN_P0 ? 2 * MOE_W_ITEMS : 0);
    for (int it_ = gw; it_ < (NITEMS << rp); it_ += NGW) {
        int r = it_ >= NITEMS ? it_ - NITEMS : it_;
        if (r < I_IN) { const int nb = r % (NIN / 64), kb = r / (NIN / 64); p0_transpose_item(A.in[I_AB_WIN], DM, NIN, (bf16_t*)(ws + WS_WIN0), 64 * kb, 64 * nb, perm_ab(64 * nb), scr, lane); continue; } r -= I_IN;
        if (r < I_IN) { const int nb = r % (NIN / 64), kb = r / (NIN / 64); p0_transpose_item(A.in[I_CD_WIN], DM, NIN, (bf16_t*)(ws + WS_WIN1), 64 * kb, 64 * nb, 64 * nb, scr, lane); continue; } r -= I_IN;
        if (r < I_OUT) { const int nb = r % (DM / 64), kb = r / (DM / 64); p0_transpose_item(A.in[I_AB_WOUT], DM, DM, (bf16_t*)(ws + WS_WOUT0), 64 * kb, 64 * nb, 64 * nb, scr, lane); continue; } r -= I_OUT;
        if (r < I_OUT) { const int nb = r % (DM / 64), kb = r / (DM / 64); p0_transpose_item(A.in[I_CD_WOUT], DM, DM, (bf16_t*)(ws + WS_WOUT1), 64 * kb, 64 * nb, 64 * nb, scr, lane); continue; } r -= I_OUT;
        moe_w_item(A, r, scr, lane);
    }
    const int gt = vcu * NTHR + tid, NGT = G * NTHR;
    { const GAS f32x4* x4 = (const GAS f32x4*)A.in[I_X]; GAS u32x4* o = (GAS u32x4*)(ws + WS_XA);
      for (int i0_ = gt; i0_ < ((M * DM / 8) << rp); i0_ += 4 * NGT) { const int i0 = i0_ & (M * DM / 8 - 1); f32x4 a[4], b[4];
#pragma unroll
          for (int j = 0; j < 4; ++j) { const int i = i0 + j * NGT; a[j] = __builtin_nontemporal_load(x4 + 2 * i); b[j] = __builtin_nontemporal_load(x4 + 2 * i + 1); }
#pragma unroll
          for (int j = 0; j < 4; ++j) { const int i = i0 + j * NGT; u32x4 w; w.x = pk2(a[j][0], a[j][1]); w.y = pk2(a[j][2], a[j][3]); w.z = pk2(b[j][0], b[j][1]); w.w = pk2(b[j][2], b[j][3]); o[i] = w; } } }
    { float* bp = (float*)(ws + WS_BIASP); for (int n = gt; n < NIN; n += NGT) bp[perm_ab(n)] = A.in[I_AB_BIN][n]; }
    { bf16_t* wr = (bf16_t*)(ws + WS_WR);
      for (int i = gt; i < 2 * 48 * DM; i += NGT) { const int l = i / (48 * DM), r = (i / DM) % 48, k = i % DM; float v = 0.f;
          if (r < 4) v = A.in[I_RG_W][((size_t)l * DM + k) * 4 + r];
          else if (r < 36) { const int g = (r - 4) >> 3, e = (r - 4) & 7; v = A.in[I_RE_W][(((size_t)l * 4 + g) * DM + k) * 8 + e]; }
          wr[i] = (bf16_t)f2bf(v); } }
    { bf16_t* sw = (bf16_t*)(ws + WS_SGUW);
      for (int i = gt; i < 8 * 128 * 128; i += NGT) { const int ii = (i >> 7) & 127, j = i & 127; const float v = ((j >> 6) <= (ii >> 6)) ? A.in[I_C_WS][i] : 0.f; sw[i] = (bf16_t)f2bf(v); } }
}

__device__ __forceinline__ void conv_phase(const Args& A, LAS unsigned char* lds, int vcu, int G, int wave, int lane, int tid, const bf16_t* H0, bf16_t* U, int rp) {
    LAS unsigned char* tileA = lds;
    LAS float* outA = (LAS float*)(lds + 63488);
    const int cp = tid & 255, pg = tid >> 8;
    float w0[31], w1[31];
#pragma unroll
    for (int t = 0; t < 31; ++t) { const f32x2 w = *(const f32x2*)(A.in[I_A_DW] + t * 512 + 2 * cp); w0[t] = w.x; w1[t] = w.y; }
    const f32x2 cb = *(const f32x2*)(A.in[I_A_DWB] + 2 * cp);
    const f32x4 g0 = *(const f32x4*)(A.in[I_A_LNG] + 4 * lane), g1 = *(const f32x4*)(A.in[I_A_LNG] + 256 + 4 * lane);
    const f32x4 b0 = *(const f32x4*)(A.in[I_A_LNB] + 4 * lane), b1 = *(const f32x4*)(A.in[I_A_LNB] + 256 + 4 * lane);
    const int nun = (BATCH * (SEQ / 32)) << rp;
    u32x4 tv[8];
#define CONV_TLOAD(un__) do { const int _un = (un__) & (BATCH * (SEQ / 32) - 1); const int _b = _un / (SEQ / 32), _s0 = (_un % (SEQ / 32)) * 32; \
        _Pragma("unroll") for (int k = 0; k < 8; ++k) { const int p = tid + k * NTHR, r = p >> 6, ch = p & 63, s = _s0 - 30 + r; tv[k] = (u32x4){0u, 0u, 0u, 0u}; \
            if (p < 62 * 64 && s >= 0) tv[k] = *(const u32x4*)(H0 + ((size_t)_b * SEQ + s) * H0P + ch * 8); } } while (0)
#define CONV_TSTORE() do { _Pragma("unroll") for (int k = 0; k < 8; ++k) { const int p = tid + k * NTHR, r = p >> 6, ch = p & 63; if (p < 62 * 64) *(LAS u32x4*)(tileA + r * 1024 + ch * 16) = tv[k]; } } while (0)
    if (vcu < nun) { CONV_TLOAD(vcu); CONV_TSTORE(); }
    __syncthreads();
    for (int un_ = vcu; un_ < nun; un_ += G) { const int un = un_ & (BATCH * (SEQ / 32) - 1);
        const int b = un / (SEQ / 32), s0 = (un % (SEQ / 32)) * 32; const size_t rowb = (size_t)b * SEQ;
        const bool more = un_ + G < nun;
#pragma unroll 1
        for (int tk = 0; tk < 2; ++tk) { const int pos0 = pg * 16 + tk * 8;
            float a0[8], a1[8];
#pragma unroll
            for (int p = 0; p < 8; ++p) { a0[p] = cb.x; a1[p] = cb.y; }
#pragma unroll
            for (int j = 0; j < 38; ++j) { const unsigned w = *(const LAS unsigned*)(tileA + (pos0 + j) * 1024 + cp * 4); const float x0 = bflo(w), x1 = bfhi(w);
#pragma unroll
                for (int p = 0; p < 8; ++p) { const int t = j - p; if (t >= 0 && t <= 30) { a0[p] += w0[t] * x0; a1[p] += w1[t] * x1; } } }
#pragma unroll
            for (int p = 0; p < 8; ++p) *(LAS f32x2*)(outA + (pos0 + p) * 512 + 2 * cp) = (f32x2){a0[p], a1[p]};
        }
        __syncthreads();
        if (more) CONV_TLOAD(un_ + G);
#pragma unroll 1
        for (int rr = 0; rr < 4; ++rr) { const int r = wave * 4 + rr;
            const f32x4 v0 = *(const LAS f32x4*)(outA + r * 512 + 4 * lane), v1 = *(const LAS f32x4*)(outA + r * 512 + 256 + 4 * lane);
            const float mean = wave_sum((v0[0] + v0[1]) + (v0[2] + v0[3]) + (v1[0] + v1[1]) + (v1[2] + v1[3])) * (1.f / 512.f);
            const f32x4 d0 = v0 - mean, d1 = v1 - mean;
            const float var = wave_sum((d0[0] * d0[0] + d0[1] * d0[1]) + (d0[2] * d0[2] + d0[3] * d0[3]) + (d1[0] * d1[0] + d1[1] * d1[1]) + (d1[2] * d1[2] + d1[3] * d1[3])) * (1.f / 512.f);
            const float rstd = 1.0f / sqrtf(var + LN_EPS);
            f32x4 y0 = d0 * rstd * g0 + b0, y1 = d1 * rstd * g1 + b1;
            y0 = y0 * pg8::sigm4(y0); y1 = y1 * pg8::sigm4(y1);
            bf16_t* orow = U + (rowb + s0 + r) * DM;
            *(u32x2*)(orow + 4 * lane) = (u32x2){cvt_pk_bf16(y0[0], y0[1]), cvt_pk_bf16(y0[2], y0[3])};
            *(u32x2*)(orow + 256 + 4 * lane) = (u32x2){cvt_pk_bf16(y1[0], y1[1]), cvt_pk_bf16(y1[2], y1[3])}; }
#pragma unroll
        for (int k = 0; k < 4; ++k) { const int task = tid + k * NTHR, p = task >> 6, cg = task & 63; const int s = s0 + p;
            f32x4 acc0 = (f32x4){0.f, 0.f, 0.f, 0.f}, acc1 = acc0;
#pragma unroll
            for (int t = 0; t < 3; ++t) { const int ss = s - 2 + t;
                if (ss >= 0) { const u32x4 w = *(const u32x4*)(H0 + (rowb + ss) * H0P + 1024 + cg * 8);
                    const f32x4 k0 = *(const f32x4*)(A.in[I_B_DW] + t * 512 + cg * 8), k1 = *(const f32x4*)(A.in[I_B_DW] + t * 512 + cg * 8 + 4);
                    acc0 += k0 * (f32x4){bflo(w.x), bfhi(w.x), bflo(w.y), bfhi(w.y)}; acc1 += k1 * (f32x4){bflo(w.z), bfhi(w.z), bflo(w.w), bfhi(w.w)}; } }
            const u32x4 g = *(const u32x4*)(H0 + (rowb + s) * H0P + 512 + cg * 8);
            acc0 *= (f32x4){bflo(g.x), bfhi(g.x), bflo(g.y), bfhi(g.y)}; acc1 *= (f32x4){bflo(g.z), bfhi(g.z), bflo(g.w), bfhi(g.w)};
            *(u32x4*)(U + (rowb + s) * DM + 512 + cg * 8) = pg8::pack8(acc0, acc1); }
        if (more) CONV_TSTORE();
        __syncthreads();
    }
#undef CONV_TLOAD
#undef CONV_TSTORE
}

__device__ __forceinline__ void router_preload(const Args& A, LAS unsigned char* lds, int tid, int layer) {
    constexpr int RS = 2064; LAS unsigned char* wrl = lds;
    const bf16_t* WR = (const bf16_t*)(A.ws + WS_WR) + (size_t)layer * 48 * DM;
    u32x4 tv[9];
#pragma unroll
    for (int k = 0; k < 9; ++k) { const int p = tid + k * NTHR, r = p >> 7, ch = p & 127; tv[k] = *(const u32x4*)(WR + r * DM + ch * 8); }
#pragma unroll
    for (int k = 0; k < 9; ++k) { const int p = tid + k * NTHR, r = p >> 7, ch = p & 127; *(LAS u32x4*)(wrl + r * RS + ch * 16) = tv[k]; }
}
__device__ __forceinline__ void router_phase(const Args& A, LAS unsigned char* lds, int vcu, int wave, int lane, int tid, int layer, const bf16_t* Z, bf16_t* X1, unsigned* cnt, int rp, bool preloaded) {
    constexpr int RS = 2064;
    LAS unsigned char* wrl = lds;
    LAS unsigned char* xt = lds + 36 * RS;
    LAS float* lgp = (LAS float*)(lds + 36 * RS + 16 * RS);
    LAS float* lg = (LAS float*)(lds + 36 * RS + 16 * RS + 18432);
    LAS unsigned* rec = (LAS unsigned*)(lds + ROUTER_REC_OFF);
    if (!preloaded) router_preload(A, lds, tid, layer);
    const float* lng = A.in[I_MIX_LNG] + layer * DM; const float* lnb = A.in[I_MIX_LNB] + layer * DM;
    const float* rgb = A.in[I_RG_B] + layer * 4; const float* reb = A.in[I_RE_B] + layer * 32;
    f32x4 g[4], bb[4];
#pragma unroll
    for (int q = 0; q < 2; ++q) { g[2 * q] = *(const f32x4*)(lng + q * 512 + lane * 8); g[2 * q + 1] = *(const f32x4*)(lng + q * 512 + lane * 8 + 4);
        bb[2 * q] = *(const f32x4*)(lnb + q * 512 + lane * 8); bb[2 * q + 1] = *(const f32x4*)(lnb + q * 512 + lane * 8 + 4); }
    const int rc0 = tid % 36, rc1 = (tid + NTHR) % 36;
    const float rbias0 = rc0 < 4 ? rgb[rc0] : reb[rc0 - 4], rbias1 = rc1 < 4 ? rgb[rc1] : reb[rc1 - 4];
    const int tok0 = vcu * 128;
    u32x4 pre[2][2];
#pragma unroll
    for (int tt = 0; tt < 2; ++tt) { const int tok = tok0 + 2 * wave + tt; pre[tt][0] = __builtin_nontemporal_load((const u32x4*)(Z + (size_t)tok * DM + lane * 8)); pre[tt][1] = __builtin_nontemporal_load((const u32x4*)(Z + (size_t)tok * DM + 512 + lane * 8)); }
    __syncthreads();
#pragma unroll 1
    for (int k_ = 0; k_ < (8 << rp); ++k_) { const int k = k_ & 7;
        u32x4 curp[2][2];
#pragma unroll
        for (int tt = 0; tt < 2; ++tt) { curp[tt][0] = pre[tt][0]; curp[tt][1] = pre[tt][1]; }
        if (k_ < (8 << rp) - 1) {
#pragma unroll
            for (int tt = 0; tt < 2; ++tt) { const int tok = tok0 + 16 * ((k + 1) & 7) + 2 * wave + tt; pre[tt][0] = __builtin_nontemporal_load((const u32x4*)(Z + (size_t)tok * DM + lane * 8)); pre[tt][1] = __builtin_nontemporal_load((const u32x4*)(Z + (size_t)tok * DM + 512 + lane * 8)); } }
#pragma unroll
        for (int tt = 0; tt < 2; ++tt) { const int tl = 2 * wave + tt, tok = tok0 + 16 * k + tl;
            const u32x4 p0 = curp[tt][0], p1 = curp[tt][1];
            f32x4 v[4] = {(f32x4){bflo(p0.x), bfhi(p0.x), bflo(p0.y), bfhi(p0.y)}, (f32x4){bflo(p0.z), bfhi(p0.z), bflo(p0.w), bfhi(p0.w)},
                          (f32x4){bflo(p1.x), bfhi(p1.x), bflo(p1.y), bfhi(p1.y)}, (f32x4){bflo(p1.z), bfhi(p1.z), bflo(p1.w), bfhi(p1.w)}};
            float s = 0.f;
#pragma unroll
            for (int j = 0; j < 4; ++j) s += (v[j][0] + v[j][1]) + (v[j][2] + v[j][3]);
            const float mean = wave_sum(s) * (1.f / DM); float s2 = 0.f;
#pragma unroll
            for (int j = 0; j < 4; ++j) { v[j] = v[j] - mean; s2 += (v[j][0] * v[j][0] + v[j][1] * v[j][1]) + (v[j][2] * v[j][2] + v[j][3] * v[j][3]); }
            const float rstd = 1.0f / sqrtf(wave_sum(s2) * (1.f / DM) + LN_EPS);
#pragma unroll
            for (int j = 0; j < 4; ++j) v[j] = v[j] * rstd * g[j] + bb[j];
            const u32x4 o0 = pg8::pack8(v[0], v[1]), o1 = pg8::pack8(v[2], v[3]);
            *(u32x4*)(X1 + (size_t)tok * DM + lane * 8) = o0; *(u32x4*)(X1 + (size_t)tok * DM + 512 + lane * 8) = o1;
            { unsigned char* xq = A.ws + WS_X1Q + (size_t)tok * DM;
              *(u32x2*)(xq + lane * 8) = (u32x2){pk4_fp8(v[0][0], v[0][1], v[0][2], v[0][3]), pk4_fp8(v[1][0], v[1][1], v[1][2], v[1][3])};
              *(u32x2*)(xq + 512 + lane * 8) = (u32x2){pk4_fp8(v[2][0], v[2][1], v[2][2], v[2][3]), pk4_fp8(v[3][0], v[3][1], v[3][2], v[3][3])}; }
            *(LAS u32x4*)(xt + tl * RS + lane * 16) = o0; *(LAS u32x4*)(xt + tl * RS + 1024 + lane * 16) = o1; }
        __syncthreads();
        {
          f32x4 acc[3]; const int fr = lane & 15, fq = lane >> 4;
#pragma unroll
          for (int nt = 0; nt < 3; ++nt) acc[nt] = (f32x4){0.f, 0.f, 0.f, 0.f};
#pragma unroll
          for (int q = 0; q < 4; ++q) { const int kk = 4 * wave + q; const bf16x8 a = *(const LAS bf16x8*)(xt + fr * RS + (32 * kk + 8 * fq) * 2);
#pragma unroll
              for (int nt = 0; nt < 3; ++nt) { int br = 16 * nt + fr; br = br < 36 ? br : 35; const bf16x8 bw = *(const LAS bf16x8*)(wrl + br * RS + (32 * kk + 8 * fq) * 2);
                  acc[nt] = __builtin_amdgcn_mfma_f32_16x16x32_bf16(a, bw, acc[nt], 0, 0, 0); } }
#pragma unroll
          for (int nt = 0; nt < 3; ++nt) if (16 * nt + fr < 36) {
#pragma unroll
              for (int r = 0; r < 4; ++r) lgp[(wave * 16 + 4 * fq + r) * 36 + 16 * nt + fr] = acc[nt][r]; } }
        __syncthreads();
        { float v = rbias0;
#pragma unroll
          for (int w = 0; w < 8; ++w) v += lgp[w * 576 + tid];
          lg[tid] = v;
          if (tid < 64) { float v1 = rbias1;
#pragma unroll
              for (int w = 0; w < 8; ++w) v1 += lgp[w * 576 + NTHR + tid];
              lg[NTHR + tid] = v1; } }
        __syncthreads();
        if (tid < 16) { const LAS float* L = lg + tid * 36; const int tok = tok0 + 16 * k + tid;
            int gi = 0; float gm = L[0];
#pragma unroll
            for (int j = 1; j < 4; ++j) { const float v = L[j]; if (v > gm) { gm = v; gi = j; } }
            float gs = 0.f;
#pragma unroll
            for (int j = 0; j < 4; ++j) gs += __expf(L[j] - gm);
            const float gtop = 1.0f / gs;
            const LAS float* Le = L + 4 + gi * 8;
            int e1 = 0; float m1 = Le[0];
#pragma unroll
            for (int j = 1; j < 8; ++j) { const float v = Le[j]; if (v > m1) { m1 = v; e1 = j; } }
            int e2 = -1; float m2 = -3.0e38f;
#pragma unroll
            for (int j = 0; j < 8; ++j) { const float v = Le[j]; if (j != e1 && v > m2) { m2 = v; e2 = j; } }
            const float q2 = __expf(m2 - m1), w1 = gtop / (1.0f + q2), w2 = gtop * q2 / (1.0f + q2);
            LAS unsigned* rp = rec + (16 * k + tid) * 8;
            rp[0] = (unsigned)(gi * 8 + e1); rp[1] = (unsigned)(tok * 2); rp[2] = __float_as_uint(w1);
            rp[4] = (unsigned)(gi * 8 + e2); rp[5] = (unsigned)(tok * 2 + 1); rp[6] = __float_as_uint(w2); }
    }
    __syncthreads();
    {
        const int e = tid >> 4, s = tid & 15; int c = 0;
#pragma unroll
        for (int r = 0; r < 16; ++r) c += (rec[(16 * s + r) * 4] == (unsigned)e) ? 1 : 0;
        int incl = c;
#pragma unroll
        for (int o = 1; o < 16; o <<= 1) { const int t = __shfl_up(incl, o, 16); if (s >= o) incl += t; }
        const int total = __shfl(incl, 15, 16);
        unsigned base = 0; if (s == 0 && total > 0) base = __hip_atomic_fetch_add(cnt + e * 64, (unsigned)total, RLX_AGENT);
        base = __shfl(base, 0, 16) + (unsigned)(incl - c);
        unsigned* list = (unsigned*)(A.ws + WS_LIST) + (size_t)e * CAP; float* roww = (float*)(A.ws + WS_ROWW) + (size_t)e * CAP;
#pragma unroll
        for (int r = 0; r < 16; ++r) { const int q = (16 * s + r) * 4; if (rec[q] == (unsigned)e) { list[base] = rec[q + 1]; roww[base] = __uint_as_float(rec[q + 2]); ++base; } } }
    __syncthreads();
}

__device__ __forceinline__ int moe_table(LAS unsigned char* lds, const unsigned* cnt, int tid) {
    LAS unsigned* tb = (LAS unsigned*)(lds + TBL_OFF);
    __syncthreads();
    if (tid < NE) tb[tid] = __hip_atomic_load(cnt + tid * 64, RLX_AGENT);
    __syncthreads();
    if (tid < 64) { const int n = tid < NE ? (((int)tb[tid] + 255) >> 8) : 0; int incl = n;
#pragma unroll
        for (int o = 1; o < 32; o <<= 1) { const int t = __shfl_up(incl, o, 64); if (tid >= o) incl += t; }
        if (tid < NE) { int T = incl - n; for (int m = 0; m < n; ++m) tb[64 + T++] = ((unsigned)tid << 16) | (unsigned)m; }
        if (tid == NE - 1) tb[32] = (unsigned)incl; }
    __syncthreads();
    return (int)tb[32];
}

template <bool FINAL, bool SKIPMOE>
__device__ __forceinline__ void combine_ln_phase(const Args& A, int vcu, int G, int wave, int lane, int layer, const bf16_t* X1, const unsigned char* YB, bf16_t* XN, float* OUT, int rp) {
    const float* lng = A.in[I_FFN_LNG] + layer * DM; const float* lnb = A.in[I_FFN_LNB] + layer * DM;
    f32x4 g[4], bb[4];
#pragma unroll
    for (int q = 0; q < 2; ++q) { g[2 * q] = *(const f32x4*)(lng + q * 512 + lane * 8); g[2 * q + 1] = *(const f32x4*)(lng + q * 512 + lane * 8 + 4);
        bb[2 * q] = *(const f32x4*)(lnb + q * 512 + lane * 8); bb[2 * q + 1] = *(const f32x4*)(lnb + q * 512 + lane * 8 + 4); }
#pragma unroll 1
    for (int tok_ = vcu * NWAVES + wave; tok_ < (M << rp); tok_ += G * NWAVES) { const int tok = tok_ & (M - 1);
        u32x4 px[2]; u32x2 py0[2], py1[2];
#pragma unroll
        for (int q = 0; q < 2; ++q) { px[q] = __builtin_nontemporal_load((const u32x4*)(X1 + (size_t)tok * DM + q * 512 + lane * 8));
            if (!SKIPMOE) { py0[q] = __builtin_nontemporal_load((const u32x2*)(YB + (size_t)(2 * tok) * DM + q * 512 + lane * 8)); py1[q] = __builtin_nontemporal_load((const u32x2*)(YB + (size_t)(2 * tok + 1) * DM + q * 512 + lane * 8)); }
            else { py0[q] = (u32x2){0u, 0u}; py1[q] = py0[q]; } }
        f32x4 v[4];
#pragma unroll
        for (int q = 0; q < 2; ++q) {
            v[2 * q] = (f32x4){bflo(px[q].x), bfhi(px[q].x), bflo(px[q].y), bfhi(px[q].y)} * ALPHA + (unpk4_fp8(py0[q].x) + unpk4_fp8(py1[q].x)) * Y8INV;
            v[2 * q + 1] = (f32x4){bflo(px[q].z), bfhi(px[q].z), bflo(px[q].w), bfhi(px[q].w)} * ALPHA + (unpk4_fp8(py0[q].y) + unpk4_fp8(py1[q].y)) * Y8INV; }
        float s = 0.f;
#pragma unroll
        for (int j = 0; j < 4; ++j) s += (v[j][0] + v[j][1]) + (v[j][2] + v[j][3]);
        const float mean = wave_sum(s) * (1.f / DM); float s2 = 0.f;
#pragma unroll
        for (int j = 0; j < 4; ++j) { v[j] = v[j] - mean; s2 += (v[j][0] * v[j][0] + v[j][1] * v[j][1]) + (v[j][2] * v[j][2] + v[j][3] * v[j][3]); }
        const float rstd = 1.0f / sqrtf(wave_sum(s2) * (1.f / DM) + LN_EPS);
#pragma unroll
        for (int j = 0; j < 4; ++j) v[j] = v[j] * rstd * g[j] + bb[j];
        if (FINAL) {
#pragma unroll
            for (int q = 0; q < 2; ++q) { __builtin_nontemporal_store(v[2 * q], (f32x4*)(OUT + (size_t)tok * DM + q * 512 + lane * 8)); __builtin_nontemporal_store(v[2 * q + 1], (f32x4*)(OUT + (size_t)tok * DM + q * 512 + lane * 8 + 4)); }
        } else {
#pragma unroll
            for (int q = 0; q < 2; ++q) *(u32x4*)(XN + (size_t)tok * DM + q * 512 + lane * 8) = pg8::pack8(v[2 * q], v[2 * q + 1]);
        }
    }
}

__device__ __forceinline__ s16x4 tr16(const LAS unsigned char* p) { return __builtin_bit_cast(s16x4, __builtin_amdgcn_ds_read_tr16_b64_v4i16((LAS s16x4*)p)); }
__device__ __forceinline__ int sgu_sw(int row) { return (row & 3) | ((row >> 1) & 4); }
__device__ __forceinline__ void sgu_unit(const Args& A, LAS unsigned char* lds, int wave, int lane, int b, int blk, const bf16_t* H1, bf16_t* U) {
    const size_t row0 = (size_t)b * SEQ + (size_t)blk * 128;
    { const f32x4 g0 = *(const f32x4*)(A.in[I_C_LNG] + lane * 8), g1 = *(const f32x4*)(A.in[I_C_LNG] + lane * 8 + 4), b0 = *(const f32x4*)(A.in[I_C_LNB] + lane * 8), b1 = *(const f32x4*)(A.in[I_C_LNB] + lane * 8 + 4);
      u32x4 pv[16];
#pragma unroll
      for (int jj = 0; jj < 16; ++jj) pv[jj] = __builtin_nontemporal_load((const u32x4*)(H1 + (row0 + wave * 16 + jj) * H1P + 512 + lane * 8));
#pragma unroll
      for (int jj = 0; jj < 16; ++jj) { const int j = wave * 16 + jj; const u32x4 p = pv[jj];
        f32x4 v0 = (f32x4){bflo(p.x), bfhi(p.x), bflo(p.y), bfhi(p.y)}, v1 = (f32x4){bflo(p.z), bfhi(p.z), bflo(p.w), bfhi(p.w)};
        const float mean = wave_sum((v0[0] + v0[1]) + (v0[2] + v0[3]) + (v1[0] + v1[1]) + (v1[2] + v1[3])) * (1.f / 512.f);
        v0 = v0 - mean; v1 = v1 - mean;
        const float var = wave_sum((v0[0] * v0[0] + v0[1] * v0[1]) + (v0[2] * v0[2] + v0[3] * v0[3]) + (v1[0] * v1[0] + v1[1] * v1[1]) + (v1[2] * v1[2] + v1[3] * v1[3])) * (1.f / 512.f);
        const float rstd = 1.0f / sqrtf(var + LN_EPS);
        v0 = v0 * rstd * g0 + b0; v1 = v1 * rstd * g1 + b1;
        *(LAS u32x4*)(lds + j * 1024 + ((lane ^ sgu_sw(j)) << 4)) = pg8::pack8(v0, v1); } }
    __syncthreads();
    { const int h = wave, fr = lane & 15, fq = lane >> 4, q = fr >> 2, p = fr & 3;
      const bf16_t* Wm = (const bf16_t*)(A.ws + WS_SGUW) + (size_t)h * 128 * 128 + (size_t)fr * 128 + 8 * fq;
      const bf16_t* Up = H1 + (row0 + fr) * H1P + h * 64 + 16 * fq;
      constexpr int DIST = 2, NSET = DIST + 1;
      bf16x8 wf[NSET][4]; u32x4 uu[NSET][2]; float bs[8];
#define SGU_LOAD(it_) do { _Pragma("unroll") for (int kk = 0; kk < 4; ++kk) if (kk < ((it_) < 4 ? 2 : 4)) wf[(it_) % NSET][kk] = *(const bf16x8*)(Wm + (size_t)(16 * (it_)) * 128 + 32 * kk); \
        _Pragma("unroll") for (int c2 = 0; c2 < 2; ++c2) uu[(it_) % NSET][c2] = *(const u32x4*)(Up + (size_t)(16 * (it_)) * H1P + 8 * c2); } while (0)
#pragma unroll
      for (int it = 0; it < 8; ++it) bs[it] = A.in[I_C_WSB][h * 128 + 16 * it + fr];
#pragma unroll
      for (int it = 0; it < DIST; ++it) SGU_LOAD(it);
#pragma unroll
      for (int it = 0; it < 8; ++it) { const int nk = it < 4 ? 2 : 4;
        if (it + DIST < 8) SGU_LOAD(it + DIST);
        f32x4 acc[4];
#pragma unroll
        for (int ct = 0; ct < 4; ++ct) acc[ct] = (f32x4){0.f, 0.f, 0.f, 0.f};
#pragma unroll
        for (int kk = 0; kk < 4; ++kk) if (kk < nk) {
#pragma unroll
            for (int ct = 0; ct < 4; ++ct) { const int col = h * 64 + 16 * p + 4 * ct; const int r0 = 32 * kk + 8 * fq + q, r1 = r0 + 4;
                const s16x4 lo = tr16(lds + r0 * 1024 + (((col >> 3) ^ sgu_sw(r0)) << 4) + (col & 7) * 2), hi = tr16(lds + r1 * 1024 + (((col >> 3) ^ sgu_sw(r1)) << 4) + (col & 7) * 2);
                const bf16x8 vf = (bf16x8){lo[0], lo[1], lo[2], lo[3], hi[0], hi[1], hi[2], hi[3]};
                acc[ct] = __builtin_amdgcn_mfma_f32_16x16x32_bf16(vf, wf[it % NSET][kk], acc[ct], 0, 0, 0); } }
        const int i = 16 * it + fr; const float bias = bs[it];
#pragma unroll
        for (int c2 = 0; c2 < 2; ++c2) { const int c = h * 64 + 16 * fq + 8 * c2; const u32x4 u4 = uu[it % NSET][c2]; const f32x4 a0 = acc[2 * c2], a1 = acc[2 * c2 + 1];
            const float o0 = bflo(u4.x) * (a0[0] + bias), o1 = bfhi(u4.x) * (a0[1] + bias), o2 = bflo(u4.y) * (a0[2] + bias), o3 = bfhi(u4.y) * (a0[3] + bias);
            const float o4 = bflo(u4.z) * (a1[0] + bias), o5 = bfhi(u4.z) * (a1[1] + bias), o6 = bflo(u4.w) * (a1[2] + bias), o7 = bfhi(u4.w) * (a1[3] + bias);
            *(u32x4*)(U + (row0 + i) * DM + c) = (u32x4){cvt_pk_bf16(o0, o1), cvt_pk_bf16(o2, o3), cvt_pk_bf16(o4, o5), cvt_pk_bf16(o6, o7)}; } }
#undef SGU_LOAD
    }
    __syncthreads();
}
__device__ __forceinline__ int crow(int r, int hi) { return (r & 3) + 8 * (r >> 2) + 4 * hi; }
__device__ __forceinline__ void attn_units(const Args& A, LAS unsigned char* lds, int wave, int lane, int tid, int b, int h, int par, int nunits, const bf16_t* H1, bf16_t* U) {
    LAS unsigned char* Kb = lds; LAS unsigned char* Vb = lds + 16384; LAS float* biasL = (LAS float*)(lds + 32768);
    LAS float* wsf = (LAS float*)(lds + 36864) + wave * 64; LAS unsigned char* stg = lds + 40960 + wave * 4096;
    const int r32 = lane & 31, hi = lane >> 5;
    const size_t rowb = (size_t)b * SEQ;
    for (int i = tid; i < 513; i += NTHR) biasL[i] = A.in[I_D_REL][h * 513 + i] * LOG2E;
    const bf16_t* qsrc = H1 + (rowb + (wave >> 1) * 64 + (wave & 1) * 32 + r32) * H1P + 1024 + h * 64 + hi * 8;
    const bf16_t* ksrc = H1 + (rowb + lane) * H1P + 1536 + h * 64 + wave * 8;
    const bf16_t* vsrc = H1 + (rowb + 16 * (wave & 3) + (lane >> 2)) * H1P + 2048 + h * 64 + (wave >> 2) * 32 + (lane & 3) * 8;
    const int kdst = wave * 1024 + lane * 16, vdst = wave * 1024 + lane * 16;
    bf16x8 qr[4], qn[4]; u32x4 kreg, vreg;
    { const int cg0 = par, tl0 = 4 * cg0 - 8 > 0 ? 4 * cg0 - 8 : 0;
#pragma unroll
      for (int d0 = 0; d0 < 4; ++d0) qn[d0] = __builtin_nontemporal_load((const bf16x8*)(qsrc + (size_t)cg0 * 256 * H1P + d0 * 16));
      kreg = *(const u32x4*)(ksrc + (size_t)tl0 * 64 * H1P); vreg = *(const u32x4*)(vsrc + (size_t)tl0 * 64 * H1P); }
#pragma unroll 1
    for (int ui = 0; ui < nunits; ++ui) {
    const int cg = 2 * (ui & 3) + par, n0 = 4 * cg, n = n0 + (wave >> 1), qpos0 = n * 64 + (wave & 1) * 32;
    const int t_lo = n0 - 8 > 0 ? n0 - 8 : 0, t_hi = n0 + 3;
    const int cgn = 2 * ((ui + 1) & 3) + par, tln = 4 * cgn - 8 > 0 ? 4 * cgn - 8 : 0; const bool more = ui + 1 < nunits;
#pragma unroll
    for (int d0 = 0; d0 < 4; ++d0) qr[d0] = qn[d0];
    *(LAS u32x4*)(Kb + kdst) = kreg; *(LAS u32x4*)(Vb + vdst) = vreg;
    __syncthreads();
    float mrun = -1.0e30f, lrun = 0.f; f32x16 o[2];
#pragma unroll
    for (int r = 0; r < 16; ++r) { o[0][r] = 0.f; o[1][r] = 0.f; }
    const int vlane = ((lane >> 4) & 1) * 32 + (lane & 3) * 8 + (4 * hi + ((lane & 15) >> 2)) * 64;
#pragma unroll 1
    for (int t = t_lo; t <= t_hi; ++t) {
        const int buf = (t - t_lo) & 1;
        if (t < t_hi) { kreg = *(const u32x4*)(ksrc + (size_t)(t + 1) * 64 * H1P); vreg = *(const u32x4*)(vsrc + (size_t)(t + 1) * 64 * H1P); }
        else if (more) {
#pragma unroll
            for (int d0 = 0; d0 < 4; ++d0) qn[d0] = __builtin_nontemporal_load((const bf16x8*)(qsrc + (size_t)cgn * 256 * H1P + d0 * 16));
            kreg = *(const u32x4*)(ksrc + (size_t)tln * 64 * H1P); vreg = *(const u32x4*)(vsrc + (size_t)tln * 64 * H1P); }
        if (t >= n - 8 && t <= n) {
            const LAS unsigned char* kb = Kb + buf * 8192 + hi * 1024 + r32 * 16;
            f32x16 p0, p1;
#pragma unroll
            for (int r = 0; r < 16; ++r) { p0[r] = 0.f; p1[r] = 0.f; }
#pragma unroll
            for (int d0 = 0; d0 < 4; ++d0) { const bf16x8 b0 = *(const LAS bf16x8*)(kb + d0 * 2048), b1 = *(const LAS bf16x8*)(kb + d0 * 2048 + 512);
                p0 = __builtin_amdgcn_mfma_f32_32x32x16_bf16(b0, qr[d0], p0, 0, 0, 0); p1 = __builtin_amdgcn_mfma_f32_32x32x16_bf16(b1, qr[d0], p1, 0, 0, 0); }
            const int dbase = (qpos0 + r32) - t * 64;
            float rm = -3.0e38f;
#pragma unroll
            for (int r = 0; r < 16; ++r) { const int d0_ = dbase - crow(r, hi), d1_ = d0_ - 32;
                p0[r] += biasL[(d0_ < 256 ? d0_ : 256) + 256]; p1[r] += biasL[(d1_ < 256 ? d1_ : 256) + 256];
                rm = fmaxf(rm, fmaxf(p0[r], p1[r])); }
            rm = fmaxf(rm, __shfl_xor(rm, 32));
            const float mnew = fmaxf(mrun, rm), f = __builtin_amdgcn_exp2f(mrun - mnew); mrun = mnew;
            float ps = 0.f;
#pragma unroll
            for (int r = 0; r < 16; ++r) { p0[r] = __builtin_amdgcn_exp2f(p0[r] - mnew); p1[r] = __builtin_amdgcn_exp2f(p1[r] - mnew); ps += p0[r] + p1[r]; }
            lrun = lrun * f + ps;
            if (hi == 0) wsf[r32] = f;
            bf16x8 pa[4];
#pragma unroll
            for (int ks = 0; ks < 2; ++ks) { u32x4 w0, w1;
                w0.x = cvt_pk_bf16(p0[8 * ks + 0], p0[8 * ks + 1]); w0.y = cvt_pk_bf16(p0[8 * ks + 2], p0[8 * ks + 3]); w0.z = cvt_pk_bf16(p0[8 * ks + 4], p0[8 * ks + 5]); w0.w = cvt_pk_bf16(p0[8 * ks + 6], p0[8 * ks + 7]);
                w1.x = cvt_pk_bf16(p1[8 * ks + 0], p1[8 * ks + 1]); w1.y = cvt_pk_bf16(p1[8 * ks + 2], p1[8 * ks + 3]); w1.z = cvt_pk_bf16(p1[8 * ks + 4], p1[8 * ks + 5]); w1.w = cvt_pk_bf16(p1[8 * ks + 6], p1[8 * ks + 7]);
                pa[ks] = __builtin_bit_cast(bf16x8, w0); pa[2 + ks] = __builtin_bit_cast(bf16x8, w1); }
#pragma unroll
            for (int r = 0; r < 16; ++r) { const float fr_ = wsf[crow(r, hi)]; o[0][r] *= fr_; o[1][r] *= fr_; }
            const LAS unsigned char* vb = Vb + buf * 8192 + vlane;
#pragma unroll
            for (int dh = 0; dh < 2; ++dh)
#pragma unroll
                for (int ks = 0; ks < 4; ++ks) { const s16x4 lo = tr16(vb + dh * 4096 + ks * 1024), hh = tr16(vb + dh * 4096 + ks * 1024 + 512);
                    const bf16x8 vf = (bf16x8){lo[0], lo[1], lo[2], lo[3], hh[0], hh[1], hh[2], hh[3]};
                    o[dh] = __builtin_amdgcn_mfma_f32_32x32x16_bf16(pa[ks], vf, o[dh], 0, 0, 0); }
        }
        if (t < t_hi) { *(LAS u32x4*)(Kb + (buf ^ 1) * 8192 + kdst) = kreg; *(LAS u32x4*)(Vb + (buf ^ 1) * 8192 + vdst) = vreg; }
        __syncthreads();
    }
    lrun += __shfl_xor(lrun, 32);
    if (hi == 0) wsf[32 + r32] = 1.0f / lrun;
    bf16_t* Ow = U + (rowb + qpos0) * DM + 512 + h * 64;
#pragma unroll
    for (int r = 0; r < 16; ++r) { const int q = crow(r, hi); const float rl = wsf[32 + q];
        *(LAS bf16_t*)(stg + q * 128 + r32 * 2) = (bf16_t)f2bf(o[0][r] * rl); *(LAS bf16_t*)(stg + q * 128 + 64 + r32 * 2) = (bf16_t)f2bf(o[1][r] * rl); }
#pragma unroll
    for (int i = 0; i < 4; ++i) { const int row = i * 8 + (lane >> 3), ch = lane & 7; const u32x4 v = *(const LAS u32x4*)(stg + row * 128 + ch * 16); *(u32x4*)(Ow + (size_t)row * DM + ch * 8) = v; }
    __syncthreads();
    }
}

constexpr int NPHASE = 15;
__global__ void __launch_bounds__(NTHR, 2) hybrid_fwd(Args args) {
    extern __shared__ __attribute__((aligned(16))) unsigned char lds_raw[];
    LAS unsigned char* lds = (LAS unsigned char*)lds_raw;
    volatile LAS unsigned* MISC = (volatile LAS unsigned*)(lds + MISC_OFF);
    const int tid = threadIdx.x, lane = tid & 63, wave = __builtin_amdgcn_readfirstlane(tid >> 6);
    const int G = gridDim.x; const int bx = blockIdx.x; const int vcu = (G % 8 == 0) ? (bx % 8) * (G / 8) + bx / 8 : bx;
    unsigned char* ws = args.ws;
    gu32* ctl = (gu32*)(ws + WS_CTL);
    for (int u = tid; u < (LDS_BYTES - LDSCTL_OFF) / 4; u += NTHR) ((LAS unsigned*)(lds + LDSCTL_OFF))[u] = 0u;
    __syncthreads();
    XcdBarrier bar; bar.bar = (unsigned*)(ctl + CW_BAR); bar.x = 0; bar.st = nullptr;
    if (!MK_PER_PHASE) bar = xcd_barrier_post((unsigned*)(ctl + CW_BAR), MISC + 8);
    const int lo = args.ph_lo, hi = args.ph_hi, dblm = args.dbl;
#define IN(k) (lo <= (k) && (k) < hi)
#define DB(k) ((dblm >> (k)) & 1)
#define SEAM(k) do { if (IN(k) && IN((k) + 1)) { xcd_barrier(bar); if (dblm & 0x8000) xcd_barrier(bar); } } while (0)
    bf16_t* XA = (bf16_t*)(ws + WS_XA); bf16_t* X1 = (bf16_t*)(ws + WS_X1); bf16_t* HB = (bf16_t*)(ws + WS_H);
    bf16_t* U = (bf16_t*)args.out; bf16_t* Z = (bf16_t*)args.out + (size_t)M * DM; unsigned char* YB = ws + WS_H + 64 * MiB;
    unsigned* list = (unsigned*)(ws + WS_LIST); float* roww = (float*)(ws + WS_ROWW);

    if (IN(0)) { p0_prologue(args, lds, vcu, G, wave, lane, tid, DB(0)); } SEAM(0);
    LAS float* biasL = (LAS float*)(lds + TBL_OFF + 4096);
    if (IN(1)) { pg8::StaticOrder S; S.init(M, NIN, DM, ws + WS_WIN0, G, bx, DB(1)); pg8::EpiIn0 E{HB, biasL};
        for (int i = tid; i < NIN; i += NTHR) biasL[i] = ((const float*)(ws + WS_BIASP))[i];
        const int pre = MOE_W_IN_P0 ? 0 : (vcu >> 5) % (MOE_W_SA + 1), tot = MOE_W_IN_P0 ? 0 : MOE_W_SA;
        moe_w_steps(args, lds, 0, vcu, wave, lane, 0, pre); __syncthreads();
        pg8::gemm_phase<pg8::EpiIn0, pg8::StaticOrder, true>(lds, (const char*)XA, DM, S, E);
        moe_w_steps(args, lds, 0, vcu, wave, lane, pre, tot); } SEAM(1);
    if (IN(2)) { conv_phase(args, lds, vcu, G, wave, lane, tid, HB, U, DB(2)); } SEAM(2);
    if (IN(3)) { pg8::StaticOrder S; S.init(M, DM, DM, ws + WS_WOUT0, G, bx, DB(3)); pg8::EpiOut<false, SKIP_MIX0> E{Z, (const void*)XA};
        const int pre = MOE_W_IN_P0 ? 0 : (vcu >> 5) % (7 - MOE_W_SA), tot = MOE_W_IN_P0 ? 0 : 6 - MOE_W_SA;
        moe_w_steps(args, lds, 0, vcu, wave, lane, MOE_W_SA, MOE_W_SA + pre); __syncthreads();
        pg8::gemm_phase<pg8::EpiOut<false, SKIP_MIX0>, pg8::StaticOrder, true>(lds, (const char*)U, DM, S, E);
        moe_w_steps(args, lds, 0, vcu, wave, lane, MOE_W_SA + pre, MOE_W_SA + tot);
        if (IN(4)) { __syncthreads(); router_preload(args, lds, tid, 0); } } SEAM(3);
    if (IN(4)) { router_phase(args, lds, vcu, wave, lane, tid, 0, Z, X1, (unsigned*)(ctl + CW_CNT), DB(4), IN(3)); } SEAM(4);
    if (IN(5)) { if (!SKIP_MOE0) { const int T = moe_table(lds, (const unsigned*)(ctl + CW_CNT), tid); LAS unsigned* tb = (LAS unsigned*)(lds + TBL_OFF);
        pg8::MoeOrder<true> S{tb + 64, tb, T, G, vcu, DM / 2, (const char*)(ws + WS_WGU), (size_t)DM * DM, list, DB(5)}; pg8::EpiGU E{(unsigned char*)HB};
        pg8::gemm_phase<pg8::EpiGU, pg8::MoeOrder<true>, true, true>(lds, (const char*)(ws + WS_X1Q), DM / 2, S, E);
        if (MOE_W_SLACK) { const int f = slack_first(T); if (f && vcu >= f) moe_w_ids(args, lds, 1, wave, lane, vcu - f, 256 - f, SLACK_K5); } } } SEAM(5);
    if (IN(6)) { if (!SKIP_MOE0) { LAS unsigned* tb = (LAS unsigned*)(lds + TBL_OFF); const int T = MK_PER_PHASE ? moe_table(lds, (const unsigned*)(ctl + CW_CNT), tid) : (int)tb[32];
        pg8::MoeOrder<false> S{tb + 64, tb, T, G, vcu, DE / 2, (const char*)(ws + WS_WD), (size_t)DM * DE, list, DB(6)}; pg8::EpiDown E{YB, list, roww, (LAS unsigned*)(lds + ROUTER_REC_OFF)};
        pg8::gemm_phase<pg8::EpiDown, pg8::MoeOrder<false>, true, true>(lds, (const char*)HB, DE / 2, S, E);
        if (MOE_W_SLACK) { const int f = slack_first(T); if (f && vcu >= f) moe_w_ids(args, lds, 1, wave, lane, (256 - f) * SLACK_K5 + vcu - f, 256 - f, SLACK_K6); } } } SEAM(6);
    if (IN(7)) { combine_ln_phase<false, SKIP_MOE0>(args, vcu, G, wave, lane, 0, X1, YB, XA, nullptr, DB(7)); } SEAM(7);
    if (IN(8)) { pg8::StaticOrder S; S.init(M, NIN, DM, ws + WS_WIN1, G, bx, DB(8)); pg8::EpiIn1 E{HB, biasL};
        for (int i = tid; i < NIN; i += NTHR) biasL[i] = args.in[I_CD_BIN][i];
        const int T0 = MK_PER_PHASE ? moe_table(lds, (const unsigned*)(ctl + CW_CNT), tid) : (int)((LAS unsigned*)(lds + TBL_OFF))[32];
        const int D = (MOE_W_SLACK && !SKIP_MOE0) ? slack_done(T0) : 0;
        pg8::gemm_phase<pg8::EpiIn1, pg8::StaticOrder, true>(lds, (const char*)XA, DM, S, E);
        moe_w_ids(args, lds, 1, wave, lane, D + vcu, 256, MOE_W_SA); } SEAM(8);
    if (IN(9)) { if (!SKIP_MIX1) {
        for (int un = vcu; un < ((BATCH * 16) << DB(9)); un += G) sgu_unit(args, lds, wave, lane, (un >> 4) & 15, un & 15, HB, U);
        { const int pr = vcu >> 1; if (pr < BATCH * 8) attn_units(args, lds, wave, lane, tid, pr >> 3, pr & 7, vcu & 1, 4 << DB(9), HB, U); } } } SEAM(9);
    if (IN(10)) { pg8::StaticOrder S; S.init(M, DM, DM, ws + WS_WOUT1, G, bx, DB(10)); pg8::EpiOut<false, SKIP_MIX1> E{Z, (const void*)XA};
        const int T0 = MK_PER_PHASE ? moe_table(lds, (const unsigned*)(ctl + CW_CNT), tid) : (int)((LAS unsigned*)(lds + TBL_OFF))[32];
        const int D = (MOE_W_SLACK && !SKIP_MOE0) ? slack_done(T0) : 0;
        pg8::gemm_phase<pg8::EpiOut<false, SKIP_MIX1>, pg8::StaticOrder, true>(lds, (const char*)U, DM, S, E);
        moe_w_ids(args, lds, 1, wave, lane, D + vcu + 256 * MOE_W_SA, 256, 6 - MOE_W_SA);
        if (IN(11)) { __syncthreads(); router_preload(args, lds, tid, 1); } } SEAM(10);
    if (IN(11)) { router_phase(args, lds, vcu, wave, lane, tid, 1, Z, X1, (unsigned*)(ctl + CW_CNT) + 32 * 64, DB(11), IN(10)); } SEAM(11);
    if (IN(12)) { if (!SKIP_MOE1) { const int T = moe_table(lds, (const unsigned*)(ctl + CW_CNT) + 32 * 64, tid); LAS unsigned* tb = (LAS unsigned*)(lds + TBL_OFF);
        pg8::MoeOrder<true> S{tb + 64, tb, T, G, vcu, DM / 2, (const char*)(ws + WS_WGU) + (size_t)NE * DM * DM, (size_t)DM * DM, list, DB(12)}; pg8::EpiGU E{(unsigned char*)HB};
        pg8::gemm_phase<pg8::EpiGU, pg8::MoeOrder<true>, true, true>(lds, (const char*)(ws + WS_X1Q), DM / 2, S, E); } } SEAM(12);
    if (IN(13)) { if (!SKIP_MOE1) { LAS unsigned* tb = (LAS unsigned*)(lds + TBL_OFF); const int T = MK_PER_PHASE ? moe_table(lds, (const unsigned*)(ctl + CW_CNT) + 32 * 64, tid) : (int)tb[32];
        pg8::MoeOrder<false> S{tb + 64, tb, T, G, vcu, DE / 2, (const char*)(ws + WS_WD) + (size_t)NE * DM * DE, (size_t)DM * DE, list, DB(13)}; pg8::EpiDown E{YB, list, roww, (LAS unsigned*)(lds + ROUTER_REC_OFF)};
        pg8::gemm_phase<pg8::EpiDown, pg8::MoeOrder<false>, true, true>(lds, (const char*)HB, DE / 2, S, E); } } SEAM(13);
    if (IN(14)) { combine_ln_phase<true, SKIP_MOE1>(args, vcu, G, wave, lane, 1, X1, YB, nullptr, args.out, 0); }
#undef IN
#undef SEAM
}

extern "C" void kernel_launch(void* const* d_in, const int* in_sizes, int n_in, void* d_out, int out_size, void* d_ws, size_t ws_size, hipStream_t stream) {
    static int grid = 0;
    if (grid == 0) {
        if (n_in != 28 || in_sizes[0] != M * DM || out_size != M * DM || ws_size < WS_END) { fprintf(stderr, "kernel_launch: unexpected shapes / workspace (n_in %d, ws %zu); nothing launched\n", n_in, ws_size); grid = -1; return; }
        int dev = 0, cus = 0;
        if (hipGetDevice(&dev) != hipSuccess || hipDeviceGetAttribute(&cus, hipDeviceAttributeMultiprocessorCount, dev) != hipSuccess) { grid = -1; return; }
        if (hipFuncSetAttribute((const void*)hybrid_fwd, hipFuncAttributeMaxDynamicSharedMemorySize, LDS_BYTES) != hipSuccess) { fprintf(stderr, "kernel_launch: hipFuncSetAttribute failed\n"); grid = -1; return; }
        (void)hipGetLastError();
        grid = cus;
        if (grid != 256) { fprintf(stderr, "kernel_launch: built for 256 CUs, device has %d\n", cus); grid = -1; return; }
    }
    if (grid < 0) return;
    if (hipMemsetAsync((char*)d_ws + WS_CTL, 0, CTL_ZERO_BYTES, stream) != hipSuccess) return;
    Args a{};
    for (int i = 0; i < 28; ++i) a.in[i] = (const float*)d_in[i];
    a.out = (float*)d_out; a.ws = (unsigned char*)d_ws; a.dbl = DBL_MASK;
#if MK_PER_PHASE
    for (int p = 0; p < NPHASE; ++p) { a.ph_lo = p; a.ph_hi = p + 1; hipLaunchKernelGGL(hybrid_fwd, dim3(grid), dim3(NTHR), LDS_BYTES, stream, a); }
#else
    a.ph_lo = 0; a.ph_hi = NPHASE; hipLaunchKernelGGL(hybrid_fwd, dim3(grid), dim3(NTHR), LDS_BYTES, stream, a);
#ifdef EXTRA_PHASE
    a.ph_lo = EXTRA_PHASE; a.ph_hi = EXTRA_PHASE + 1; hipLaunchKernelGGL(hybrid_fwd, dim3(grid), dim3(NTHR), LDS_BYTES, stream, a);
#endif
#endif
}
```

```cpp
#include <hip/hip_runtime.h>
#include <cstdio>
#include <cstdint>

#ifndef MK_PER_PHASE
#define MK_PER_PHASE 0
#endif
#ifndef SKIP_MIX0
#define SKIP_MIX0 0
#endif
#ifndef SKIP_MOE0
#define SKIP_MOE0 0
#endif
#ifndef SKIP_MIX1
#define SKIP_MIX1 0
#endif
#ifndef SKIP_MOE1
#define SKIP_MOE1 0
#endif

#ifndef MOE_W_IN_P0
#define MOE_W_IN_P0 0
#endif
#ifndef MOE_W_SLACK
#define MOE_W_SLACK 1
#endif
#ifndef MOE_W_SA
#define MOE_W_SA 4
#endif
#ifndef DBL_MASK
#define DBL_MASK 0
#endif
#define GAS __attribute__((address_space(1)))
#define LAS __attribute__((address_space(3)))
typedef unsigned short bf16_t;
typedef short bf16x8 __attribute__((ext_vector_type(8)));
typedef short s16x4 __attribute__((ext_vector_type(4)));
typedef float f32x2 __attribute__((ext_vector_type(2)));
typedef float f32x4 __attribute__((ext_vector_type(4)));
typedef float f32x16 __attribute__((ext_vector_type(16)));
typedef unsigned u32x2 __attribute__((ext_vector_type(2)));
typedef unsigned u32x4 __attribute__((ext_vector_type(4)));
typedef GAS unsigned gu32;

constexpr int BATCH = 16, SEQ = 2048, DM = 1024, M = BATCH * SEQ;
constexpr int NIN = 2560;
constexpr int NE = 32, DE = 512, CAP = 32768;
constexpr int H0P = 1536, H1P = 2560;
constexpr float LN_EPS = 1e-5f, ALPHA = 1.4142135623730951f, LOG2E = 1.4426950408889634f;
constexpr float QSCALE = 0.125f * LOG2E;
constexpr int NWAVES = 8, NTHR = 512;

constexpr size_t MiB = 1u << 20;
constexpr size_t WS_CTL = 0, CTL_ZERO_BYTES = 128 * 1024;
constexpr size_t WS_BIASP = 1 * MiB;
constexpr size_t WS_WR = 1 * MiB + 64 * 1024;
constexpr size_t WS_SGUW = 1 * MiB + 512 * 1024;
constexpr size_t WS_LIST = 2 * MiB;
constexpr size_t WS_ROWW = 6 * MiB;
constexpr size_t WS_WIN0 = 10 * MiB, WS_WIN1 = 15 * MiB, WS_WOUT0 = 20 * MiB, WS_WOUT1 = 22 * MiB;
constexpr size_t WS_WGU = 24 * MiB;
constexpr size_t WS_WD = 88 * MiB;
constexpr size_t WS_X1Q = 120 * MiB;
constexpr size_t WS_XA = 216 * MiB;
constexpr size_t WS_X1 = 280 * MiB;
constexpr size_t WS_H = 344 * MiB;
constexpr size_t WS_END = 504 * MiB;

constexpr int CW_TMO = 0, CW_CODE = 1;
constexpr int CW_BAR = 4096;
constexpr int CW_CNT = 16384;
static_assert((size_t)(CW_CNT + 2 * 32 * 64) * 4 <= CTL_ZERO_BYTES && (size_t)(CW_BAR + 3456) * 4 <= CTL_ZERO_BYTES, "control words inside the per-call memset");

constexpr int RING_BYTES = 131072;
constexpr int LDSCTL_OFF = RING_BYTES, MISC_OFF = LDSCTL_OFF + 320;
constexpr int TBL_OFF = RING_BYTES + 1024;
constexpr int ROUTER_REC_OFF = TBL_OFF + 2048;
constexpr int LDS_BYTES = 147456;
static_assert(ROUTER_REC_OFF + 4096 <= 147456 && TBL_OFF + 4096 + 2560 * 4 <= 147456, "LDS map");

#define RLX_AGENT __ATOMIC_RELAXED, __HIP_MEMORY_SCOPE_AGENT
#define LDS_WAIT() asm volatile("s_waitcnt lgkmcnt(0)" ::: "memory")
#define VM_WAIT() asm volatile("s_waitcnt vmcnt(0)" ::: "memory")
__device__ __forceinline__ unsigned f2bf(float f) { unsigned u = __builtin_bit_cast(unsigned, f); return (u + 0x7fffu + ((u >> 16) & 1u)) >> 16; }
__device__ __forceinline__ unsigned pk2(float lo, float hi) { return f2bf(lo) | (f2bf(hi) << 16); }
typedef __bf16 bf16x2_n __attribute__((ext_vector_type(2)));
__device__ __forceinline__ unsigned cvt_pk_bf16(float lo, float hi) { const f32x2 v = {lo, hi}; const bf16x2_n b = __builtin_convertvector(v, bf16x2_n); return __builtin_bit_cast(unsigned, b); }
__device__ __forceinline__ float bflo(unsigned w) { return __uint_as_float(w << 16); }
__device__ __forceinline__ float bfhi(unsigned w) { return __uint_as_float(w & 0xffff0000u); }
template <int CTRL> __device__ __forceinline__ float dpp_f(float v) { return __builtin_bit_cast(float, __builtin_amdgcn_update_dpp(0, __builtin_bit_cast(int, v), CTRL, 0xF, 0xF, true)); }
template <int CTRL> __device__ __forceinline__ int dpp_i(int v) { return __builtin_amdgcn_update_dpp(0, v, CTRL, 0xF, 0xF, true); }
__device__ __forceinline__ float wave_sum(float v) {
    v += dpp_f<0xB1>(v); v += dpp_f<0x4E>(v); v += dpp_f<0x141>(v); v += dpp_f<0x140>(v);
    const int vi = __builtin_bit_cast(int, v);
    const float s0 = __builtin_bit_cast(float, __builtin_amdgcn_readlane(vi, 0)), s1 = __builtin_bit_cast(float, __builtin_amdgcn_readlane(vi, 16)),
                s2 = __builtin_bit_cast(float, __builtin_amdgcn_readlane(vi, 32)), s3 = __builtin_bit_cast(float, __builtin_amdgcn_readlane(vi, 48));
    return (s0 + s1) + (s2 + s3);
}
typedef int i32x4 __attribute__((ext_vector_type(4)));
typedef int i32x8 __attribute__((ext_vector_type(8)));
constexpr bool X1_RECOMP = true;
constexpr float W8SCALE = 32.0f, W8INV = 1.0f / 32.0f;
__device__ __forceinline__ float clamp8(float v) { return __builtin_amdgcn_fmed3f(v, -448.0f, 448.0f); }
__device__ __forceinline__ unsigned pk4_fp8(float a, float b, float c, float d) { int w = 0; w = __builtin_amdgcn_cvt_pk_fp8_f32(clamp8(a), clamp8(b), w, false); w = __builtin_amdgcn_cvt_pk_fp8_f32(clamp8(c), clamp8(d), w, true); return (unsigned)w; }
__device__ __forceinline__ f32x4 unpk4_fp8(unsigned w) { const f32x2 lo = __builtin_amdgcn_cvt_pk_f32_fp8((int)w, false), hi = __builtin_amdgcn_cvt_pk_f32_fp8((int)w, true); return (f32x4){lo[0], lo[1], hi[0], hi[1]}; }
constexpr float Y8SCALE = 64.0f, Y8INV = 1.0f / 64.0f;
__device__ __forceinline__ float fast_sigmoid(float x) { return __builtin_amdgcn_rcpf(1.0f + __builtin_amdgcn_exp2f(-x * LOG2E)); }

namespace pg8 {
constexpr int BM = 256, BK = 64, HALF = 128, HTB = HALF * BK * 2, STAGE_BYTES = 8 * HTB, NXCD = 8, WGM = 8;
__host__ __device__ __forceinline__ int lds_byte(int r, int c) { const int st = (r >> 4) * 2 + (c >> 5), rr = r & 15, cc = c & 31, ob = rr * 64 + cc * 2; return st * 1024 + (ob ^ (((ob >> 9) & 1) << 5)); }
__host__ __device__ __forceinline__ void stage_rc(int b, int& R, int& C) { const int st = b / 1024, sb = b % 1024, swz = sb ^ (((sb >> 9) & 1) << 5); R = (st >> 1) * 16 + swz / 64; C = (st & 1) * 32 + (swz % 64) / 2; }
__host__ __device__ __forceinline__ int perm32(int rho) { const int n = rho >> 4, i = rho & 15; return 8 * (i >> 2) + 4 * n + (i & 3); }

struct Unit {
    int pm, pn;
    size_t aoff;
    unsigned lbase;
    int nvalid;
    const char* B;
    int slot;
};

struct StaticOrder {
    static constexpr bool GATHER = false;
    int nM, nN, nwg, G, c, K, dsh; const char* Bt; const unsigned* list;
    __device__ void init(int Mrows, int N, int K_, const void* Bt_, int G_, int c_, int dsh_) { nM = Mrows / BM; nN = N / BM; nwg = nM * nN; G = G_; c = c_; K = K_; Bt = (const char*)Bt_; list = nullptr; dsh = dsh_; }
    __device__ __forceinline__ bool next(int i, Unit& u) const {
        const int nmine = (nwg - c + G - 1) / G; if (i >= (nmine << dsh)) return false; const long L = (long)(i >= nmine ? i - nmine : i) * G + c;
        int wgid = (int)L; { const int q = nwg / NXCD, r = nwg % NXCD, xcd = wgid % NXCD, off = wgid / NXCD; wgid = (xcd < r ? xcd * (q + 1) : r * (q + 1) + (xcd - r) * q) + off; }
        const int nig = WGM * nN, gid = wgid / nig, fm = gid * WGM, gsz = (nM - fm) < WGM ? (nM - fm) : WGM;
        u.pm = fm + ((wgid % nig) % gsz); u.pn = (wgid % nig) / gsz;
        u.aoff = (size_t)u.pm * BM * K * 2; u.B = Bt + (size_t)u.pn * BM * K * 2; u.lbase = 0; u.nvalid = BM; return true;
    }
};
template <bool GATHER_> struct MoeOrder {
    static constexpr bool GATHER = GATHER_;
    const LAS unsigned* tinfo; const LAS unsigned* cntl; int ntiles, G, c, K; const char* Bbase; size_t per_expert; const unsigned* list; int dsh;
    __device__ __forceinline__ bool next(int i, Unit& u) const {
        const int nmine = (ntiles * 4 - c + G - 1) / G; if (i >= (nmine << dsh)) return false; const int L = (i >= nmine ? i - nmine : i) * G + c;
        const int tile = L >> 2; const unsigned ti = tinfo[tile]; const int e = (int)(ti >> 16), mt = (int)(ti & 0xffffu);
        u.pm = tile; u.pn = L & 3; u.aoff = (size_t)tile * BM * K * 2; u.lbase = (unsigned)(e * CAP + mt * BM);
        const int left = (int)cntl[e] - mt * BM; u.nvalid = left < BM ? left : BM;
        u.B = Bbase + (size_t)e * per_expert + (size_t)u.pn * BM * K * 2; return true;
    }
};

#define PG8_EPI_ARGS const f32x4 (&acc)[2][2][4][2], const Unit& u, int wr, int wc, int fr, int fq

template <class Epi, class Sched, bool ALIGN_EPI, bool F8 = false>
__device__ __forceinline__ void gemm_phase(LAS unsigned char* lds, const char* Abase, const int K, const Sched& S, const Epi& E) {
    const int tid = threadIdx.x, wid = __builtin_amdgcn_readfirstlane(tid >> 6), lane = tid & 63, wr = wid >> 2, wc = wid & 3, fr = lane & 15, fq = lane >> 4;
    const int nt = K / BK;
    unsigned voffA[2], voffB[2]; int RA[2]; unsigned CA2[2];
#pragma unroll
    for (int i = 0; i < 2; ++i) { int R, C; stage_rc(tid * 16 + i * 8192, R, C);
        const int Rb = Epi::BJ8 ? (64 * (R >> 5) + 16 * ((R & 15) >> 2) + 4 * ((R >> 4) & 1) + (R & 3)) : Epi::PERM ? ((R & ~31) + perm32(R & 31)) : R;
        voffA[i] = (unsigned)(R * K + C) * 2u; voffB[i] = (unsigned)(Rb * K + C) * 2u; RA[i] = R; CA2[i] = (unsigned)C * 2u; }
    const size_t kstep = (size_t)(BK * 2);
    const size_t hstep = (size_t)HALF * K * 2, hstepB = Epi::BJ8 ? (size_t)8 * K * 2 : hstep;
    const unsigned ldsw = (unsigned)wid * 1024u;
    const int c8 = (fq >> 1) * 32 + fq * 8;
    const int aoff = F8 ? lds_byte(wr * 64 + fr, c8) : lds_byte(wr * 64 + fr, fq * 8), boff = F8 ? lds_byte(wc * 32 + fr, c8) : lds_byte(wc * 32 + fr, fq * 8);
    const int aoffh = aoff ^ 32, boffh = boff ^ 32;

#define PG8_SA(b, h) (((b) * 2 + (h)) * HTB)
#define PG8_SB(b, h) ((4 + (b) * 2 + (h)) * HTB)
#define PG8_STAGE(bufoff, gbase, voff) do { _Pragma("unroll") for (int _i = 0; _i < 2; ++_i) \
        __builtin_amdgcn_global_load_lds((const unsigned*)((const char*)(gbase) + (voff)[_i]), (LAS unsigned*)(lds + (bufoff) + ldsw + _i * 8192), 16, 0, 0); } while (0)
#define PG8_STAGE_A(bufoff, h, pd, go, kb) do { if constexpr (Sched::GATHER) { PG8_STAGE(bufoff, Abase + (kb), go[h]); } else { PG8_STAGE(bufoff, (pd) + (h) * hstep, voffA); } } while (0)
#define PG8_LDA(dst, b, h) do { if constexpr (F8) { _Pragma("unroll") for (int m = 0; m < 4; ++m) { dst##8[m].lo = *(const LAS i32x4*)(lds + PG8_SA(b, h) + aoff + m * 2048); dst##8[m].hi = *(const LAS i32x4*)(lds + PG8_SA(b, h) + aoffh + m * 2048); } } \
        else { _Pragma("unroll") for (int m = 0; m < 4; ++m) _Pragma("unroll") for (int k = 0; k < 2; ++k) dst[m][k] = *(const LAS bf16x8*)(lds + PG8_SA(b, h) + aoff + m * 2048 + k * 1024); } } while (0)
#define PG8_LDB(dst, b, h) do { if constexpr (F8) { _Pragma("unroll") for (int n = 0; n < 2; ++n) { dst##8[n].lo = *(const LAS i32x4*)(lds + PG8_SB(b, h) + boff + n * 2048); dst##8[n].hi = *(const LAS i32x4*)(lds + PG8_SB(b, h) + boffh + n * 2048); } } \
        else { _Pragma("unroll") for (int n = 0; n < 2; ++n) _Pragma("unroll") for (int k = 0; k < 2; ++k) dst[n][k] = *(const LAS bf16x8*)(lds + PG8_SB(b, h) + boff + n * 2048 + k * 1024); } } while (0)
#define PG8_MMA(ai, bj, At, Bt) do { __builtin_amdgcn_s_setprio(1); if constexpr (F8) { _Pragma("unroll") for (int m = 0; m < 4; ++m) _Pragma("unroll") for (int n = 0; n < 2; ++n) \
        asm volatile("v_mfma_scale_f32_16x16x128_f8f6f4 %0, %1, %2, %0, %3, %3 op_sel_hi:[0,0,0]" : "+v"(acc[ai][bj][m][n]) : "v"(Bt##8[n]), "v"(At##8[m]), "v"(sc8)); } else { \
        _Pragma("unroll") for (int m = 0; m < 4; ++m) _Pragma("unroll") for (int n = 0; n < 2; ++n) _Pragma("unroll") for (int k = 0; k < 2; ++k) \
        acc[ai][bj][m][n] = __builtin_amdgcn_mfma_f32_16x16x32_bf16(Bt[n][k], At[m][k], acc[ai][bj][m][n], 0, 0, 0); } __builtin_amdgcn_s_setprio(0); } while (0)
#define PG8_WAIT_V(n) asm volatile("s_waitcnt vmcnt(" #n ")" ::: "memory")
#define PG8_WAIT_L(n) asm volatile("s_waitcnt lgkmcnt(" #n ")" ::: "memory")
#define PG8_BAR __builtin_amdgcn_s_barrier()
#define PG8_SCHED __builtin_amdgcn_sched_barrier(0)
#define PG8_GOFF(dst, uu) do { _Pragma("unroll") for (int _h = 0; _h < 2; ++_h) _Pragma("unroll") for (int _i = 0; _i < 2; ++_i) { \
        int _r = _h * HALF + RA[_i]; _r = _r < (uu).nvalid ? _r : 0; const unsigned _e = S.list[(uu).lbase + _r]; dst[_h][_i] = (_e >> 1) * (unsigned)(K * 2) + CA2[_i]; } } while (0)
    Unit cur, nxt; int ui = 0;
    if (!S.next(0, cur)) return;
    f32x4 acc[2][2][4][2];
#pragma unroll
    for (int a = 0; a < 2; ++a)
#pragma unroll
        for (int b = 0; b < 2; ++b)
#pragma unroll
            for (int m = 0; m < 4; ++m)
#pragma unroll
                for (int n = 0; n < 2; ++n) { acc[a][b][m][n] = (f32x4){0.f, 0.f, 0.f, 0.f}; }
    bf16x8 At[4][2], B0[2][2], B1[2][2];
    i32x8 At8[4], B08[2], B18[2];
    int sc8 = 0x7F7F7F7F; asm volatile("" : "+v"(sc8));
    unsigned goff[2][2] = {{0u, 0u}, {0u, 0u}}, goffn[2][2] = {{0u, 0u}, {0u, 0u}}, eraw[2][2] = {{0u, 0u}, {0u, 0u}};
#define PG8_ERAW(dst, uu) do { _Pragma("unroll") for (int _h = 0; _h < 2; ++_h) _Pragma("unroll") for (int _i = 0; _i < 2; ++_i) { \
        int _r = _h * HALF + RA[_i]; _r = _r < (uu).nvalid ? _r : 0; dst[_h][_i] = S.list[(uu).lbase + _r]; } } while (0)
#define PG8_ECONV(dst, src) do { _Pragma("unroll") for (int _h = 0; _h < 2; ++_h) _Pragma("unroll") for (int _i = 0; _i < 2; ++_i) dst[_h][_i] = (src[_h][_i] >> 1) * (unsigned)(K * 2) + CA2[_i]; } while (0)
    LAS unsigned* lrow = (LAS unsigned*)(lds + ROUTER_REC_OFF);
    if constexpr (Sched::GATHER) { PG8_ERAW(eraw, cur); }
    const char* cA = Abase + cur.aoff; const char* cB = cur.B;
    cur.slot = 0; E.stage(cur, wid, lane);
    PG8_STAGE(PG8_SB(0, 0), cB, voffB); PG8_STAGE(PG8_SB(0, 1), cB + hstepB, voffB);
    if constexpr (Sched::GATHER) { PG8_ECONV(goff, eraw); }
    PG8_STAGE_A(PG8_SA(0, 0), 0, cA, goff, 0); PG8_STAGE_A(PG8_SA(0, 1), 1, cA, goff, 0);
    if (wr == 1) PG8_BAR;
    PG8_WAIT_V(2); PG8_BAR;
    PG8_STAGE(PG8_SB(1, 0), cB + kstep, voffB); PG8_STAGE_A(PG8_SA(1, 0), 0, cA + kstep, goff, kstep); PG8_STAGE(PG8_SB(1, 1), cB + hstepB + kstep, voffB);
    PG8_WAIT_V(6); PG8_BAR;
    for (;;) {
        const bool has_next = S.next(ui + 1, nxt);
        const char* nA = has_next ? Abase + nxt.aoff : cA; const char* nB = has_next ? nxt.B : cB;
        if constexpr (Sched::GATHER) { if (has_next && wid < 4) __builtin_amdgcn_global_load_lds((const unsigned*)(S.list + nxt.lbase + wid * 64 + lane), (LAS unsigned*)(lrow + wid * 64), 4, 0, 0); }
#pragma unroll 1
        for (int t = 0; t < nt; t += 2) {
            const bool last = (t == nt - 2);
            const char* a1 = cA + (size_t)(t + 1) * kstep;
            const char* a2 = last ? nA : cA + (size_t)(t + 2) * kstep; const char* b2 = last ? nB : cB + (size_t)(t + 2) * kstep;
            const char* a3 = a2 + kstep; const char* b3 = b2 + kstep;
            const size_t k1 = (size_t)(t + 1) * kstep, k2 = last ? (size_t)0 : (size_t)(t + 2) * kstep, k3 = k2 + kstep;
            if constexpr (Sched::GATHER) { if (last) {
                if (has_next) { unsigned et[2][2];
#pragma unroll
                    for (int h = 0; h < 2; ++h)
#pragma unroll
                        for (int i = 0; i < 2; ++i) { int r = h * HALF + RA[i]; r = r < nxt.nvalid ? r : 0; asm volatile("" : "+v"(r)); et[h][i] = lrow[r]; }
                    PG8_ECONV(goffn, et); }
                else {
#pragma unroll
                    for (int h = 0; h < 2; ++h) { goffn[h][0] = goff[h][0]; goffn[h][1] = goff[h][1]; } } } }
            unsigned gsel[2][2];
#pragma unroll
            for (int h = 0; h < 2; ++h) { gsel[h][0] = last ? goffn[h][0] : goff[h][0]; gsel[h][1] = last ? goffn[h][1] : goff[h][1]; }
            PG8_LDB(B0, 0, 0); PG8_LDB(B1, 0, 1); PG8_SCHED; PG8_LDA(At, 0, 0); PG8_STAGE_A(PG8_SA(1, 1), 1, a1, goff, k1);
            PG8_WAIT_V(8); PG8_WAIT_L(0); PG8_BAR; PG8_MMA(0, 0, At, B0); PG8_MMA(0, 1, At, B1); PG8_BAR; PG8_SCHED;
            PG8_LDA(At, 0, 1); PG8_STAGE(PG8_SB(0, 0), b2, voffB); PG8_STAGE(PG8_SB(0, 1), b2 + hstepB, voffB); PG8_STAGE_A(PG8_SA(0, 0), 0, a2, gsel, k2);
            PG8_WAIT_V(8); PG8_WAIT_L(0); PG8_BAR; PG8_MMA(1, 0, At, B0); PG8_MMA(1, 1, At, B1); PG8_BAR; PG8_SCHED;
            PG8_LDB(B0, 1, 0); PG8_LDB(B1, 1, 1); PG8_SCHED; PG8_LDA(At, 1, 0); PG8_STAGE_A(PG8_SA(0, 1), 1, a2, gsel, k2);
            PG8_WAIT_V(8); PG8_WAIT_L(0); PG8_BAR; PG8_MMA(0, 0, At, B0); PG8_MMA(0, 1, At, B1); PG8_BAR; PG8_SCHED;
            PG8_LDA(At, 1, 1); PG8_STAGE(PG8_SB(1, 0), b3, voffB); PG8_STAGE(PG8_SB(1, 1), b3 + hstepB, voffB); PG8_STAGE_A(PG8_SA(1, 0), 0, a3, gsel, k3);
            PG8_WAIT_V(8); PG8_WAIT_L(0); PG8_BAR; PG8_MMA(1, 0, At, B0); PG8_MMA(1, 1, At, B1); PG8_BAR; PG8_SCHED;
        }
        if constexpr (ALIGN_EPI) { if (wr == 0) PG8_BAR; }
        if constexpr (F8) asm volatile("s_nop 15\n\ts_nop 15" ::: "memory");
        E(acc, cur, wr, wc, fr, fq);
        if (!has_next) break;
#pragma unroll
        for (int a = 0; a < 2; ++a)
#pragma unroll
            for (int b = 0; b < 2; ++b)
#pragma unroll
                for (int m = 0; m < 4; ++m)
#pragma unroll
                    for (int n = 0; n < 2; ++n) { acc[a][b][m][n] = (f32x4){0.f, 0.f, 0.f, 0.f}; }
        cur = nxt; cA = nA; cB = nB; ++ui;
        cur.slot = ui & 1; E.stage(cur, wid, lane);
#pragma unroll
        for (int h = 0; h < 2; ++h) { goff[h][0] = goffn[h][0]; goff[h][1] = goffn[h][1]; }
        if constexpr (ALIGN_EPI) { if (wr == 1) PG8_BAR; }
    }
    PG8_WAIT_V(0);
    if constexpr (!ALIGN_EPI) { if (wr == 0) PG8_BAR; }
    PG8_BAR;
#undef PG8_SA
#undef PG8_SB
#undef PG8_STAGE
#undef PG8_STAGE_A
#undef PG8_LDA
#undef PG8_LDB
#undef PG8_MMA
#undef PG8_WAIT_V
#undef PG8_WAIT_L
#undef PG8_BAR
#undef PG8_SCHED
#undef PG8_GOFF
#undef PG8_ERAW
#undef PG8_ECONV
}

__device__ __forceinline__ u32x4 pack8(const f32x4 v0, const f32x4 v1) { u32x4 w; w.x = cvt_pk_bf16(v0[0], v0[1]); w.y = cvt_pk_bf16(v0[2], v0[3]); w.z = cvt_pk_bf16(v1[0], v1[1]); w.w = cvt_pk_bf16(v1[2], v1[3]); return w; }
__device__ __forceinline__ f32x4 sigm4(const f32x4 g) { return (f32x4){fast_sigmoid(g[0]), fast_sigmoid(g[1]), fast_sigmoid(g[2]), fast_sigmoid(g[3])}; }
__device__ __forceinline__ float sig_scaled(float a) { return __builtin_amdgcn_rcpf(1.0f + __builtin_amdgcn_exp2f(a * (-LOG2E * W8INV))); }
__device__ __forceinline__ f32x4 sigs4(const f32x4 a) { return (f32x4){sig_scaled(a[0]), sig_scaled(a[1]), sig_scaled(a[2]), sig_scaled(a[3])}; }

struct EpiIn0 {
    static constexpr bool PERM = true, BJ8 = false;
    bf16_t* H; const LAS float* biasp;
    __device__ __forceinline__ void stage(const Unit&, int, int) const {}
    __device__ __forceinline__ void operator()(PG8_EPI_ARGS) const {
        const int row0 = u.pm * BM + wr * 64 + fr, cin = wc * 32 + 8 * fq, pn = u.pn;
        f32x4 bv[2][2];
#pragma unroll
        for (int bj = 0; bj < 2; ++bj)
#pragma unroll
            for (int n = 0; n < 2; ++n) bv[bj][n] = *(const LAS f32x4*)(biasp + pn * BM + bj * HALF + cin + 4 * n);
        if (pn == 4 || pn == 5) {
            const int oc = 512 + (pn - 4) * 256 + cin;
#pragma unroll
            for (int ai = 0; ai < 2; ++ai)
#pragma unroll
                for (int m = 0; m < 4; ++m) { bf16_t* rowp = H + (size_t)(row0 + ai * HALF + m * 16) * H0P + oc;
#pragma unroll
                    for (int bj = 0; bj < 2; ++bj) *(u32x4*)(rowp + bj * HALF) = pack8(acc[ai][bj][m][0] + bv[bj][0], acc[ai][bj][m][1] + bv[bj][1]); }
        } else {
            const bool glu = pn < 4; const int oc = glu ? pn * 128 + cin : 1024 + (pn - 6) * 128 + cin;
            if (glu) {
#pragma unroll
                for (int ai = 0; ai < 2; ++ai)
#pragma unroll
                    for (int m = 0; m < 4; ++m) { bf16_t* rowp = H + (size_t)(row0 + ai * HALF + m * 16) * H0P + oc;
                        const f32x4 a0 = acc[ai][0][m][0] + bv[0][0], a1 = acc[ai][0][m][1] + bv[0][1]; const f32x4 g0 = sigm4(acc[ai][1][m][0] + bv[1][0]), g1 = sigm4(acc[ai][1][m][1] + bv[1][1]);
                        *(u32x4*)rowp = pack8(a0 * g0, a1 * g1); }
            } else {
#pragma unroll
                for (int ai = 0; ai < 2; ++ai)
#pragma unroll
                    for (int m = 0; m < 4; ++m) { bf16_t* rowp = H + (size_t)(row0 + ai * HALF + m * 16) * H0P + oc;
                        const f32x4 a0 = acc[ai][0][m][0] + bv[0][0], a1 = acc[ai][0][m][1] + bv[0][1]; const f32x4 g0 = acc[ai][1][m][0] + bv[1][0], g1 = acc[ai][1][m][1] + bv[1][1];
                        *(u32x4*)rowp = pack8(a0 * g0, a1 * g1); }
            }
        }
    }
};
struct EpiIn1 {
    static constexpr bool PERM = true, BJ8 = true;
    bf16_t* H; const LAS float* bias;
    __device__ __forceinline__ void stage(const Unit&, int, int) const {}
    __device__ __forceinline__ void operator()(PG8_EPI_ARGS) const {
        const int row0 = u.pm * BM + wr * 64 + fr, col0 = u.pn * BM + wc * 64 + 16 * fq; const float sc = (u.pn == 4 || u.pn == 5) ? QSCALE : 1.0f;
        f32x4 bv[2][2];
#pragma unroll
        for (int bj = 0; bj < 2; ++bj)
#pragma unroll
            for (int n = 0; n < 2; ++n) bv[bj][n] = *(const LAS f32x4*)(bias + col0 + bj * 8 + 4 * n);
#pragma unroll
        for (int ai = 0; ai < 2; ++ai)
#pragma unroll
            for (int m = 0; m < 4; ++m) { bf16_t* rowp = H + (size_t)(row0 + ai * HALF + m * 16) * H1P + col0;
#pragma unroll
                for (int bj = 0; bj < 2; ++bj) *(u32x4*)(rowp + bj * 8) = pack8((acc[ai][bj][m][0] + bv[bj][0]) * sc, (acc[ai][bj][m][1] + bv[bj][1]) * sc); }
    }
};
template <bool RESF32, bool SKIPMIX> struct EpiOut {
    static constexpr bool PERM = true, BJ8 = true;
    bf16_t* Z; const void* res;
    __device__ __forceinline__ void stage(const Unit&, int, int) const {}
    __device__ __forceinline__ void operator()(PG8_EPI_ARGS) const {
        static_assert(!RESF32, "bf16 residual only");
        const int row0 = u.pm * BM + wr * 64 + fr, col0 = u.pn * BM + wc * 64 + 16 * fq;
        u32x4 w[2][4][2];
#pragma unroll
        for (int ai = 0; ai < 2; ++ai)
#pragma unroll
            for (int m = 0; m < 4; ++m)
#pragma unroll
                for (int bj = 0; bj < 2; ++bj) w[ai][m][bj] = __builtin_nontemporal_load((const u32x4*)((const bf16_t*)res + (size_t)(row0 + ai * HALF + m * 16) * DM + col0 + bj * 8));
#pragma unroll
        for (int ai = 0; ai < 2; ++ai)
#pragma unroll
            for (int m = 0; m < 4; ++m)
#pragma unroll
                for (int bj = 0; bj < 2; ++bj) { const size_t off = (size_t)(row0 + ai * HALF + m * 16) * DM + col0 + bj * 8; const u32x4 ww = w[ai][m][bj];
                    const f32x4 r0 = (f32x4){bflo(ww.x), bfhi(ww.x), bflo(ww.y), bfhi(ww.y)}, r1 = (f32x4){bflo(ww.z), bfhi(ww.z), bflo(ww.w), bfhi(ww.w)};
                    f32x4 v0 = r0 * ALPHA, v1 = r1 * ALPHA; if (!SKIPMIX) { v0 += acc[ai][bj][m][0]; v1 += acc[ai][bj][m][1]; }
                    *(u32x4*)(Z + off) = pack8(v0, v1); }
    }
};
struct EpiGU {
    static constexpr bool PERM = true, BJ8 = false;
    unsigned char* HH;
    __device__ __forceinline__ void stage(const Unit&, int, int) const {}
    __device__ __forceinline__ void operator()(PG8_EPI_ARGS) const {
        const int row0 = u.pm * BM + wr * 64 + fr, oc = u.pn * 128 + wc * 32 + 8 * fq;
#pragma unroll
        for (int ai = 0; ai < 2; ++ai)
#pragma unroll
            for (int m = 0; m < 4; ++m) { unsigned char* rowp = HH + (size_t)(row0 + ai * HALF + m * 16) * DE + oc;
                const f32x4 a0 = acc[ai][0][m][0], a1 = acc[ai][0][m][1];
                const f32x4 h0 = (a0 * acc[ai][1][m][0]) * sigs4(a0) * (W8INV * W8INV), h1 = (a1 * acc[ai][1][m][1]) * sigs4(a1) * (W8INV * W8INV);
                *(u32x2*)rowp = (u32x2){pk4_fp8(h0[0], h0[1], h0[2], h0[3]), pk4_fp8(h1[0], h1[1], h1[2], h1[3])}; }
    }
};
struct EpiDown {
    static constexpr bool PERM = true, BJ8 = true;
    unsigned char* YB; const unsigned* list; const float* roww; LAS unsigned* lrow;
    __device__ __forceinline__ void stage(const Unit& u, int wid, int lane) const {
        const unsigned* src = (wid < 4 ? list : (const unsigned*)roww) + u.lbase + (wid & 3) * 64;
        __builtin_amdgcn_global_load_lds((const unsigned*)(src + lane), (LAS unsigned*)(lrow + u.slot * 512 + wid * 64), 4, 0, 0);
    }
    __device__ __forceinline__ void operator()(PG8_EPI_ARGS) const {
        const int col0 = u.pn * BM + wc * 64 + 16 * fq;
#pragma unroll
        for (int ai = 0; ai < 2; ++ai)
#pragma unroll
            for (int m = 0; m < 4; ++m) { const int r = ai * HALF + wr * 64 + m * 16 + fr;
                if (r < u.nvalid) { const unsigned e = lrow[u.slot * 512 + r]; const float w = __uint_as_float(lrow[u.slot * 512 + 256 + r]) * (W8INV * Y8SCALE); unsigned char* rowp = YB + (size_t)e * DM + col0;
                    const f32x4 v0 = acc[ai][0][m][0] * w, v1 = acc[ai][0][m][1] * w, v2 = acc[ai][1][m][0] * w, v3 = acc[ai][1][m][1] * w;
                    *(u32x4*)rowp = (u32x4){pk4_fp8(v0[0], v0[1], v0[2], v0[3]), pk4_fp8(v1[0], v1[1], v1[2], v1[3]), pk4_fp8(v2[0], v2[1], v2[2], v2[3]), pk4_fp8(v3[0], v3[1], v3[2], v3[3])}; } }
    }
};
}

#define XB_TMO      128
#define XB_XCNT(j)  (256  + 64 * (j))
#define XB_XSUB(j)  (1280 + 64 * (j))
#define XB_XGEN(j)  (2304 + 64 * (j))
#define XB_TOP      3328
#define XB_TOPGEN   3392
#define XCD_BAR_WORDS 3456
#define XB_SPIN_CAP (1u << 18)
__device__ __forceinline__ unsigned xb_ld(unsigned* p)              { return __hip_atomic_load(p, __ATOMIC_RELAXED, __HIP_MEMORY_SCOPE_AGENT); }
__device__ __forceinline__ unsigned xb_add(unsigned* p, unsigned v) { return __hip_atomic_fetch_add(p, v, __ATOMIC_RELAXED, __HIP_MEMORY_SCOPE_AGENT); }
__device__ __forceinline__ unsigned xb_xcc_id() { return (unsigned)__builtin_amdgcn_s_getreg((3 << 11) | 20) & 0xFu; }
#define XB_SPIN(cond, bar) do { unsigned _sp = 0; while (cond) { __builtin_amdgcn_s_sleep(1); \
    if ((++_sp & 255u) == 0u) { if (xb_ld(&(bar)[XB_TMO])) break; if (_sp > XB_SPIN_CAP) { atomicAdd(&(bar)[XB_TMO], 1u); break; } } } } while (0)
struct XcdBarrier { unsigned* bar; unsigned x; volatile LAS unsigned* st; };
__device__ __forceinline__ XcdBarrier xcd_barrier_post(unsigned* bar, volatile LAS unsigned* st) {
    XcdBarrier b; b.bar = bar; b.x = xb_xcc_id(); b.st = st;
    if (threadIdx.x == 0) (void)xb_add(&bar[XB_XCNT(b.x)], 1u);
    return b;
}
__device__ __forceinline__ void xcd_barrier_complete(unsigned* bar, unsigned x, unsigned& nloc, unsigned& nx) {
    const unsigned G = gridDim.x * gridDim.y * gridDim.z;
    unsigned sum, cnt, mine, sp = 0u;
    for (;;) {
        sum = 0u; cnt = 0u; mine = 0u;
#pragma unroll
        for (unsigned j = 0; j < 16; ++j) { const unsigned c = xb_ld(&bar[XB_XCNT(j)]); sum += c; cnt += (c > 0u) ? 1u : 0u; mine = (j == x) ? c : mine; }
        if (sum == G) break;
        __builtin_amdgcn_s_sleep(1);
        if ((++sp & 255u) == 0u) { if (xb_ld(&bar[XB_TMO])) break; if (sp > XB_SPIN_CAP) { atomicAdd(&bar[XB_TMO], 1u); break; } }
    }
    nloc = mine > 0u ? mine : 1u; nx = cnt > 0u ? cnt : 1u;
}
__device__ __forceinline__ void xcd_barrier(const XcdBarrier& b) {
    asm volatile("s_waitcnt vmcnt(0)" ::: "memory");
    __syncthreads();
    if (threadIdx.x == 0) {
        unsigned* bar = b.bar;
        __builtin_amdgcn_s_waitcnt(0);
        unsigned nloc = b.st[0], nx = b.st[1];
        if (nloc == 0u) { xcd_barrier_complete(bar, b.x, nloc, nx); b.st[0] = nloc; b.st[1] = nx; }
        const unsigned old = xb_add(&bar[XB_XSUB(b.x)], 1u);
        const unsigned gen = old / nloc;
        if (old + 1u == (gen + 1u) * nloc) {
            __builtin_amdgcn_fence(__ATOMIC_RELEASE, "agent");
            asm volatile("s_waitcnt vmcnt(0)" ::: "memory");
            const unsigned og = xb_add(&bar[XB_TOP], 1u);
            const unsigned tg = og / nx;
            if (og + 1u == (tg + 1u) * nx) xb_add(&bar[XB_TOPGEN], 1u);
            else XB_SPIN(xb_ld(&bar[XB_TOPGEN]) == tg, bar);
            __builtin_amdgcn_fence(__ATOMIC_ACQUIRE, "agent");
            xb_add(&bar[XB_XGEN(b.x)], 1u);
            asm volatile("s_waitcnt vmcnt(0)" ::: "memory");
        } else {
            XB_SPIN(xb_ld(&bar[XB_XGEN(b.x)]) == gen, bar);
            __builtin_amdgcn_fence(__ATOMIC_ACQUIRE, "agent");
            asm volatile("s_waitcnt vmcnt(0)" ::: "memory");
        }
    }
    __syncthreads();
}

struct Args { const float* in[28]; float* out; unsigned char* ws; int ph_lo, ph_hi, dbl, pad; };
enum { I_X = 0, I_AB_WIN, I_AB_BIN, I_A_DW, I_A_DWB, I_A_LNG, I_A_LNB, I_B_DW, I_AB_WOUT, I_CD_WIN, I_CD_BIN, I_C_LNG, I_C_LNB, I_C_WS, I_C_WSB, I_D_REL, I_CD_WOUT,
       I_MIX_LNG, I_MIX_LNB, I_RG_W, I_RG_B, I_RE_W, I_RE_B, I_WGATE, I_WUP, I_WDOWN, I_FFN_LNG, I_FFN_LNB };

__device__ __forceinline__ void p0_transpose_item(const float* W, int K, int N, bf16_t* WT, int k0, int n0, int drow0, LAS float* scr, int lane) {
    const int n4 = lane & 15, kr = lane >> 4;
    f32x4 v[16];
#pragma unroll
    for (int i = 0; i < 16; ++i) v[i] = __builtin_nontemporal_load((const GAS f32x4*)(W + (size_t)(k0 + 4 * i + kr) * N + n0 + 4 * n4));
#pragma unroll
    for (int i = 0; i < 16; ++i) { const int k = 4 * i + kr; *(LAS f32x4*)(scr + k * 64 + ((4 * n4) ^ (4 * ((k >> 3) & 7)))) = v[i]; }
    LDS_WAIT(); asm volatile("" ::: "memory");
    const int c = lane & 7;
#pragma unroll
    for (int it = 0; it < 8; ++it) { const int n = (lane >> 3) + 8 * it; const LAS float* s = scr + (8 * c) * 64 + (n ^ (4 * c));
        u32x4 o; o.x = pk2(s[0 * 64], s[1 * 64]); o.y = pk2(s[2 * 64], s[3 * 64]); o.z = pk2(s[4 * 64], s[5 * 64]); o.w = pk2(s[6 * 64], s[7 * 64]);
        __builtin_nontemporal_store(o, (GAS u32x4*)(WT + (size_t)(drow0 + n) * K + k0 + 8 * c)); }
    LDS_WAIT(); asm volatile("" ::: "memory");
}
__device__ __forceinline__ void p0_transpose_item_f8(const float* W, int K, int N, unsigned char* WT8, int k0, int n0, int drow0, LAS float* scr, int lane, float scale) {
    const int n4 = lane & 15, kr = lane >> 4;
    f32x4 v[16];
#pragma unroll
    for (int i = 0; i < 16; ++i) v[i] = __builtin_nontemporal_load((const GAS f32x4*)(W + (size_t)(k0 + 4 * i + kr) * N + n0 + 4 * n4));
#pragma unroll
    for (int i = 0; i < 16; ++i) { const int k = 4 * i + kr; *(LAS f32x4*)(scr + k * 64 + ((4 * n4) ^ (4 * ((k >> 3) & 7)))) = v[i]; }
    LDS_WAIT(); asm volatile("" ::: "memory");
    const int c = lane & 3;
#pragma unroll
    for (int it = 0; it < 4; ++it) { const int n = (lane >> 2) + 16 * it; float s[16];
#pragma unroll
        for (int j = 0; j < 16; ++j) { const int k = 16 * c + j; s[j] = scr[k * 64 + (n ^ (4 * ((k >> 3) & 7)))] * scale; }
        u32x4 o; o.x = pk4_fp8(s[0], s[1], s[2], s[3]); o.y = pk4_fp8(s[4], s[5], s[6], s[7]); o.z = pk4_fp8(s[8], s[9], s[10], s[11]); o.w = pk4_fp8(s[12], s[13], s[14], s[15]);
        __builtin_nontemporal_store(o, (GAS u32x4*)(WT8 + (size_t)(drow0 + n) * K + k0 + 16 * c)); }
    LDS_WAIT(); asm volatile("" ::: "memory");
}
__device__ __forceinline__ int perm_ab(int n) {
    const int seg = n >> 9, ch = n & 511, t = ch >> 7, r = ch & 127;
    if (seg == 0) return t * 256 + r;
    if (seg == 1) return t * 256 + 128 + r;
    if (seg == 2) return 1024 + ch;
    if (seg == 3) return 1536 + t * 256 + r;
    return 1536 + t * 256 + 128 + r;
}
constexpr int MOE_W_ITEMS = NE * 3 * 128;
__device__ __forceinline__ void moe_w_item(const Args& A, int r, LAS float* scr, int lane) {
    unsigned char* ws = A.ws;
    const int mat = r >> 7, q = r & 127, le = mat / 3, kind = mat % 3;
    if (kind < 2) {
        const int nb = q % (DE / 64), kb = q / (DE / 64), n0 = 64 * nb;
        const float* src = A.in[kind == 0 ? I_WGATE : I_WUP] + (size_t)le * DM * DE;
        p0_transpose_item_f8(src, DM, DE, ws + WS_WGU + (size_t)le * DM * DM, 64 * kb, n0, (n0 >> 7) * 256 + kind * 128 + (n0 & 127), scr, lane, W8SCALE);
    } else {
        const int nb = q % (DM / 64), kb = q / (DM / 64);
        p0_transpose_item_f8(A.in[I_WDOWN] + (size_t)le * DE * DM, DE, DM, ws + WS_WD + (size_t)le * DM * DE, 64 * kb, 64 * nb, 64 * nb, scr, lane, W8SCALE);
    }
}
__device__ __forceinline__ void moe_w_ids(const Args& A, LAS unsigned char* lds, int layer, int wave, int lane, int id0, int stride, int count) {
    LAS float* scr = (LAS float*)(lds + wave * 16384);
    for (int k = 0, id = id0; k < count && id < MOE_W_ITEMS / NWAVES; ++k, id += stride) moe_w_item(A, layer * MOE_W_ITEMS + id * NWAVES + wave, scr, lane);
}
constexpr int SLACK_K5 = 2, SLACK_K6 = 2;
__device__ __forceinline__ int slack_first(int T) { return (4 * T) & 255; }
__device__ __forceinline__ int slack_done(int T) { const int f = slack_first(T); return f ? (256 - f) * (SLACK_K5 + SLACK_K6) : 0; }
__device__ __forceinline__ void moe_w_steps(const Args& A, LAS unsigned char* lds, int layer, int vcu, int wave, int lane, int s0, int s1) {
    LAS float* scr = (LAS float*)(lds + wave * 16384);
    for (int s = s0; s < s1; ++s) moe_w_item(A, layer * MOE_W_ITEMS + (s * 256 + vcu) * NWAVES + wave, scr, lane);
}
__device__ __forceinline__ void p0_prologue(const Args& A, LAS unsigned char* lds, int vcu, int G, int wave, int lane, int tid, int rp) {
    unsigned char* ws = A.ws;
    LAS float* scr = (LAS float*)(lds + wave * 16384);
    const int gw = vcu * NWAVES + wave, NGW = G * NWAVES;
    constexpr int I_IN = (DM / 64) * (NIN / 64), I_OUT = (DM / 64) * (DM / 64);
    constexpr int NITEMS = 2 * I_IN + 2 * I_OUT + (MOE_W_IN_P0 ? 2 * MOE_W_ITEMS : 0);
    for (int it_ = gw; it_ < (NITEMS << rp); it_ += NGW) {
        int r = it_ >= NITEMS ? it_ - NITEMS : it_;
        if (r < I_IN) { const int nb = r % (NIN / 64), kb = r / (NIN / 64); p0_transpose_item(A.in[I_AB_WIN], DM, NIN, (bf16_t*)(ws + WS_WIN0), 64 * kb, 64 * nb, perm_ab(64 * nb), scr, lane); continue; } r -= I_IN;
        if (r < I_IN) { const int nb = r % (NIN / 64), kb = r / (NIN / 64); p0_transpose_item(A.in[I_CD_WIN], DM, NIN, (bf16_t*)(ws + WS_WIN1), 64 * kb, 64 * nb, 64 * nb, scr, lane); continue; } r -= I_IN;
        if (r < I_OUT) { const int nb = r % (DM / 64), kb = r / (DM / 64); p0_transpose_item(A.in[I_AB_WOUT], DM, DM, (bf16_t*)(ws + WS_WOUT0), 64 * kb, 64 * nb, 64 * nb, scr, lane); continue; } r -= I_OUT;
        if (r < I_OUT) { const int nb = r % (DM / 64), kb = r / (DM / 64); p0_transpose_item(A.in[I_CD_WOUT], DM, DM, (bf16_t*)(ws + WS_WOUT1), 64 * kb, 64 * nb, 64 * nb, scr, lane); continue; } r -= I_OUT;
        moe_w_item(A, r, scr, lane);
    }
    const int gt = vcu * NTHR + tid, NGT = G * NTHR;
    { const GAS f32x4* x4 = (const GAS f32x4*)A.in[I_X]; GAS u32x4* o = (GAS u32x4*)(ws + WS_XA);
      for (int i0_ = gt; i0_ < ((M * DM / 8) << rp); i0_ += 4 * NGT) { const int i0 = i0_ & (M * DM / 8 - 1); f32x4 a[4], b[4];
#pragma unroll
          for (int j = 0; j < 4; ++j) { const int i = i0 + j * NGT; a[j] = __builtin_nontemporal_load(x4 + 2 * i); b[j] = __builtin_nontemporal_load(x4 + 2 * i + 1); }
#pragma unroll
          for (int j = 0; j < 4; ++j) { const int i = i0 + j * NGT; u32x4 w; w.x = pk2(a[j][0], a[j][1]); w.y = pk2(a[j][2], a[j][3]); w.z = pk2(b[j][0], b[j][1]); w.w = pk2(b[j][2], b[j][3]); o[i] = w; } } }
    { float* bp = (float*)(ws + WS_BIASP); for (int n = gt; n < NIN; n += NGT) bp[perm_ab(n)] = A.in[I_AB_BIN][n]; }
    { bf16_t* wr = (bf16_t*)(ws + WS_WR);
      for (int i = gt; i < 2 * 48 * DM; i += NGT) { const int l = i / (48 * DM), r = (i / DM) % 48, k = i % DM; float v = 0.f;
          if (r < 4) v = A.in[I_RG_W][((size_t)l * DM + k) * 4 + r];
          else if (r < 36) { const int g = (r - 4) >> 3, e = (r - 4) & 7; v = A.in[I_RE_W][(((size_t)l * 4 + g) * DM + k) * 8 + e]; }
          wr[i] = (bf16_t)f2bf(v); } }
    { bf16_t* sw = (bf16_t*)(ws + WS_SGUW);
      for (int i = gt; i < 8 * 128 * 128; i += NGT) { const int ii = (i >> 7) & 127, j = i & 127; const float v = ((j >> 6) <= (ii >> 6)) ? A.in[I_C_WS][i] : 0.f; sw[i] = (bf16_t)f2bf(v); } }
}

#define LDS_BARRIER() do { asm volatile("s_waitcnt lgkmcnt(0)" ::: "memory"); __builtin_amdgcn_s_barrier(); asm volatile("" ::: "memory"); } while (0)
__device__ __forceinline__ void conv_phase(const Args& A, LAS unsigned char* lds, int vcu, int G, int wave, int lane, int tid, const bf16_t* H0, bf16_t* U, int rp) {
    LAS unsigned char* tileA = lds;
    LAS float* outA = (LAS float*)(lds + 63488);
    const int cp = tid & 255, pg = tid >> 8;
    float w0[31], w1[31];
#pragma unroll
    for (int t = 0; t < 31; ++t) { const f32x2 w = *(const f32x2*)(A.in[I_A_DW] + t * 512 + 2 * cp); w0[t] = w.x; w1[t] = w.y; }
    const f32x2 cb = *(const f32x2*)(A.in[I_A_DWB] + 2 * cp);
    const f32x4 g0 = *(const f32x4*)(A.in[I_A_LNG] + 4 * lane), g1 = *(const f32x4*)(A.in[I_A_LNG] + 256 + 4 * lane);
    const f32x4 b0 = *(const f32x4*)(A.in[I_A_LNB] + 4 * lane), b1 = *(const f32x4*)(A.in[I_A_LNB] + 256 + 4 * lane);
    const int nun = (BATCH * (SEQ / 32)) << rp;
    u32x4 tv[8];
#define CONV_TLOAD(un__) do { const int _un = (un__) & (BATCH * (SEQ / 32) - 1); const int _b = _un / (SEQ / 32), _s0 = (_un % (SEQ / 32)) * 32; \
        _Pragma("unroll") for (int k = 0; k < 8; ++k) { const int p = tid + k * NTHR, r = p >> 6, ch = p & 63, s = _s0 - 30 + r; tv[k] = (u32x4){0u, 0u, 0u, 0u}; \
            if (p < 62 * 64 && s >= 0) tv[k] = *(const u32x4*)(H0 + ((size_t)_b * SEQ + s) * H0P + ch * 8); } } while (0)
#define CONV_TSTORE() do { _Pragma("unroll") for (int k = 0; k < 8; ++k) { const int p = tid + k * NTHR, r = p >> 6, ch = p & 63; if (p < 62 * 64) *(LAS u32x4*)(tileA + r * 1024 + ch * 16) = tv[k]; } } while (0)
    if (vcu < nun) { CONV_TLOAD(vcu); CONV_TSTORE(); }
    __syncthreads();
    for (int un_ = vcu; un_ < nun; un_ += G) { const int un = un_ & (BATCH * (SEQ / 32) - 1);
        const int b = un / (SEQ / 32), s0 = (un % (SEQ / 32)) * 32; const size_t rowb = (size_t)b * SEQ;
        const bool more = un_ + G < nun;
        u32x4 bw[4][3], bg[4];
#define CONV_BLOAD(k0_, k1_) do { _Pragma("unroll") for (int k = (k0_); k < (k1_); ++k) { const int task = tid + k * NTHR, p = task >> 6, cg = task & 63; const int s = s0 + p; \
            _Pragma("unroll") for (int t = 0; t < 3; ++t) { const int ss = s - 2 + t; bw[k][t] = (u32x4){0u, 0u, 0u, 0u}; if (ss >= 0) bw[k][t] = *(const u32x4*)(H0 + (rowb + ss) * H0P + 1024 + cg * 8); } \
            bg[k] = *(const u32x4*)(H0 + (rowb + s) * H0P + 512 + cg * 8); } } while (0)
        CONV_BLOAD(0, 2);
#pragma unroll 1
        for (int tk = 0; tk < 2; ++tk) { const int pos0 = pg * 16 + tk * 8;
            float a0[8], a1[8];
#pragma unroll
            for (int p = 0; p < 8; ++p) { a0[p] = cb.x; a1[p] = cb.y; }
#pragma unroll
            for (int j = 0; j < 38; ++j) { const unsigned w = *(const LAS unsigned*)(tileA + (pos0 + j) * 1024 + cp * 4); const float x0 = bflo(w), x1 = bfhi(w);
#pragma unroll
                for (int p = 0; p < 8; ++p) { const int t = j - p; if (t >= 0 && t <= 30) { a0[p] += w0[t] * x0; a1[p] += w1[t] * x1; } } }
#pragma unroll
            for (int p = 0; p < 8; ++p) *(LAS f32x2*)(outA + (pos0 + p) * 512 + 2 * cp) = (f32x2){a0[p], a1[p]};
        }
        LDS_BARRIER();
        CONV_BLOAD(2, 4);
        if (more) CONV_TLOAD(un_ + G);
#pragma unroll 2
        for (int rr = 0; rr < 4; ++rr) { const int r = wave * 4 + rr;
            const f32x4 v0 = *(const LAS f32x4*)(outA + r * 512 + 4 * lane), v1 = *(const LAS f32x4*)(outA + r * 512 + 256 + 4 * lane);
            const float mean = wave_sum((v0[0] + v0[1]) + (v0[2] + v0[3]) + (v1[0] + v1[1]) + (v1[2] + v1[3])) * (1.f / 512.f);
            const f32x4 d0 = v0 - mean, d1 = v1 - mean;
            const float var = wave_sum((d0[0] * d0[0] + d0[1] * d0[1]) + (d0[2] * d0[2] + d0[3] * d0[3]) + (d1[0] * d1[0] + d1[1] * d1[1]) + (d1[2] * d1[2] + d1[3] * d1[3])) * (1.f / 512.f);
            const float rstd = __builtin_amdgcn_rsqf(var + LN_EPS);
            f32x4 y0 = d0 * rstd * g0 + b0, y1 = d1 * rstd * g1 + b1;
            y0 = y0 * pg8::sigm4(y0); y1 = y1 * pg8::sigm4(y1);
            bf16_t* orow = U + (rowb + s0 + r) * DM;
            *(u32x2*)(orow + 4 * lane) = (u32x2){cvt_pk_bf16(y0[0], y0[1]), cvt_pk_bf16(y0[2], y0[3])};
            *(u32x2*)(orow + 256 + 4 * lane) = (u32x2){cvt_pk_bf16(y1[0], y1[1]), cvt_pk_bf16(y1[2], y1[3])}; }
#pragma unroll
        for (int k = 0; k < 4; ++k) { const int task = tid + k * NTHR, p = task >> 6, cg = task & 63; const int s = s0 + p;
            f32x4 acc0 = (f32x4){0.f, 0.f, 0.f, 0.f}, acc1 = acc0;
#pragma unroll
            for (int t = 0; t < 3; ++t) { const u32x4 w = bw[k][t];
                const f32x4 k0 = *(const f32x4*)(A.in[I_B_DW] + t * 512 + cg * 8), k1 = *(const f32x4*)(A.in[I_B_DW] + t * 512 + cg * 8 + 4);
                acc0 += k0 * (f32x4){bflo(w.x), bfhi(w.x), bflo(w.y), bfhi(w.y)}; acc1 += k1 * (f32x4){bflo(w.z), bfhi(w.z), bflo(w.w), bfhi(w.w)}; }
            const u32x4 g = bg[k];
            acc0 *= (f32x4){bflo(g.x), bfhi(g.x), bflo(g.y), bfhi(g.y)}; acc1 *= (f32x4){bflo(g.z), bfhi(g.z), bflo(g.w), bfhi(g.w)};
            *(u32x4*)(U + (rowb + s) * DM + 512 + cg * 8) = pg8::pack8(acc0, acc1); }
        if (more) CONV_TSTORE();
        __syncthreads();
    }
#undef CONV_TLOAD
#undef CONV_BLOAD
#undef CONV_TSTORE
}

__device__ __forceinline__ void router_preload(const Args& A, LAS unsigned char* lds, int tid, int layer) {
    constexpr int RS = 2064; LAS unsigned char* wrl = lds;
    const bf16_t* WR = (const bf16_t*)(A.ws + WS_WR) + (size_t)layer * 48 * DM;
    u32x4 tv[9];
#pragma unroll
    for (int k = 0; k < 9; ++k) { const int p = tid + k * NTHR, r = p >> 7, ch = p & 127; tv[k] = *(const u32x4*)(WR + r * DM + ch * 8); }
#pragma unroll
    for (int k = 0; k < 9; ++k) { const int p = tid + k * NTHR, r = p >> 7, ch = p & 127; *(LAS u32x4*)(wrl + r * RS + ch * 16) = tv[k]; }
}
__device__ __forceinline__ void router_phase(const Args& A, LAS unsigned char* lds, int vcu, int wave, int lane, int tid, int layer, const bf16_t* Z, bf16_t* X1, unsigned* cnt, int rp, bool preloaded) {
    constexpr int RS = 2064;
    LAS unsigned char* wrl = lds;
    LAS unsigned char* xt = lds + 36 * RS;
    LAS float* lgp = (LAS float*)(lds + 36 * RS + 16 * RS);
    LAS float* lg = (LAS float*)(lds + 36 * RS + 16 * RS + 18432);
    LAS unsigned* rec = (LAS unsigned*)(lds + ROUTER_REC_OFF);
    if (!preloaded) router_preload(A, lds, tid, layer);
    const float* lng = A.in[I_MIX_LNG] + layer * DM; const float* lnb = A.in[I_MIX_LNB] + layer * DM;
    const float* rgb = A.in[I_RG_B] + layer * 4; const float* reb = A.in[I_RE_B] + layer * 32;
    f32x4 g[4], bb[4];
#pragma unroll
    for (int q = 0; q < 2; ++q) { g[2 * q] = *(const f32x4*)(lng + q * 512 + lane * 8); g[2 * q + 1] = *(const f32x4*)(lng + q * 512 + lane * 8 + 4);
        bb[2 * q] = *(const f32x4*)(lnb + q * 512 + lane * 8); bb[2 * q + 1] = *(const f32x4*)(lnb + q * 512 + lane * 8 + 4); }
    const int rc0 = tid % 36, rc1 = (tid + NTHR) % 36;
    const float rbias0 = rc0 < 4 ? rgb[rc0] : reb[rc0 - 4], rbias1 = rc1 < 4 ? rgb[rc1] : reb[rc1 - 4];
    const int tok0 = vcu * 128;
    u32x4 pre[2][2];
#pragma unroll
    for (int tt = 0; tt < 2; ++tt) { const int tok = tok0 + 2 * wave + tt; pre[tt][0] = __builtin_nontemporal_load((const u32x4*)(Z + (size_t)tok * DM + lane * 8)); pre[tt][1] = __builtin_nontemporal_load((const u32x4*)(Z + (size_t)tok * DM + 512 + lane * 8)); }
    __syncthreads();
#pragma unroll 1
    for (int k_ = 0; k_ < (8 << rp); ++k_) { const int k = k_ & 7;
        u32x4 curp[2][2];
#pragma unroll
        for (int tt = 0; tt < 2; ++tt) { curp[tt][0] = pre[tt][0]; curp[tt][1] = pre[tt][1]; }
        if (k_ < (8 << rp) - 1) {
#pragma unroll
            for (int tt = 0; tt < 2; ++tt) { const int tok = tok0 + 16 * ((k + 1) & 7) + 2 * wave + tt; pre[tt][0] = __builtin_nontemporal_load((const u32x4*)(Z + (size_t)tok * DM + lane * 8)); pre[tt][1] = __builtin_nontemporal_load((const u32x4*)(Z + (size_t)tok * DM + 512 + lane * 8)); } }
#pragma unroll
        for (int tt = 0; tt < 2; ++tt) { const int tl = 2 * wave + tt, tok = tok0 + 16 * k + tl;
            const u32x4 p0 = curp[tt][0], p1 = curp[tt][1];
            f32x4 v[4] = {(f32x4){bflo(p0.x), bfhi(p0.x), bflo(p0.y), bfhi(p0.y)}, (f32x4){bflo(p0.z), bfhi(p0.z), bflo(p0.w), bfhi(p0.w)},
                          (f32x4){bflo(p1.x), bfhi(p1.x), bflo(p1.y), bfhi(p1.y)}, (f32x4){bflo(p1.z), bfhi(p1.z), bflo(p1.w), bfhi(p1.w)}};
            float s = 0.f;
#pragma unroll
            for (int j = 0; j < 4; ++j) s += (v[j][0] + v[j][1]) + (v[j][2] + v[j][3]);
            const float mean = wave_sum(s) * (1.f / DM); float s2 = 0.f;
#pragma unroll
            for (int j = 0; j < 4; ++j) { v[j] = v[j] - mean; s2 += (v[j][0] * v[j][0] + v[j][1] * v[j][1]) + (v[j][2] * v[j][2] + v[j][3] * v[j][3]); }
            const float rstd = __builtin_amdgcn_rsqf(wave_sum(s2) * (1.f / DM) + LN_EPS);
#pragma unroll
            for (int j = 0; j < 4; ++j) v[j] = v[j] * rstd * g[j] + bb[j];
            const u32x4 o0 = pg8::pack8(v[0], v[1]), o1 = pg8::pack8(v[2], v[3]);
            if constexpr (!X1_RECOMP) { __builtin_nontemporal_store(o0, (u32x4*)(X1 + (size_t)tok * DM + lane * 8)); __builtin_nontemporal_store(o1, (u32x4*)(X1 + (size_t)tok * DM + 512 + lane * 8)); }
            { unsigned char* xq = A.ws + WS_X1Q + (size_t)tok * DM;
              *(u32x2*)(xq + lane * 8) = (u32x2){pk4_fp8(v[0][0], v[0][1], v[0][2], v[0][3]), pk4_fp8(v[1][0], v[1][1], v[1][2], v[1][3])};
              *(u32x2*)(xq + 512 + lane * 8) = (u32x2){pk4_fp8(v[2][0], v[2][1], v[2][2], v[2][3]), pk4_fp8(v[3][0], v[3][1], v[3][2], v[3][3])}; }
            *(LAS u32x4*)(xt + tl * RS + lane * 16) = o0; *(LAS u32x4*)(xt + tl * RS + 1024 + lane * 16) = o1; }
        __syncthreads();
        {
          f32x4 acc[3]; const int fr = lane & 15, fq = lane >> 4;
#pragma unroll
          for (int nt = 0; nt < 3; ++nt) acc[nt] = (f32x4){0.f, 0.f, 0.f, 0.f};
#pragma unroll
          for (int q = 0; q < 4; ++q) { const int kk = 4 * wave + q; const bf16x8 a = *(const LAS bf16x8*)(xt + fr * RS + (32 * kk + 8 * fq) * 2);
#pragma unroll
              for (int nt = 0; nt < 3; ++nt) { int br = 16 * nt + fr; br = br < 36 ? br : 35; const bf16x8 bw = *(const LAS bf16x8*)(wrl + br * RS + (32 * kk + 8 * fq) * 2);
                  acc[nt] = __builtin_amdgcn_mfma_f32_16x16x32_bf16(a, bw, acc[nt], 0, 0, 0); } }
#pragma unroll
          for (int nt = 0; nt < 3; ++nt) if (16 * nt + fr < 36) {
#pragma unroll
              for (int r = 0; r < 4; ++r) lgp[(wave * 16 + 4 * fq + r) * 36 + 16 * nt + fr] = acc[nt][r]; } }
        __syncthreads();
        { float v = rbias0;
#pragma unroll
          for (int w = 0; w < 8; ++w) v += lgp[w * 576 + tid];
          lg[tid] = v;
          if (tid < 64) { float v1 = rbias1;
#pragma unroll
              for (int w = 0; w < 8; ++w) v1 += lgp[w * 576 + NTHR + tid];
              lg[NTHR + tid] = v1; } }
        __syncthreads();
        if (tid < 64) {
            const int tq = tid >> 2, q = tid & 3; const LAS float* L = lg + tq * 36; const int tok = tok0 + 16 * k + tq;
            const float g = L[q];
            float gm = fmaxf(g, dpp_f<0xB1>(g)); gm = fmaxf(gm, dpp_f<0x4E>(gm));
            int gi = g == gm ? q : 4; gi = min(gi, dpp_i<0xB1>(gi)); gi = min(gi, dpp_i<0x4E>(gi));
            float gs = __builtin_amdgcn_exp2f((g - gm) * LOG2E); gs += dpp_f<0xB1>(gs); gs += dpp_f<0x4E>(gs);
            const float gtop = __builtin_amdgcn_rcpf(gs);
            const LAS float* Le = L + 4 + gi * 8 + 2 * q; const float ea = Le[0], eb = Le[1];
            float lm = fmaxf(ea, eb); int li = eb > ea ? 2 * q + 1 : 2 * q;
            float m1 = fmaxf(lm, dpp_f<0xB1>(lm)); m1 = fmaxf(m1, dpp_f<0x4E>(m1));
            int e1 = lm == m1 ? li : 8; e1 = min(e1, dpp_i<0xB1>(e1)); e1 = min(e1, dpp_i<0x4E>(e1));
            const float ea2 = (2 * q == e1) ? -3.0e38f : ea, eb2 = (2 * q + 1 == e1) ? -3.0e38f : eb;
            const float lm2 = fmaxf(ea2, eb2); const int li2 = eb2 > ea2 ? 2 * q + 1 : 2 * q;
            float m2 = fmaxf(lm2, dpp_f<0xB1>(lm2)); m2 = fmaxf(m2, dpp_f<0x4E>(m2));
            int e2 = lm2 == m2 ? li2 : 8; e2 = min(e2, dpp_i<0xB1>(e2)); e2 = min(e2, dpp_i<0x4E>(e2));
            const float q2 = __builtin_amdgcn_exp2f((m2 - m1) * LOG2E), w1 = gtop * __builtin_amdgcn_rcpf(1.0f + q2), w2 = w1 * q2;
            if (q == 0) { LAS unsigned* rp = rec + (16 * k + tq) * 8;
                rp[0] = (unsigned)(gi * 8 + e1); rp[1] = (unsigned)(tok * 2); rp[2] = __float_as_uint(w1);
                rp[4] = (unsigned)(gi * 8 + e2); rp[5] = (unsigned)(tok * 2 + 1); rp[6] = __float_as_uint(w2); } }
    }
    __syncthreads();
    {
        const int e = tid >> 4, s = tid & 15; int c = 0;
#pragma unroll
        for (int r = 0; r < 16; ++r) c += (rec[(16 * s + r) * 4] == (unsigned)e) ? 1 : 0;
        int incl = c;
#pragma unroll
        for (int o = 1; o < 16; o <<= 1) { const int t = __shfl_up(incl, o, 16); if (s >= o) incl += t; }
        const int total = __shfl(incl, 15, 16);
        unsigned base = 0; if (s == 0 && total > 0) base = __hip_atomic_fetch_add(cnt + e * 64, (unsigned)total, RLX_AGENT);
        base = __shfl(base, 0, 16) + (unsigned)(incl - c);
        unsigned* list = (unsigned*)(A.ws + WS_LIST) + (size_t)e * CAP; float* roww = (float*)(A.ws + WS_ROWW) + (size_t)e * CAP;
#pragma unroll
        for (int r = 0; r < 16; ++r) { const int q = (16 * s + r) * 4; if (rec[q] == (unsigned)e) { list[base] = rec[q + 1]; roww[base] = __uint_as_float(rec[q + 2]); ++base; } } }
    __syncthreads();
}

__device__ __forceinline__ int moe_table(LAS unsigned char* lds, const unsigned* cnt, int tid) {
    LAS unsigned* tb = (LAS unsigned*)(lds + TBL_OFF);
    __syncthreads();
    if (tid < NE) tb[tid] = __hip_atomic_load(cnt + tid * 64, RLX_AGENT);
    __syncthreads();
    if (tid < 64) { const int n = tid < NE ? (((int)tb[tid] + 255) >> 8) : 0; int incl = n;
#pragma unroll
        for (int o = 1; o < 32; o <<= 1) { const int t = __shfl_up(incl, o, 64); if (tid >= o) incl += t; }
        if (tid < NE) { int T = incl - n; for (int m = 0; m < n; ++m) tb[64 + T++] = ((unsigned)tid << 16) | (unsigned)m; }
        if (tid == NE - 1) tb[32] = (unsigned)incl; }
    __syncthreads();
    return (int)tb[32];
}

template <bool FINAL, bool SKIPMOE>
__device__ __forceinline__ void combine_ln_phase(const Args& A, int vcu, int G, int wave, int lane, int layer, const bf16_t* X1, const unsigned char* YB, bf16_t* XN, float* OUT, int rp) {
    const float* lng = A.in[I_FFN_LNG] + layer * DM; const float* lnb = A.in[I_FFN_LNB] + layer * DM;
    f32x4 g[4], bb[4], g1[4], b1[4];
#pragma unroll
    for (int q = 0; q < 2; ++q) { g[2 * q] = *(const f32x4*)(lng + q * 512 + lane * 8); g[2 * q + 1] = *(const f32x4*)(lng + q * 512 + lane * 8 + 4);
        bb[2 * q] = *(const f32x4*)(lnb + q * 512 + lane * 8); bb[2 * q + 1] = *(const f32x4*)(lnb + q * 512 + lane * 8 + 4); }
    if constexpr (X1_RECOMP) { const float* mg = A.in[I_MIX_LNG] + layer * DM; const float* mb = A.in[I_MIX_LNB] + layer * DM;
#pragma unroll
        for (int q = 0; q < 2; ++q) { g1[2 * q] = *(const f32x4*)(mg + q * 512 + lane * 8); g1[2 * q + 1] = *(const f32x4*)(mg + q * 512 + lane * 8 + 4);
            b1[2 * q] = *(const f32x4*)(mb + q * 512 + lane * 8); b1[2 * q + 1] = *(const f32x4*)(mb + q * 512 + lane * 8 + 4); } }
#pragma unroll 1
    for (int tok_ = vcu * NWAVES + wave; tok_ < (M << rp); tok_ += G * NWAVES) { const int tok = tok_ & (M - 1);
        u32x4 px[2]; u32x2 py0[2], py1[2];
#pragma unroll
        for (int q = 0; q < 2; ++q) { px[q] = __builtin_nontemporal_load((const u32x4*)(X1 + (size_t)tok * DM + q * 512 + lane * 8));
            if (!SKIPMOE) { py0[q] = __builtin_nontemporal_load((const u32x2*)(YB + (size_t)(2 * tok) * DM + q * 512 + lane * 8)); py1[q] = __builtin_nontemporal_load((const u32x2*)(YB + (size_t)(2 * tok + 1) * DM + q * 512 + lane * 8)); }
            else { py0[q] = (u32x2){0u, 0u}; py1[q] = py0[q]; } }
        f32x4 v[4];
#pragma unroll
        for (int q = 0; q < 2; ++q) { v[2 * q] = (f32x4){bflo(px[q].x), bfhi(px[q].x), bflo(px[q].y), bfhi(px[q].y)}; v[2 * q + 1] = (f32x4){bflo(px[q].z), bfhi(px[q].z), bflo(px[q].w), bfhi(px[q].w)}; }
        if constexpr (X1_RECOMP) { float t = 0.f;
#pragma unroll
            for (int j = 0; j < 4; ++j) t += (v[j][0] + v[j][1]) + (v[j][2] + v[j][3]);
            const float m1 = wave_sum(t) * (1.f / DM); float t2 = 0.f;
#pragma unroll
            for (int j = 0; j < 4; ++j) { v[j] = v[j] - m1; t2 += (v[j][0] * v[j][0] + v[j][1] * v[j][1]) + (v[j][2] * v[j][2] + v[j][3] * v[j][3]); }
            const float r1 = __builtin_amdgcn_rsqf(wave_sum(t2) * (1.f / DM) + LN_EPS);
#pragma unroll
            for (int j = 0; j < 4; ++j) v[j] = v[j] * r1 * g1[j] + b1[j]; }
#pragma unroll
        for (int q = 0; q < 2; ++q) {
            v[2 * q] = v[2 * q] * ALPHA + (unpk4_fp8(py0[q].x) + unpk4_fp8(py1[q].x)) * Y8INV;
            v[2 * q + 1] = v[2 * q + 1] * ALPHA + (unpk4_fp8(py0[q].y) + unpk4_fp8(py1[q].y)) * Y8INV; }
        float s = 0.f;
#pragma unroll
        for (int j = 0; j < 4; ++j) s += (v[j][0] + v[j][1]) + (v[j][2] + v[j][3]);
        const float mean = wave_sum(s) * (1.f / DM); float s2 = 0.f;
#pragma unroll
        for (int j = 0; j < 4; ++j) { v[j] = v[j] - mean; s2 += (v[j][0] * v[j][0] + v[j][1] * v[j][1]) + (v[j][2] * v[j][2] + v[j][3] * v[j][3]); }
        const float rstd = __builtin_amdgcn_rsqf(wave_sum(s2) * (1.f / DM) + LN_EPS);
#pragma unroll
        for (int j = 0; j < 4; ++j) v[j] = v[j] * rstd * g[j] + bb[j];
        if (FINAL) {
#pragma unroll
            for (int q = 0; q < 2; ++q) { __builtin_nontemporal_store(v[2 * q], (f32x4*)(OUT + (size_t)tok * DM + q * 512 + lane * 8)); __builtin_nontemporal_store(v[2 * q + 1], (f32x4*)(OUT + (size_t)tok * DM + q * 512 + lane * 8 + 4)); }
        } else {
#pragma unroll
            for (int q = 0; q < 2; ++q) *(u32x4*)(XN + (size_t)tok * DM + q * 512 + lane * 8) = pg8::pack8(v[2 * q], v[2 * q + 1]);
        }
    }
}

__device__ __forceinline__ s16x4 tr16(const LAS unsigned char* p) { return __builtin_bit_cast(s16x4, __builtin_amdgcn_ds_read_tr16_b64_v4i16((LAS s16x4*)p)); }
__device__ __forceinline__ int sgu_sw(int row) { return (row & 3) | ((row >> 1) & 4); }
__device__ __forceinline__ void sgu_unit(const Args& A, LAS unsigned char* lds, int wave, int lane, int b, int blk, const bf16_t* H1, bf16_t* U) {
    const size_t row0 = (size_t)b * SEQ + (size_t)blk * 128;
    const int h = wave, fr = lane & 15, fq = lane >> 4, q = fr >> 2, p = fr & 3;
    const bf16_t* Wm = (const bf16_t*)(A.ws + WS_SGUW) + (size_t)h * 128 * 128 + (size_t)fr * 128 + 8 * fq;
    const bf16_t* Up = H1 + (row0 + fr) * H1P + h * 64 + 16 * fq;
    constexpr int DIST = 2, NSET = DIST + 1;
    bf16x8 wf[NSET][4]; u32x4 uu[8][2]; float bs[8];
#define SGU_LOADW(it_) do { _Pragma("unroll") for (int kk = 0; kk < 4; ++kk) if (kk < ((it_) < 4 ? 2 : 4)) wf[(it_) % NSET][kk] = *(const bf16x8*)(Wm + (size_t)(16 * (it_)) * 128 + 32 * kk); } while (0)
#pragma unroll
    for (int it = 0; it < 8; ++it) {
#pragma unroll
        for (int c2 = 0; c2 < 2; ++c2) uu[it][c2] = __builtin_nontemporal_load((const u32x4*)(Up + (size_t)(16 * it) * H1P + 8 * c2));
        bs[it] = A.in[I_C_WSB][h * 128 + 16 * it + fr]; }
    { const f32x4 g0 = *(const f32x4*)(A.in[I_C_LNG] + lane * 8), g1 = *(const f32x4*)(A.in[I_C_LNG] + lane * 8 + 4), b0 = *(const f32x4*)(A.in[I_C_LNB] + lane * 8), b1 = *(const f32x4*)(A.in[I_C_LNB] + lane * 8 + 4);
      u32x4 pv[16];
#pragma unroll
      for (int jj = 0; jj < 16; ++jj) pv[jj] = __builtin_nontemporal_load((const u32x4*)(H1 + (row0 + wave * 16 + jj) * H1P + 512 + lane * 8));
#pragma unroll
      for (int jj = 0; jj < 16; ++jj) { const int j = wave * 16 + jj; const u32x4 p = pv[jj];
        f32x4 v0 = (f32x4){bflo(p.x), bfhi(p.x), bflo(p.y), bfhi(p.y)}, v1 = (f32x4){bflo(p.z), bfhi(p.z), bflo(p.w), bfhi(p.w)};
        const float mean = wave_sum((v0[0] + v0[1]) + (v0[2] + v0[3]) + (v1[0] + v1[1]) + (v1[2] + v1[3])) * (1.f / 512.f);
        v0 = v0 - mean; v1 = v1 - mean;
        const float var = wave_sum((v0[0] * v0[0] + v0[1] * v0[1]) + (v0[2] * v0[2] + v0[3] * v0[3]) + (v1[0] * v1[0] + v1[1] * v1[1]) + (v1[2] * v1[2] + v1[3] * v1[3])) * (1.f / 512.f);
        const float rstd = __builtin_amdgcn_rsqf(var + LN_EPS);
        v0 = v0 * rstd * g0 + b0; v1 = v1 * rstd * g1 + b1;
        *(LAS u32x4*)(lds + j * 1024 + ((lane ^ sgu_sw(j)) << 4)) = pg8::pack8(v0, v1); } }
#pragma unroll
    for (int it = 0; it < DIST; ++it) SGU_LOADW(it);
    __syncthreads();
    {
#pragma unroll
      for (int it = 0; it < 8; ++it) { const int nk = it < 4 ? 2 : 4;
        if (it + DIST < 8) SGU_LOADW(it + DIST);
        f32x4 acc[4];
#pragma unroll
        for (int ct = 0; ct < 4; ++ct) acc[ct] = (f32x4){0.f, 0.f, 0.f, 0.f};
#pragma unroll
        for (int kk = 0; kk < 4; ++kk) if (kk < nk) {
#pragma unroll
            for (int ct = 0; ct < 4; ++ct) { const int col = h * 64 + 16 * p + 4 * ct; const int r0 = 32 * kk + 8 * fq + q, r1 = r0 + 4;
                const s16x4 lo = tr16(lds + r0 * 1024 + (((col >> 3) ^ sgu_sw(r0)) << 4) + (col & 7) * 2), hi = tr16(lds + r1 * 1024 + (((col >> 3) ^ sgu_sw(r1)) << 4) + (col & 7) * 2);
                const bf16x8 vf = (bf16x8){lo[0], lo[1], lo[2], lo[3], hi[0], hi[1], hi[2], hi[3]};
                acc[ct] = __builtin_amdgcn_mfma_f32_16x16x32_bf16(vf, wf[it % NSET][kk], acc[ct], 0, 0, 0); } }
        const int i = 16 * it + fr; const float bias = bs[it];
#pragma unroll
        for (int c2 = 0; c2 < 2; ++c2) { const int c = h * 64 + 16 * fq + 8 * c2; const u32x4 u4 = uu[it][c2]; const f32x4 a0 = acc[2 * c2], a1 = acc[2 * c2 + 1];
            const float o0 = bflo(u4.x) * (a0[0] + bias), o1 = bfhi(u4.x) * (a0[1] + bias), o2 = bflo(u4.y) * (a0[2] + bias), o3 = bfhi(u4.y) * (a0[3] + bias);
            const float o4 = bflo(u4.z) * (a1[0] + bias), o5 = bfhi(u4.z) * (a1[1] + bias), o6 = bflo(u4.w) * (a1[2] + bias), o7 = bfhi(u4.w) * (a1[3] + bias);
            *(u32x4*)(U + (row0 + i) * DM + c) = (u32x4){cvt_pk_bf16(o0, o1), cvt_pk_bf16(o2, o3), cvt_pk_bf16(o4, o5), cvt_pk_bf16(o6, o7)}; } }
#undef SGU_LOADW
    }
    __syncthreads();
}
__device__ __forceinline__ int crow(int r, int hi) { return (r & 3) + 8 * (r >> 2) + 4 * hi; }
__device__ __forceinline__ void attn_units(const Args& A, LAS unsigned char* lds, int wave, int lane, int tid, int b, int h, int par, const bf16_t* H1, bf16_t* U) {
    LAS unsigned char* Kb = lds; LAS unsigned char* Vb = lds + 40960; LAS float* biasL = (LAS float*)(lds + 81920);
    LAS float* wsf = (LAS float*)(lds + 86016) + wave * 64; LAS unsigned char* stg = lds + 90112 + wave * 4096;
    const int r32 = lane & 31, hi = lane >> 5, pj = wave >> 1;
    const size_t rowb = (size_t)b * SEQ;
    const bf16_t* qsrc = H1 + (rowb + (wave >> 1) * 64 + (wave & 1) * 32 + r32) * H1P + 1024 + h * 64 + hi * 8;
    const bf16_t* ksrc = H1 + (rowb + lane) * H1P + 1536 + h * 64 + wave * 8;
    const bf16_t* vsrc = H1 + (rowb + 16 * (wave & 3) + (lane >> 2)) * H1P + 2048 + h * 64 + (wave >> 2) * 32 + (lane & 3) * 8;
    const int kdst = wave * 1024 + lane * 16, vdst = wave * 1024 + lane * 16;
    const int t_end = 4 * (6 + par) + 3;
    bf16x8 qr[4], qn[4]; u32x4 kreg, vreg;
    {
#pragma unroll
      for (int d0 = 0; d0 < 4; ++d0) qn[d0] = __builtin_nontemporal_load((const bf16x8*)(qsrc + (size_t)par * 256 * H1P + d0 * 16));
      kreg = *(const u32x4*)(ksrc); vreg = *(const u32x4*)(vsrc);
      const float bv0 = A.in[I_D_REL][h * 513 + tid], bv1 = A.in[I_D_REL][h * 513 + 512];
      biasL[tid] = bv0 * LOG2E; if (tid == 0) biasL[512] = bv1 * LOG2E;
      *(LAS u32x4*)(Kb + kdst) = kreg; *(LAS u32x4*)(Vb + vdst) = vreg;
      kreg = *(const u32x4*)(ksrc + (size_t)64 * H1P); vreg = *(const u32x4*)(vsrc + (size_t)64 * H1P);
      __syncthreads(); }
#pragma unroll 1
    for (int ui = 0; ui < 4; ++ui) {
    const int cg = 2 * ui + par, n0 = 4 * cg, n = n0 + pj, qpos0 = n * 64 + (wave & 1) * 32;
    const int s_lo = n0 >= 8 ? n0 - 8 : -3, w_lo = n - 8 > 0 ? n - 8 : 0;
    const int cgn = 2 * (ui + 1) + par; const bool more = ui + 1 < 4;
#pragma unroll
    for (int d0 = 0; d0 < 4; ++d0) qr[d0] = qn[d0];
    float mrun = -1.0e30f, lrun = 0.f; f32x16 o[2];
#pragma unroll
    for (int r = 0; r < 16; ++r) { o[0][r] = 0.f; o[1][r] = 0.f; }
    const int vlane = ((lane >> 4) & 1) * 32 + (lane & 3) * 8 + (4 * hi + ((lane & 15) >> 2)) * 64;
#pragma unroll 1
    for (int s_ = s_lo; s_ <= n0; ++s_) {
        const int tnew = s_ + 4;
        if (s_ < n0) { const int slot = tnew % 5; *(LAS u32x4*)(Kb + slot * 8192 + kdst) = kreg; *(LAS u32x4*)(Vb + slot * 8192 + vdst) = vreg;
            if (tnew + 1 <= t_end) { kreg = *(const u32x4*)(ksrc + (size_t)(tnew + 1) * 64 * H1P); vreg = *(const u32x4*)(vsrc + (size_t)(tnew + 1) * 64 * H1P); } }
        const int t = s_ + pj, buf = (t + 5) % 5;
        if (s_ == n0 - 1 && more) {
#pragma unroll
            for (int d0 = 0; d0 < 4; ++d0) qn[d0] = __builtin_nontemporal_load((const bf16x8*)(qsrc + (size_t)cgn * 256 * H1P + d0 * 16)); }
        if (t >= w_lo) {
            const LAS unsigned char* kb = Kb + buf * 8192 + hi * 1024 + r32 * 16;
            const bool fresh = __builtin_amdgcn_ballot_w64(mrun < -1.0e29f) != 0ull;
            const bool clipped = qpos0 - t * 64 - 63 >= 256;
            const float sub0 = fresh ? 0.f : mrun, cin = (clipped ? biasL[512] : 0.f) - sub0;
            f32x16 p0, p1;
#pragma unroll
            for (int r = 0; r < 16; ++r) { p0[r] = cin; p1[r] = cin; }
#pragma unroll
            for (int d0 = 0; d0 < 4; ++d0) { const bf16x8 b0 = *(const LAS bf16x8*)(kb + d0 * 2048), b1 = *(const LAS bf16x8*)(kb + d0 * 2048 + 512);
                p0 = __builtin_amdgcn_mfma_f32_32x32x16_bf16(b0, qr[d0], p0, 0, 0, 0); p1 = __builtin_amdgcn_mfma_f32_32x32x16_bf16(b1, qr[d0], p1, 0, 0, 0); }
            if (!clipped) { const int dbase = (qpos0 + r32) - t * 64;
                if (qpos0 + 31 - t * 64 < 256) {
                    const LAS float* bp = biasL + (dbase - 4 * hi + 256 - 59 - 32);
#pragma unroll
                    for (int r = 0; r < 16; ++r) { const int c = (r & 3) + 8 * (r >> 2); p0[r] += bp[32 + 59 - c]; p1[r] += bp[59 - c]; }
                } else {
#pragma unroll
                    for (int r = 0; r < 16; ++r) { const int d0_ = dbase - crow(r, hi), d1_ = d0_ - 32;
                        p0[r] += biasL[(d0_ < 256 ? d0_ : 256) + 256]; p1[r] += biasL[(d1_ < 256 ? d1_ : 256) + 256]; } } }
            float mx[8];
#pragma unroll
            for (int r = 0; r < 8; ++r) mx[r] = fmaxf(fmaxf(p0[2 * r], p0[2 * r + 1]), fmaxf(p1[2 * r], p1[2 * r + 1]));
            float rm = fmaxf(fmaxf(fmaxf(mx[0], mx[1]), fmaxf(mx[2], mx[3])), fmaxf(fmaxf(mx[4], mx[5]), fmaxf(mx[6], mx[7])));
            { const unsigned ri = __builtin_bit_cast(unsigned, rm); const auto sw = __builtin_amdgcn_permlane32_swap(ri, ri, false, false); rm = fmaxf(__builtin_bit_cast(float, sw[0]), __builtin_bit_cast(float, sw[1])); }
            const bool resc = fresh || __builtin_amdgcn_ballot_w64(rm > 8.0f) != 0ull;
            float f = 1.0f;
            if (resc) { const float d = fresh ? rm : fmaxf(rm, 0.f); f = fresh ? 0.f : __builtin_amdgcn_exp2f(-d); mrun = sub0 + d;
#pragma unroll
                for (int r = 0; r < 16; ++r) { p0[r] -= d; p1[r] -= d; } }
            float ps = 0.f;
#pragma unroll
            for (int r = 0; r < 16; ++r) { p0[r] = __builtin_amdgcn_exp2f(p0[r]); p1[r] = __builtin_amdgcn_exp2f(p1[r]); ps += p0[r] + p1[r]; }
            lrun = lrun * f + ps;
            if (resc && hi == 0) wsf[r32] = f;
            bf16x8 pa[4];
#pragma unroll
            for (int ks = 0; ks < 2; ++ks) { u32x4 w0, w1;
                w0.x = cvt_pk_bf16(p0[8 * ks + 0], p0[8 * ks + 1]); w0.y = cvt_pk_bf16(p0[8 * ks + 2], p0[8 * ks + 3]); w0.z = cvt_pk_bf16(p0[8 * ks + 4], p0[8 * ks + 5]); w0.w = cvt_pk_bf16(p0[8 * ks + 6], p0[8 * ks + 7]);
                w1.x = cvt_pk_bf16(p1[8 * ks + 0], p1[8 * ks + 1]); w1.y = cvt_pk_bf16(p1[8 * ks + 2], p1[8 * ks + 3]); w1.z = cvt_pk_bf16(p1[8 * ks + 4], p1[8 * ks + 5]); w1.w = cvt_pk_bf16(p1[8 * ks + 6], p1[8 * ks + 7]);
                pa[ks] = __builtin_bit_cast(bf16x8, w0); pa[2 + ks] = __builtin_bit_cast(bf16x8, w1); }
            if (resc) {
#pragma unroll
                for (int r = 0; r < 16; ++r) { const float fr_ = wsf[crow(r, hi)]; o[0][r] *= fr_; o[1][r] *= fr_; } }
            const LAS unsigned char* vb = Vb + buf * 8192 + vlane;
#pragma unroll
            for (int dh = 0; dh < 2; ++dh)
#pragma unroll
                for (int ks = 0; ks < 4; ++ks) { const s16x4 lo = tr16(vb + dh * 4096 + ks * 1024), hh = tr16(vb + dh * 4096 + ks * 1024 + 512);
                    const bf16x8 vf = (bf16x8){lo[0], lo[1], lo[2], lo[3], hh[0], hh[1], hh[2], hh[3]};
                    o[dh] = __builtin_amdgcn_mfma_f32_32x32x16_bf16(pa[ks], vf, o[dh], 0, 0, 0); }
        }
        LDS_BARRIER();
    }
    { const unsigned li = __builtin_bit_cast(unsigned, lrun); const auto sw = __builtin_amdgcn_permlane32_swap(li, li, false, false); lrun = __builtin_bit_cast(float, sw[0]) + __builtin_bit_cast(float, sw[1]); }
    if (hi == 0) wsf[32 + r32] = 1.0f / lrun;
    bf16_t* Ow = U + (rowb + qpos0) * DM + 512 + h * 64;
#pragma unroll
    for (int r = 0; r < 16; ++r) { const int q = crow(r, hi); const float rl = wsf[32 + q];
        *(LAS bf16_t*)(stg + q * 128 + r32 * 2) = (bf16_t)f2bf(o[0][r] * rl); *(LAS bf16_t*)(stg + q * 128 + 64 + r32 * 2) = (bf16_t)f2bf(o[1][r] * rl); }
#pragma unroll
    for (int i = 0; i < 4; ++i) { const int row = i * 8 + (lane >> 3), ch = lane & 7; const u32x4 v = *(const LAS u32x4*)(stg + row * 128 + ch * 16); *(u32x4*)(Ow + (size_t)row * DM + ch * 8) = v; }
    }
    __syncthreads();
}

constexpr int NPHASE = 15;
__global__ void __launch_bounds__(NTHR, 2) hybrid_fwd(Args args) {
    extern __shared__ __attribute__((aligned(16))) unsigned char lds_raw[];
    LAS unsigned char* lds = (LAS unsigned char*)lds_raw;
    volatile LAS unsigned* MISC = (volatile LAS unsigned*)(lds + MISC_OFF);
    const int tid = threadIdx.x, lane = tid & 63, wave = __builtin_amdgcn_readfirstlane(tid >> 6);
    const int G = gridDim.x; const int bx = blockIdx.x; const int vcu = (G % 8 == 0) ? (bx % 8) * (G / 8) + bx / 8 : bx;
    unsigned char* ws = args.ws;
    gu32* ctl = (gu32*)(ws + WS_CTL);
    for (int u = tid; u < (LDS_BYTES - LDSCTL_OFF) / 4; u += NTHR) ((LAS unsigned*)(lds + LDSCTL_OFF))[u] = 0u;
    __syncthreads();
    XcdBarrier bar; bar.bar = (unsigned*)(ctl + CW_BAR); bar.x = 0; bar.st = nullptr;
    if (!MK_PER_PHASE) bar = xcd_barrier_post((unsigned*)(ctl + CW_BAR), MISC + 8);
    const int lo = args.ph_lo, hi = args.ph_hi, dblm = args.dbl;
#define IN(k) (lo <= (k) && (k) < hi)
#define DB(k) ((dblm >> (k)) & 1)
#define SEAM(k) do { if (IN(k) && IN((k) + 1)) { xcd_barrier(bar); if (dblm & 0x8000) xcd_barrier(bar); } } while (0)
    bf16_t* XA = (bf16_t*)(ws + WS_XA); bf16_t* X1 = (bf16_t*)(ws + WS_X1); bf16_t* HB = (bf16_t*)(ws + WS_H);
    bf16_t* U = (bf16_t*)args.out; bf16_t* Z = X1_RECOMP ? (bf16_t*)(ws + WS_X1) : (bf16_t*)args.out + (size_t)M * DM;       unsigned char* YB = ws + WS_H + 64 * MiB;
    unsigned* list = (unsigned*)(ws + WS_LIST); float* roww = (float*)(ws + WS_ROWW);

    if (IN(0)) { p0_prologue(args, lds, vcu, G, wave, lane, tid, DB(0)); } SEAM(0);
    LAS float* biasL = (LAS float*)(lds + TBL_OFF + 4096);
    if (IN(1)) { pg8::StaticOrder S; S.init(M, NIN, DM, ws + WS_WIN0, G, bx, DB(1)); pg8::EpiIn0 E{HB, biasL};
#pragma unroll
        for (int k = 0; k < NIN / 64 / NWAVES; ++k) { const int c = wave * (NIN / 64 / NWAVES) + k;
            __builtin_amdgcn_global_load_lds((const unsigned*)((const float*)(ws + WS_BIASP) + c * 64 + lane), (LAS unsigned*)(biasL + c * 64), 4, 0, 0); }
        const int pre = MOE_W_IN_P0 ? 0 : (vcu >> 5) % (MOE_W_SA + 1), tot = MOE_W_IN_P0 ? 0 : MOE_W_SA;
        moe_w_steps(args, lds, 0, vcu, wave, lane, 0, pre); __syncthreads();
        pg8::gemm_phase<pg8::EpiIn0, pg8::StaticOrder, true>(lds, (const char*)XA, DM, S, E);
        moe_w_steps(args, lds, 0, vcu, wave, lane, pre, tot); } SEAM(1);
    if (IN(2)) { conv_phase(args, lds, vcu, G, wave, lane, tid, HB, U, DB(2)); } SEAM(2);
    if (IN(3)) { pg8::StaticOrder S; S.init(M, DM, DM, ws + WS_WOUT0, G, bx, DB(3)); pg8::EpiOut<false, SKIP_MIX0> E{Z, (const void*)XA};
        const int pre = MOE_W_IN_P0 ? 0 : (vcu >> 5) % (7 - MOE_W_SA), tot = MOE_W_IN_P0 ? 0 : 6 - MOE_W_SA;
        moe_w_steps(args, lds, 0, vcu, wave, lane, MOE_W_SA, MOE_W_SA + pre); __syncthreads();
        pg8::gemm_phase<pg8::EpiOut<false, SKIP_MIX0>, pg8::StaticOrder, true>(lds, (const char*)U, DM, S, E);
        moe_w_steps(args, lds, 0, vcu, wave, lane, MOE_W_SA + pre, MOE_W_SA + tot);
        if (IN(4)) { __syncthreads(); router_preload(args, lds, tid, 0); } } SEAM(3);
    if (IN(4)) { router_phase(args, lds, vcu, wave, lane, tid, 0, Z, X1, (unsigned*)(ctl + CW_CNT), DB(4), IN(3)); } SEAM(4);
    if (IN(5)) { if (!SKIP_MOE0) { const int T = moe_table(lds, (const unsigned*)(ctl + CW_CNT), tid); LAS unsigned* tb = (LAS unsigned*)(lds + TBL_OFF);
        pg8::MoeOrder<true> S{tb + 64, tb, T, G, vcu, DM / 2, (const char*)(ws + WS_WGU), (size_t)DM * DM, list, DB(5)}; pg8::EpiGU E{(unsigned char*)HB};
        pg8::gemm_phase<pg8::EpiGU, pg8::MoeOrder<true>, true, true>(lds, (const char*)(ws + WS_X1Q), DM / 2, S, E);
        if (MOE_W_SLACK) { const int f = slack_first(T); if (f && vcu >= f) moe_w_ids(args, lds, 1, wave, lane, vcu - f, 256 - f, SLACK_K5); } } } SEAM(5);
    if (IN(6)) { if (!SKIP_MOE0) { LAS unsigned* tb = (LAS unsigned*)(lds + TBL_OFF); const int T = MK_PER_PHASE ? moe_table(lds, (const unsigned*)(ctl + CW_CNT), tid) : (int)tb[32];
        pg8::MoeOrder<false> S{tb + 64, tb, T, G, vcu, DE / 2, (const char*)(ws + WS_WD), (size_t)DM * DE, list, DB(6)}; pg8::EpiDown E{YB, list, roww, (LAS unsigned*)(lds + ROUTER_REC_OFF)};
        pg8::gemm_phase<pg8::EpiDown, pg8::MoeOrder<false>, true, true>(lds, (const char*)HB, DE / 2, S, E);
        if (MOE_W_SLACK) { const int f = slack_first(T); if (f && vcu >= f) moe_w_ids(args, lds, 1, wave, lane, (256 - f) * SLACK_K5 + vcu - f, 256 - f, SLACK_K6); } } } SEAM(6);
    if (IN(7)) { combine_ln_phase<false, SKIP_MOE0>(args, vcu, G, wave, lane, 0, X1_RECOMP ? Z : X1, YB, XA, nullptr, DB(7)); } SEAM(7);
    if (IN(8)) { pg8::StaticOrder S; S.init(M, NIN, DM, ws + WS_WIN1, G, bx, DB(8)); pg8::EpiIn1 E{HB, biasL};
#pragma unroll
        for (int k = 0; k < NIN / 64 / NWAVES; ++k) { const int c = wave * (NIN / 64 / NWAVES) + k;
            __builtin_amdgcn_global_load_lds((const unsigned*)(args.in[I_CD_BIN] + c * 64 + lane), (LAS unsigned*)(biasL + c * 64), 4, 0, 0); }
        const int T0 = MK_PER_PHASE ? moe_table(lds, (const unsigned*)(ctl + CW_CNT), tid) : (int)((LAS unsigned*)(lds + TBL_OFF))[32];
        const int D = (MOE_W_SLACK && !SKIP_MOE0) ? slack_done(T0) : 0;
        pg8::gemm_phase<pg8::EpiIn1, pg8::StaticOrder, true>(lds, (const char*)XA, DM, S, E);
        moe_w_ids(args, lds, 1, wave, lane, D + vcu, 256, MOE_W_SA); } SEAM(8);
    if (IN(9)) { if (!SKIP_MIX1) {
        for (int un = vcu; un < ((BATCH * 16) << DB(9)); un += G) sgu_unit(args, lds, wave, lane, (un >> 4) & 15, un & 15, HB, U);
        { const int pr = vcu >> 1; if (pr < BATCH * 8) attn_units(args, lds, wave, lane, tid, pr >> 3, pr & 7, vcu & 1, HB, U); } } } SEAM(9);
    if (IN(10)) { pg8::StaticOrder S; S.init(M, DM, DM, ws + WS_WOUT1, G, bx, DB(10)); pg8::EpiOut<false, SKIP_MIX1> E{Z, (const void*)XA};
        const int T0 = MK_PER_PHASE ? moe_table(lds, (const unsigned*)(ctl + CW_CNT), tid) : (int)((LAS unsigned*)(lds + TBL_OFF))[32];
        const int D = (MOE_W_SLACK && !SKIP_MOE0) ? slack_done(T0) : 0;
        pg8::gemm_phase<pg8::EpiOut<false, SKIP_MIX1>, pg8::StaticOrder, true>(lds, (const char*)U, DM, S, E);
        moe_w_ids(args, lds, 1, wave, lane, D + vcu + 256 * MOE_W_SA, 256, 6 - MOE_W_SA);
        if (IN(11)) { __syncthreads(); router_preload(args, lds, tid, 1); } } SEAM(10);
    if (IN(11)) { router_phase(args, lds, vcu, wave, lane, tid, 1, Z, X1, (unsigned*)(ctl + CW_CNT) + 32 * 64, DB(11), IN(10)); } SEAM(11);
    if (IN(12)) { if (!SKIP_MOE1) { const int T = moe_table(lds, (const unsigned*)(ctl + CW_CNT) + 32 * 64, tid); LAS unsigned* tb = (LAS unsigned*)(lds + TBL_OFF);
        pg8::MoeOrder<true> S{tb + 64, tb, T, G, vcu, DM / 2, (const char*)(ws + WS_WGU) + (size_t)NE * DM * DM, (size_t)DM * DM, list, DB(12)}; pg8::EpiGU E{(unsigned char*)HB};
        pg8::gemm_phase<pg8::EpiGU, pg8::MoeOrder<true>, true, true>(lds, (const char*)(ws + WS_X1Q), DM / 2, S, E); } } SEAM(12);
    if (IN(13)) { if (!SKIP_MOE1) { LAS unsigned* tb = (LAS unsigned*)(lds + TBL_OFF); const int T = MK_PER_PHASE ? moe_table(lds, (const unsigned*)(ctl + CW_CNT) + 32 * 64, tid) : (int)tb[32];
        pg8::MoeOrder<false> S{tb + 64, tb, T, G, vcu, DE / 2, (const char*)(ws + WS_WD) + (size_t)NE * DM * DE, (size_t)DM * DE, list, DB(13)}; pg8::EpiDown E{YB, list, roww, (LAS unsigned*)(lds + ROUTER_REC_OFF)};
        pg8::gemm_phase<pg8::EpiDown, pg8::MoeOrder<false>, true, true>(lds, (const char*)HB, DE / 2, S, E); } } SEAM(13);
    if (IN(14)) { combine_ln_phase<true, SKIP_MOE1>(args, vcu, G, wave, lane, 1, X1_RECOMP ? Z : X1, YB, nullptr, args.out, 0); }
#undef IN
#undef SEAM
}

extern "C" void kernel_launch(void* const* d_in, const int* in_sizes, int n_in, void* d_out, int out_size, void* d_ws, size_t ws_size, hipStream_t stream) {
    static int grid = 0;
    if (grid == 0) {
        if (n_in != 28 || in_sizes[0] != M * DM || out_size != M * DM || ws_size < WS_END) { fprintf(stderr, "kernel_launch: unexpected shapes / workspace (n_in %d, ws %zu); nothing launched\n", n_in, ws_size); grid = -1; return; }
        int dev = 0, cus = 0;
        if (hipGetDevice(&dev) != hipSuccess || hipDeviceGetAttribute(&cus, hipDeviceAttributeMultiprocessorCount, dev) != hipSuccess) { grid = -1; return; }
        if (hipFuncSetAttribute((const void*)hybrid_fwd, hipFuncAttributeMaxDynamicSharedMemorySize, LDS_BYTES) != hipSuccess) { fprintf(stderr, "kernel_launch: hipFuncSetAttribute failed\n"); grid = -1; return; }
        (void)hipGetLastError();
        grid = cus;
        if (grid != 256) { fprintf(stderr, "kernel_launch: built for 256 CUs, device has %d\n", cus); grid = -1; return; }
    }
    if (grid < 0) return;
    if (hipMemsetAsync((char*)d_ws + WS_CTL, 0, CTL_ZERO_BYTES, stream) != hipSuccess) return;
    Args a{};
    for (int i = 0; i < 28; ++i) a.in[i] = (const float*)d_in[i];
    a.out = (float*)d_out; a.ws = (unsigned char*)d_ws; a.dbl = DBL_MASK;
#if MK_PER_PHASE
    for (int p = 0; p < NPHASE; ++p) { a.ph_lo = p; a.ph_hi = p + 1; hipLaunchKernelGGL(hybrid_fwd, dim3(grid), dim3(NTHR), LDS_BYTES, stream, a); }
#else
    a.ph_lo = 0; a.ph_hi = NPHASE; hipLaunchKernelGGL(hybrid_fwd, dim3(grid), dim3(NTHR), LDS_BYTES, stream, a);
#ifdef EXTRA_PHASE
    a.ph_lo = EXTRA_PHASE; a.ph_hi = EXTRA_PHASE + 1; hipLaunchKernelGGL(hybrid_fwd, dim3(grid), dim3(NTHR), LDS_BYTES, stream, a);
#endif
#endif
}
```
